# Optimizing an MI355X kernel written in HIP

```python
import jax, jax.numpy as jnp
from jax import lax
import numpy as np

D_MODEL = 1024
BATCH = 8
SEQ = 4096
DEPTH = 2

HEAD_DIM = 64
N_RET_HEADS = D_MODEL // (2 * HEAD_DIM)
N_SB_HEADS = D_MODEL // (2 * HEAD_DIM)
N_FOX_HEADS = D_MODEL // HEAD_DIM
RET_WIDTH = N_RET_HEADS * HEAD_DIM
SB_WIDTH = N_SB_HEADS * HEAD_DIM
FOX_WIDTH = N_FOX_HEADS * HEAD_DIM
EVEN_MIX_WIDTH = RET_WIDTH + SB_WIDTH
EVEN_IN_SIZES = (RET_WIDTH, RET_WIDTH, RET_WIDTH, RET_WIDTH, SB_WIDTH, SB_WIDTH, SB_WIDTH)
EVEN_IN_WIDTH = sum(EVEN_IN_SIZES)
ODD_IN_SIZES = (FOX_WIDTH, FOX_WIDTH, FOX_WIDTH, N_FOX_HEADS)
ODD_IN_WIDTH = sum(ODD_IN_SIZES)
D_FF = ((8 * D_MODEL // 3 + 127) // 128) * 128
N_EXPERTS = 8
TOP_K = 2
BLOCK = 128
CHUNK = 128
ROPE_BASE = 10000.0
NORM_EPS = 1e-6
GROUP_NORM_EPS = 1e-5
FORGET_BIAS_CENTER = 2.0
N_EVEN = (DEPTH + 1) // 2
N_ODD = DEPTH // 2

kernel_name = "hybrid_retention_stickbreak_fox_moe"


def _split_points(sizes):
    return [int(v) for v in np.cumsum(sizes)[:-1]]


def _rms_norm(x, gain):
    xf = x.astype(jnp.float32)
    y = xf * lax.rsqrt(jnp.mean(xf * xf, axis=-1, keepdims=True) + NORM_EPS)
    return (y * gain.astype(jnp.float32)).astype(x.dtype)


def _split_heads(t, n_heads):
    b, s, _ = t.shape
    return t.reshape(b, s, n_heads, HEAD_DIM).transpose(0, 2, 1, 3)


def _merge_heads(t):
    b, h, s, d = t.shape
    return t.transpose(0, 2, 1, 3).reshape(b, s, h * d)


def _rotary(t):
    s, d = t.shape[2], t.shape[3]
    half = d // 2
    inv_freq = ROPE_BASE ** (-jnp.arange(half, dtype=jnp.float32) / half)
    ang = jnp.arange(s, dtype=jnp.float32)[:, None] * inv_freq[None, :]
    cos, sin = jnp.cos(ang), jnp.sin(ang)
    t1, t2 = t[..., :half], t[..., half:]
    return jnp.concatenate([t1 * cos - t2 * sin, t1 * sin + t2 * cos], axis=-1)


def _retention_chunkwise(q, k, v):
    b, h, s, d = q.shape
    nc = s // CHUNK
    log_gamma = jnp.log(1.0 - 2.0 ** (-5.0 - jnp.arange(h, dtype=jnp.float32)))
    pos = jnp.arange(CHUNK, dtype=jnp.float32)
    diff = pos[:, None] - pos[None, :]
    intra_decay = jnp.where(diff >= 0.0,
                            jnp.exp(log_gamma[:, None, None] * jnp.maximum(diff, 0.0)),
                            0.0)
    q_decay = jnp.exp(log_gamma[:, None] * (pos + 1.0))
    k_decay = jnp.exp(log_gamma[:, None] * (CHUNK - 1.0 - pos))
    chunk_decay = jnp.exp(log_gamma * CHUNK)
    qc = q.reshape(b, h, nc, CHUNK, d)
    kc = k.reshape(b, h, nc, CHUNK, d)
    vc = v.reshape(b, h, nc, CHUNK, d)
    scores = jnp.einsum("bhnqd,bhnkd->bhnqk", qc, kc) * intra_decay[None, :, None]
    inner = jnp.einsum("bhnqk,bhnke->bhnqe", scores, vc)
    kv = jnp.einsum("bhnkd,bhnke->nbhde", kc * k_decay[None, :, None, :, None], vc)

    def step(state, kv_n):
        return state * chunk_decay[None, :, None, None] + kv_n, state

    _, states = lax.scan(step, jnp.zeros((b, h, d, d), jnp.float32), kv)
    cross = jnp.einsum("bhnqd,nbhde->bhnqe", qc * q_decay[None, :, None, :, None], states)
    return (inner + cross).reshape(b, h, s, d)


def _stick_breaking_attention(q, k, v):
    b, h, s, d = q.shape
    scale = d ** -0.5
    outs = []
    for blk in range(s // BLOCK):
        lo, hi = blk * BLOCK, (blk + 1) * BLOCK
        z = jnp.einsum("bhqd,bhkd->bhqk", q[:, :, lo:hi], k[:, :, :hi]) * scale
        q_pos = lo + jnp.arange(BLOCK)
        k_pos = jnp.arange(hi)
        strict = k_pos[None, :] < q_pos[:, None]
        log_fail = jnp.where(strict, jax.nn.log_sigmoid(-z), 0.0)
        later_fail = lax.cumsum(log_fail, axis=3, reverse=True) - log_fail
        weights = jnp.where(strict, jnp.exp(jax.nn.log_sigmoid(z) + later_fail), 0.0)
        outs.append(jnp.einsum("bhqk,bhkd->bhqd", weights, v[:, :, :hi]))
    return jnp.concatenate(outs, axis=2)


def _forgetting_attention(q, k, v, log_f):
    b, h, s, d = q.shape
    scale = d ** -0.5
    cum = jnp.cumsum(log_f, axis=-1)
    outs = []
    for blk in range(s // BLOCK):
        lo, hi = blk * BLOCK, (blk + 1) * BLOCK
        z = jnp.einsum("bhqd,bhkd->bhqk", q[:, :, lo:hi], k[:, :, :hi]) * scale
        logits = z + cum[:, :, lo:hi, None] - cum[:, :, None, :hi]
        q_pos = lo + jnp.arange(BLOCK)
        k_pos = jnp.arange(hi)
        causal = k_pos[None, :] <= q_pos[:, None]
        probs = jax.nn.softmax(jnp.where(causal, logits, -jnp.inf), axis=-1)
        outs.append(jnp.einsum("bhqk,bhkd->bhqd", probs, v[:, :, :hi]))
    return jnp.concatenate(outs, axis=2)


def _even_mixer(h, w_in, ret_norm, w_out):
    f32 = jnp.float32
    proj = jnp.einsum("bsm,mn->bsn", h, w_in)
    q_r, k_r, v_r, g_r, q_s, k_s, v_s = jnp.split(proj, _split_points(EVEN_IN_SIZES), axis=-1)
    q_r = _rotary(_split_heads(q_r, N_RET_HEADS).astype(f32))
    k_r = _rotary(_split_heads(k_r, N_RET_HEADS).astype(f32)) * (HEAD_DIM ** -0.5)
    y_r = _retention_chunkwise(q_r, k_r, _split_heads(v_r, N_RET_HEADS).astype(f32))
    mu = jnp.mean(y_r, axis=-1, keepdims=True)
    var = jnp.mean(jnp.square(y_r - mu), axis=-1, keepdims=True)
    y_r = _merge_heads((y_r - mu) * lax.rsqrt(var + GROUP_NORM_EPS))
    y_r = y_r * ret_norm.astype(f32) * jax.nn.silu(g_r.astype(f32))
    y_s = _merge_heads(_stick_breaking_attention(
        _split_heads(q_s, N_SB_HEADS).astype(f32),
        _split_heads(k_s, N_SB_HEADS).astype(f32),
        _split_heads(v_s, N_SB_HEADS).astype(f32)))
    y = jnp.concatenate([y_r, y_s], axis=-1).astype(h.dtype)
    return jnp.einsum("bsm,md->bsd", y, w_out)


def _odd_mixer(h, w_in, b_forget, w_out):
    f32 = jnp.float32
    proj = jnp.einsum("bsm,mn->bsn", h, w_in)
    q, k, v, f_logit = jnp.split(proj, _split_points(ODD_IN_SIZES), axis=-1)
    log_f = jax.nn.log_sigmoid(f_logit.astype(f32) + b_forget.astype(f32)).transpose(0, 2, 1)
    y = _forgetting_attention(_split_heads(q, N_FOX_HEADS).astype(f32),
                              _split_heads(k, N_FOX_HEADS).astype(f32),
                              _split_heads(v, N_FOX_HEADS).astype(f32), log_f)
    return jnp.einsum("bsm,md->bsd", _merge_heads(y).astype(h.dtype), w_out)


def _swiglu(h, w_gate, w_up, w_down):
    a = jax.nn.silu(jnp.einsum("bsd,df->bsf", h, w_gate)) * jnp.einsum("bsd,df->bsf", h, w_up)
    return jnp.einsum("bsf,fd->bsd", a, w_down)


def _moe_swiglu(h, w_router, w_gate, w_up, w_down):
    b, s, dm = h.shape
    t = h.reshape(b * s, dm)
    logits = jnp.einsum("td,de->te", t, w_router).astype(jnp.float32)
    top_vals, top_idx = lax.top_k(logits, TOP_K)
    gates = jax.nn.softmax(top_vals, axis=-1)
    combine = jnp.sum(jax.nn.one_hot(top_idx, N_EXPERTS, dtype=jnp.float32) * gates[..., None], axis=1)
    out = jnp.zeros((b * s, dm), jnp.float32)
    for e in range(N_EXPERTS):
        a = jax.nn.silu(t @ w_gate[e]) * (t @ w_up[e])
        out = out + combine[:, e:e + 1] * (a @ w_down[e]).astype(jnp.float32)
    return out.reshape(b, s, dm).astype(h.dtype)


def _normal(key, shape, scale):
    return jax.random.normal(key, shape, jnp.float32) * scale


def setup_inputs(seed: int = 0) -> dict:
    key = jax.random.key(seed)
    ks = jax.random.split(key, 20)
    d = D_MODEL
    return {
        "x": _normal(ks[0], (BATCH, SEQ, d), 1.0),
        "attn_norm_even": 1.0 + _normal(ks[1], (N_EVEN, d), 0.02),
        "w_in_even": _normal(ks[2], (N_EVEN, d, EVEN_IN_WIDTH), d ** -0.5),
        "ret_norm_even": 1.0 + _normal(ks[3], (N_EVEN, RET_WIDTH), 0.02),
        "w_out_even": _normal(ks[4], (N_EVEN, EVEN_MIX_WIDTH, d), EVEN_MIX_WIDTH ** -0.5),
        "ffn_norm_even": 1.0 + _normal(ks[5], (N_EVEN, d), 0.02),
        "w_gate_even": _normal(ks[6], (N_EVEN, d, D_FF), d ** -0.5),
        "w_up_even": _normal(ks[7], (N_EVEN, d, D_FF), d ** -0.5),
        "w_down_even": _normal(ks[8], (N_EVEN, D_FF, d), D_FF ** -0.5),
        "attn_norm_odd": 1.0 + _normal(ks[9], (N_ODD, d), 0.02),
        "w_in_odd": _normal(ks[10], (N_ODD, d, ODD_IN_WIDTH), d ** -0.5),
        "b_forget_odd": FORGET_BIAS_CENTER + _normal(ks[11], (N_ODD, N_FOX_HEADS), 0.1),
        "w_out_odd": _normal(ks[12], (N_ODD, FOX_WIDTH, d), FOX_WIDTH ** -0.5),
        "ffn_norm_odd": 1.0 + _normal(ks[13], (N_ODD, d), 0.02),
        "w_router_odd": _normal(ks[14], (N_ODD, d, N_EXPERTS), d ** -0.5),
        "w_gate_moe_odd": _normal(ks[15], (N_ODD, N_EXPERTS, d, D_FF), d ** -0.5),
        "w_up_moe_odd": _normal(ks[16], (N_ODD, N_EXPERTS, d, D_FF), d ** -0.5),
        "w_down_moe_odd": _normal(ks[17], (N_ODD, N_EXPERTS, D_FF, d), D_FF ** -0.5),
        "final_norm": 1.0 + _normal(ks[18], (d,), 0.02),
    }


def reference(x, attn_norm_even, w_in_even, ret_norm_even, w_out_even, ffn_norm_even,
              w_gate_even, w_up_even, w_down_even, attn_norm_odd, w_in_odd, b_forget_odd,
              w_out_odd, ffn_norm_odd, w_router_odd, w_gate_moe_odd, w_up_moe_odd,
              w_down_moe_odd, final_norm):
    h = x
    for layer in range(DEPTH):
        i = layer // 2
        if layer % 2 == 0:
            h = h + _even_mixer(_rms_norm(h, attn_norm_even[i]), w_in_even[i],
                                ret_norm_even[i], w_out_even[i]).astype(h.dtype)
            h = h + _swiglu(_rms_norm(h, ffn_norm_even[i]), w_gate_even[i],
                            w_up_even[i], w_down_even[i]).astype(h.dtype)
        else:
            h = h + _odd_mixer(_rms_norm(h, attn_norm_odd[i]), w_in_odd[i],
                               b_forget_odd[i], w_out_odd[i]).astype(h.dtype)
            h = h + _moe_swiglu(_rms_norm(h, ffn_norm_odd[i]), w_router_odd[i],
                                w_gate_moe_odd[i], w_up_moe_odd[i],
                                w_down_moe_odd[i]).astype(h.dtype)
    return _rms_norm(h, final_norm)
```

```cpp
#include <hip/hip_runtime.h>
#include <cstdio>
#include <cstdint>

constexpr int DM = 1024, BATCH = 8, SEQ = 4096, T = BATCH * SEQ;
constexpr int HD = 64;
constexpr int EW = 3584;
constexpr int OW = 3088, OWP = 3328;
constexpr int QKVW = 3072;
constexpr int DFF = 2816, NEXP = 8, GU = 2 * DFF;
constexpr float NORM_EPS = 1e-6f, GN_EPS = 1e-5f;
constexpr float LOG2E = 1.4426950408889634f;
constexpr float C2 = 0.125f * LOG2E;
constexpr int MOE_MAXT = 136;

constexpr size_t MiB = 1u << 20;
constexpr size_t WS_CTL = 0, CTL_BYTES = 2 * MiB;
constexpr size_t WS_ROPE = 2 * MiB;
constexpr size_t WS_ROUTW = 3 * MiB;
constexpr size_t WS_RSTD4 = 3 * MiB + 65536;
constexpr size_t WS_LIST = 4 * MiB;
constexpr size_t WS_GATE = 6 * MiB;
constexpr size_t WS_PART = 8 * MiB;
constexpr size_t WS_LOGF = 14 * MiB;
constexpr size_t WS_CUM = 16 * MiB;
constexpr size_t WS_W = 18 * MiB;
constexpr size_t WS_W_IN_E = WS_W;
constexpr size_t WS_W_OUT_E = WS_W_IN_E + (size_t)EW * DM * 2;
constexpr size_t WS_W_GU_E = WS_W_OUT_E + (size_t)DM * DM * 2;
constexpr size_t WS_W_DN_E = WS_W_GU_E + (size_t)GU * DM * 2;
constexpr size_t WS_W_IN_O = WS_W_DN_E + (size_t)DM * DFF * 2;
constexpr size_t WS_W_OUT_O = WS_W_IN_O + (size_t)OWP * DM * 2;
constexpr size_t WS_W_GU_M = WS_W_OUT_O + (size_t)DM * DM * 2;
constexpr size_t WS_W_DN_M = WS_W_GU_M + (size_t)NEXP * GU * DM * 2;
constexpr size_t WS_W_END = WS_W_DN_M + (size_t)NEXP * DM * DFF * 2;
constexpr size_t WS_X0 = 184 * MiB;
constexpr size_t WS_BIG = 248 * MiB;
constexpr size_t WS_HID = WS_BIG + 64 * MiB;
constexpr size_t WS_END = WS_BIG + 251 * MiB;
static_assert(WS_W_END <= WS_X0 && WS_END <= 512 * MiB, "ws map");
static_assert(WS_HID + (size_t)MOE_MAXT * 256 * DFF * 2 <= WS_END, "hidden fits");
constexpr int CW_CNT = 64;
constexpr int CW_BAR = 4096;

typedef unsigned short bf16;
typedef short bf16x8 __attribute__((ext_vector_type(8)));
typedef float f32x4 __attribute__((ext_vector_type(4)));
typedef float f32x16 __attribute__((ext_vector_type(16)));
typedef unsigned u32x4 __attribute__((ext_vector_type(4)));
typedef unsigned u32x2 __attribute__((ext_vector_type(2)));

struct Params { const float* in[19]; float* out; unsigned char* ws; int ph_lo, ph_hi; };

__device__ __forceinline__ unsigned f2bf(float f) { unsigned u = __builtin_bit_cast(unsigned, f); return (u + 0x7fffu + ((u >> 16) & 1u)) >> 16; }
__device__ __forceinline__ unsigned pk2(float lo, float hi) { return f2bf(lo) | (f2bf(hi) << 16); }
__device__ __forceinline__ float bf2f(unsigned short b) { return __builtin_bit_cast(float, (unsigned)b << 16); }
__device__ __forceinline__ float wave_sum(float v) {
#pragma unroll
    for (int o = 1; o < 64; o <<= 1) v += __shfl_xor(v, o);
    return v;
}
__device__ __forceinline__ float silu_f(float x) { return x / (1.f + __expf(-x)); }
__device__ __forceinline__ float softplus2(float y) { return fmaxf(y, 0.f) + __log2f(1.f + __builtin_amdgcn_exp2f(-fabsf(y))); }
__device__ __forceinline__ float rstd_from_part(const float* part, int row) {
    const f32x4* p = (const f32x4*)(part + (size_t)row * 16); float s = 0.f;
#pragma unroll
    for (int i = 0; i < 4; ++i) { const f32x4 v = p[i]; s += (v[0] + v[1]) + (v[2] + v[3]); }
    return 1.0f / sqrtf(s * (1.f / DM) + NORM_EPS);
}
__device__ __forceinline__ bool moe_tile(const unsigned* ctl, int c, int tile, int& e, int& row0, int& nrows) {
    int ts = 0;
#pragma unroll
    for (int i = 0; i < 8; ++i) { const int cn = (int)ctl[CW_CNT + 64 * (c * 8 + i)]; const int nt = (cn + 255) >> 8;
        if (tile >= ts && tile < ts + nt) { e = i; row0 = (tile - ts) * 256; nrows = cn - row0 < 256 ? cn - row0 : 256; return true; }
        ts += nt; }
    return false;
}

__constant__ double c_invfreq[32] = {1, 0.74989420933245587, 0.56234132519034907, 0.42169650342858223, 0.31622776601683794, 0.23713737056616552, 0.17782794100389229, 0.1333521432163324,
    0.10000000000000001, 0.074989420933245579, 0.056234132519034911, 0.042169650342858224, 0.031622776601683791, 0.023713737056616554, 0.017782794100389229, 0.013335214321633241,
    0.01, 0.0074989420933245579, 0.005623413251903491, 0.0042169650342858229, 0.0031622776601683794, 0.0023713737056616554, 0.0017782794100389228, 0.0013335214321633241,
    0.001, 0.00074989420933245586, 0.0005623413251903491, 0.00042169650342858224, 0.00031622776601683794, 0.00023713737056616554, 0.00017782794100389227, 0.0001333521432163324};
__device__ __forceinline__ void rope_entry(int pos, int i, float& c, float& s) {
    const double a = (double)pos * c_invfreq[i];
    const double TWO_PI = 6.283185307179586476925286766559, HALF_PI = 1.5707963267948966192313216916398;
    double r = a - TWO_PI * __builtin_rint(a / TWO_PI);
    const double qd = __builtin_rint(r / HALF_PI); const int q = (int)qd; r -= qd * HALF_PI;
    const double r2 = r * r;
    const double sn = r * (1.0 + r2 * (-1.0 / 6 + r2 * (1.0 / 120 + r2 * (-1.0 / 5040 + r2 * (1.0 / 362880 + r2 * (-1.0 / 39916800 + r2 * (1.0 / 6227020800.0)))))));
    const double cs = 1.0 + r2 * (-0.5 + r2 * (1.0 / 24 + r2 * (-1.0 / 720 + r2 * (1.0 / 40320 + r2 * (-1.0 / 3628800 + r2 * (1.0 / 479001600.0))))));
    const int qq = q & 3; double cc, ss;
    if (qq == 0) { cc = cs; ss = sn; } else if (qq == 1) { cc = -sn; ss = cs; } else if (qq == 2) { cc = -cs; ss = -sn; } else { cc = sn; ss = -cs; }
    c = (float)cc; s = (float)ss;
}
enum { MAP_ID = 0, MAP_INE = 1, MAP_GATE = 2, MAP_UP = 3 };
__device__ __forceinline__ int map_row(int mode, int n) {
    if (mode == MAP_INE) return n < 1024 ? (n & ~63) + 2 * (n & 31) + ((n >> 5) & 1) : n;
    if (mode == MAP_GATE) return (n >> 7) * 256 + (n & 127);
    if (mode == MAP_UP) return (n >> 7) * 256 + 128 + (n & 127);
    return n;
}
template <class LP>
__device__ __forceinline__ void transpose_item(const float* __restrict__ W, int K, int N, bf16* WT, const float* __restrict__ gain, int mode, LP scr, int item, int lane) {
    const int nblk = (N + 31) / 32, kb = item / nblk, nb = item % nblk, k0 = 64 * kb, n0 = 32 * nb;
    const bool nok = n0 + (lane & 31) < N;
#pragma unroll 8
    for (int i = 0; i < 32; ++i) { const int kk = 2 * i + (lane >> 5); float v = nok ? W[(size_t)(k0 + kk) * N + n0 + (lane & 31)] : 0.f; if (gain) v *= gain[k0 + kk]; scr[kk * 33 + (lane & 31)] = v; }
    asm volatile("s_waitcnt lgkmcnt(0)" ::: "memory");
    const int c = lane & 7;
#pragma unroll
    for (int j = 0; j < 4; ++j) { const int n = (lane >> 3) + 8 * j;
        u32x4 o; o.x = pk2(scr[(8 * c + 0) * 33 + n], scr[(8 * c + 1) * 33 + n]); o.y = pk2(scr[(8 * c + 2) * 33 + n], scr[(8 * c + 3) * 33 + n]);
        o.z = pk2(scr[(8 * c + 4) * 33 + n], scr[(8 * c + 5) * 33 + n]); o.w = pk2(scr[(8 * c + 6) * 33 + n], scr[(8 * c + 7) * 33 + n]);
        if (n0 + n < N) *(u32x4*)(WT + (size_t)map_row(mode, n0 + n) * K + k0 + 8 * c) = o; }
    asm volatile("s_waitcnt lgkmcnt(0)" ::: "memory");
}
struct WJob { const float* W; int K, N; bf16* WT; const float* gain; int mode; int items; };
template <class LP>
__device__ __forceinline__ void prologue_weights(const Params& p, LP scr, int gw, int ngw, int lane) {
    unsigned char* ws = p.ws;
    for (int j = 0; j < 7 + 3 * NEXP; ++j) {
        WJob J;
        if (j == 0) J = WJob{p.in[2], DM, EW, (bf16*)(ws + WS_W_IN_E), p.in[1], MAP_INE, 0};
        else if (j == 1) J = WJob{p.in[4], DM, DM, (bf16*)(ws + WS_W_OUT_E), nullptr, MAP_ID, 0};
        else if (j == 2) J = WJob{p.in[6], DM, DFF, (bf16*)(ws + WS_W_GU_E), p.in[5], MAP_GATE, 0};
        else if (j == 3) J = WJob{p.in[7], DM, DFF, (bf16*)(ws + WS_W_GU_E), p.in[5], MAP_UP, 0};
        else if (j == 4) J = WJob{p.in[8], DFF, DM, (bf16*)(ws + WS_W_DN_E), nullptr, MAP_ID, 0};
        else if (j == 5) J = WJob{p.in[10], DM, OW, (bf16*)(ws + WS_W_IN_O), p.in[9], MAP_ID, 0};
        else if (j == 6) J = WJob{p.in[12], DM, DM, (bf16*)(ws + WS_W_OUT_O), nullptr, MAP_ID, 0};
        else { const int k = j - 7, e = k / 3, w = k % 3;
            if (w == 0) J = WJob{p.in[15] + (size_t)e * DM * DFF, DM, DFF, (bf16*)(ws + WS_W_GU_M) + (size_t)e * GU * DM, p.in[13], MAP_GATE, 0};
            else if (w == 1) J = WJob{p.in[16] + (size_t)e * DM * DFF, DM, DFF, (bf16*)(ws + WS_W_GU_M) + (size_t)e * GU * DM, p.in[13], MAP_UP, 0};
            else J = WJob{p.in[17] + (size_t)e * DFF * DM, DFF, DM, (bf16*)(ws + WS_W_DN_M) + (size_t)e * DM * DFF, nullptr, MAP_ID, 0}; }
        J.items = (J.K / 64) * ((J.N + 31) / 32);
        for (int it = gw; it < J.items; it += ngw) transpose_item(J.W, J.K, J.N, J.WT, J.gain, J.mode, scr, it, lane);
    }
}
__device__ __forceinline__ void prologue_small(const Params& p, int gt, int ngt) {
    unsigned char* ws = p.ws;
    { u32x4* z = (u32x4*)((bf16*)(ws + WS_W_IN_O) + (size_t)OW * DM); const int n16 = (OWP - OW) * DM * 2 / 16;
      for (int i = gt; i < n16; i += ngt) z[i] = (u32x4){0u, 0u, 0u, 0u}; }
    { float2* R = (float2*)(ws + WS_ROPE);
      for (int i = gt; i < SEQ * 32; i += ngt) { float c, s; rope_entry(i >> 5, i & 31, c, s); R[i] = make_float2(c, s); } }
    { float* RW = (float*)(ws + WS_ROUTW); const float* wr = p.in[14]; const float* g = p.in[13];
      for (int i = gt; i < NEXP * DM; i += ngt) { const int e = i >> 10, k = i & 1023; RW[i] = wr[k * NEXP + e] * g[k]; } }
}
__device__ __forceinline__ void rms_row_to_bf16(const float* xrow, bf16* orow, int lane) {
    const f32x4* xr = (const f32x4*)xrow + lane;
    f32x4 v[4]; float s = 0.f;
#pragma unroll
    for (int j = 0; j < 4; ++j) { v[j] = xr[64 * j]; s += (v[j][0] * v[j][0] + v[j][1] * v[j][1]) + (v[j][2] * v[j][2] + v[j][3] * v[j][3]); }
    const float rstd = 1.0f / sqrtf(wave_sum(s) * (1.f / DM) + NORM_EPS);
    unsigned long long* o8 = (unsigned long long*)orow + lane;
#pragma unroll
    for (int j = 0; j < 4; ++j) o8[64 * j] = (unsigned long long)pk2(v[j][0] * rstd, v[j][1] * rstd) | ((unsigned long long)pk2(v[j][2] * rstd, v[j][3] * rstd) << 32);
}
__device__ __forceinline__ void final_norm_row(float* row, const float* gain, int lane) {
    f32x4* xr = (f32x4*)row + lane; const f32x4* g = (const f32x4*)gain + lane;
    f32x4 v[4]; float s = 0.f;
#pragma unroll
    for (int j = 0; j < 4; ++j) { v[j] = xr[64 * j]; s += (v[j][0] * v[j][0] + v[j][1] * v[j][1]) + (v[j][2] * v[j][2] + v[j][3] * v[j][3]); }
    const float rstd = 1.0f / sqrtf(wave_sum(s) * (1.f / DM) + NORM_EPS);
#pragma unroll
    for (int j = 0; j < 4; ++j) xr[64 * j] = v[j] * rstd * g[64 * j];
}
__device__ __forceinline__ void router_row(const float* hrow, const float* RW, const float* part4, int row, float* rstd4, int lane, int& e1, int& e2, float& g1, float& g2) {
    const f32x4* xr = (const f32x4*)hrow + lane; f32x4 v[4];
#pragma unroll
    for (int j = 0; j < 4; ++j) v[j] = xr[64 * j];
    float lg[NEXP];
#pragma unroll
    for (int e = 0; e < NEXP; ++e) { const f32x4* w = (const f32x4*)(RW + e * DM) + lane; float s = 0.f;
#pragma unroll
        for (int j = 0; j < 4; ++j) { const f32x4 ww = w[64 * j]; s += (v[j][0] * ww[0] + v[j][1] * ww[1]) + (v[j][2] * ww[2] + v[j][3] * ww[3]); }
        lg[e] = wave_sum(s); }
    const float rstd = rstd_from_part(part4, row);
    if (lane == 0) rstd4[row] = rstd;
    int b1 = 0; float v1 = lg[0];
#pragma unroll
    for (int e = 1; e < NEXP; ++e) if (lg[e] > v1) { v1 = lg[e]; b1 = e; }
    int b2 = -1; float v2 = -INFINITY;
#pragma unroll
    for (int e = 0; e < NEXP; ++e) if (e != b1 && lg[e] > v2) { v2 = lg[e]; b2 = e; }
    e1 = b1; e2 = b2; const float d = (v2 - v1) * rstd;
    g1 = 1.f / (1.f + __expf(d)); g2 = 1.f - g1;
}

__global__ void __launch_bounds__(256) nk_prologue_w(Params p) {
    __shared__ float scr[4][64 * 33];
    const int wave = threadIdx.x >> 6, lane = threadIdx.x & 63;
    prologue_weights(p, &scr[wave][0], blockIdx.x * 4 + wave, gridDim.x * 4, lane);
}
__global__ void __launch_bounds__(256) nk_prologue_s(Params p) {
    prologue_small(p, blockIdx.x * 256 + threadIdx.x, gridDim.x * 256);
    const int gw = blockIdx.x * 4 + (threadIdx.x >> 6), ngw = gridDim.x * 4, lane = threadIdx.x & 63;
    for (int m = gw; m < T; m += ngw) rms_row_to_bf16(p.in[0] + (size_t)m * DM, (bf16*)(p.ws + WS_X0) + (size_t)m * DM, lane);
}
__global__ void __launch_bounds__(256) nk_rowssq(Params p, int which) {
    const int gw = blockIdx.x * 4 + (threadIdx.x >> 6), ngw = gridDim.x * 4, lane = threadIdx.x & 63;
    float* part = (float*)(p.ws + WS_PART) + (size_t)which * T * 16;
    for (int m = gw; m < T; m += ngw) { const f32x4* xr = (const f32x4*)(p.out + (size_t)m * DM) + lane; float s = 0.f;
#pragma unroll
        for (int j = 0; j < 4; ++j) { const f32x4 v = xr[64 * j]; s += (v[0] * v[0] + v[1] * v[1]) + (v[2] * v[2] + v[3] * v[3]); }
        s = wave_sum(s); if (lane < 16) part[(size_t)m * 16 + lane] = lane == 0 ? s : 0.f; }
}
template <int EPI> __global__ void __launch_bounds__(256) nk_gemm(Params p) {
    unsigned char* ws = p.ws; const unsigned* ctl = (const unsigned*)(ws + WS_CTL);
    const int lane = threadIdx.x & 63, w = threadIdx.x >> 6, wm = w >> 1, wn = w & 1, l15 = lane & 15, lq = lane >> 4;
    const int m0 = blockIdx.y * 64 + wm * 32, n0 = blockIdx.x * 64 + wn * 32;
    constexpr bool DUAL = (EPI == 4 || EPI == 10), MOE = (EPI == 10 || EPI == 11);
    constexpr int K = (EPI == 5 || EPI == 11) ? DFF : DM;
    const bf16* A; const bf16* Bt; int e = 0, row0 = 0, nrows = 256; const int c = p.ph_lo;
    if (MOE) { if (!moe_tile(ctl, c, blockIdx.y >> 2, e, row0, nrows)) return; }
    if (EPI == 1) { A = (const bf16*)(ws + WS_X0); Bt = (const bf16*)(ws + WS_W_IN_E); }
    else if (EPI == 3) { A = (const bf16*)(ws + WS_X0); Bt = (const bf16*)(ws + WS_W_OUT_E); }
    else if (EPI == 4) { A = (const bf16*)(ws + WS_BIG); Bt = (const bf16*)(ws + WS_W_GU_E); }
    else if (EPI == 5) { A = (const bf16*)(ws + WS_HID); Bt = (const bf16*)(ws + WS_W_DN_E); }
    else if (EPI == 6) { A = (const bf16*)(ws + WS_X0); Bt = (const bf16*)(ws + WS_W_IN_O); }
    else if (EPI == 8) { A = (const bf16*)(ws + WS_X0); Bt = (const bf16*)(ws + WS_W_OUT_O); }
    else if (EPI == 10) { A = (const bf16*)(ws + WS_BIG); Bt = (const bf16*)(ws + WS_W_GU_M) + (size_t)e * GU * DM; }
    else { A = (const bf16*)(ws + WS_HID); Bt = (const bf16*)(ws + WS_W_DN_M) + (size_t)e * DM * DFF; }
    const int* list = (const int*)(ws + WS_LIST) + (size_t)(c * 8 + e) * T; const float* glist = (const float*)(ws + WS_GATE) + (size_t)(c * 8 + e) * T;
    const bf16* arow[2];
#pragma unroll
    for (int i = 0; i < 2; ++i) { const int m = m0 + 16 * i + l15;
        if (EPI == 10) { const int r = (m & 255); const int tok = list[row0 + (r < nrows ? r : 0)]; arow[i] = A + (size_t)tok * K; }
        else arow[i] = A + (size_t)m * K; }
    const bf16* brow[2];
#pragma unroll
    for (int j = 0; j < 2; ++j) { const int n = n0 + 16 * j + l15; const int br = DUAL ? ((n >> 7) * 256 + (n & 127)) : n; brow[j] = Bt + (size_t)br * K; }
    f32x4 acc[2][2], acc2[2][2];
#pragma unroll
    for (int i = 0; i < 2; ++i)
#pragma unroll
        for (int j = 0; j < 2; ++j) { acc[i][j] = (f32x4){0.f, 0.f, 0.f, 0.f}; acc2[i][j] = (f32x4){0.f, 0.f, 0.f, 0.f}; }
    for (int k0 = 0; k0 < K; k0 += 32) {
        bf16x8 a[2], b[2], b2[2];
#pragma unroll
        for (int i = 0; i < 2; ++i) a[i] = *(const bf16x8*)(arow[i] + k0 + 8 * lq);
#pragma unroll
        for (int j = 0; j < 2; ++j) { b[j] = *(const bf16x8*)(brow[j] + k0 + 8 * lq); if (DUAL) b2[j] = *(const bf16x8*)(brow[j] + (size_t)128 * K + k0 + 8 * lq); }
#pragma unroll
        for (int i = 0; i < 2; ++i)
#pragma unroll
            for (int j = 0; j < 2; ++j) { acc[i][j] = __builtin_amdgcn_mfma_f32_16x16x32_bf16(a[i], b[j], acc[i][j], 0, 0, 0);
                if (DUAL) acc2[i][j] = __builtin_amdgcn_mfma_f32_16x16x32_bf16(a[i], b2[j], acc2[i][j], 0, 0, 0); }
    }
    const float2* rope = (const float2*)(ws + WS_ROPE);
#pragma unroll
    for (int i = 0; i < 2; ++i)
#pragma unroll
        for (int j = 0; j < 2; ++j)
#pragma unroll
            for (int r = 0; r < 4; ++r) {
                const int m = m0 + 16 * i + 4 * lq + r, n = n0 + 16 * j + l15; float v = acc[i][j][r];
                if (EPI == 1) {
                    bf16* O = (bf16*)(ws + WS_BIG);
                    const float vp = __shfl_xor(v, 1);
                    if (n < 1024) { const float2 cs = rope[(m & (SEQ - 1)) * 32 + ((n & 63) >> 1)];
                        v = (n & 1) ? (vp * cs.y + v * cs.x) : (v * cs.x - vp * cs.y);
                        if (n >= 512) v *= 0.125f; }
                    else if (n >= 2048 && n < 2560) v *= C2;
                    O[(size_t)m * EW + n] = (bf16)f2bf(v);
                } else if (EPI == 3 || EPI == 5 || EPI == 8) {
                    const float* resid = (EPI == 3) ? p.in[0] : p.out; const float o = resid[(size_t)m * DM + n] + v;
                    p.out[(size_t)m * DM + n] = o;
                    bf16* hb = (bf16*)(ws + (EPI == 5 ? WS_X0 : WS_BIG)); hb[(size_t)m * DM + n] = (bf16)f2bf(o);
                } else if (EPI == 4) {
                    const float rs = rstd_from_part((const float*)(ws + WS_PART), m);
                    const float g = v * rs, u = acc2[i][j][r] * rs; ((bf16*)(ws + WS_HID))[(size_t)m * DFF + n] = (bf16)f2bf(silu_f(g) * u);
                } else if (EPI == 6) {
                    const float rs = rstd_from_part((const float*)(ws + WS_PART) + (size_t)T * 16, m); v *= rs;
                    if (n < QKVW) { if (n < 1024) v *= C2; ((bf16*)(ws + WS_BIG))[(size_t)m * QKVW + n] = (bf16)f2bf(v); }
                    else if (n < OW) { const int h = n - QKVW; const float z = v + p.in[11][h]; const float lf = fminf(z, 0.f) - log1pf(__expf(-fabsf(z)));
                        ((float*)(ws + WS_LOGF))[((size_t)(m >> 12) * 16 + h) * SEQ + (m & (SEQ - 1))] = lf; }
                } else if (EPI == 10) {
                    const int rr = m & 255; const int tok = list[row0 + (rr < nrows ? rr : 0)]; const float rs = ((const float*)(ws + WS_RSTD4))[tok];
                    const float g = v * rs, u = acc2[i][j][r] * rs; ((bf16*)(ws + WS_HID))[(size_t)m * DFF + n] = (bf16)f2bf(silu_f(g) * u);
                } else if (EPI == 11) {
                    const int rr = m & 255; if (rr < nrows) { const int tok = list[row0 + rr]; const float gt = glist[row0 + rr]; p.out[(size_t)tok * DM + n] += gt * v; }
                }
            }
}
__global__ void __launch_bounds__(256) nk_retention(Params p) {
    const bf16* P = (const bf16*)(p.ws + WS_BIG); bf16* Y = (bf16*)(p.ws + WS_X0);
    const int gw = blockIdx.x * 4 + (threadIdx.x >> 6), lane = threadIdx.x & 63;
    const int t = gw & (SEQ - 1), h = (gw >> 12) & 7, b = gw >> 15; if (b >= BATCH) return;
    const float lg2 = log2f(1.0f - exp2f(-5.0f - (float)h));
    const size_t rb = (size_t)b * SEQ;
    const float q = bf2f(P[(rb + t) * EW + h * 64 + lane]);
    float o = 0.f;
    for (int s = 0; s <= t; ++s) {
        const float k = bf2f(P[(rb + s) * EW + 512 + h * 64 + lane]), v = bf2f(P[(rb + s) * EW + 1024 + h * 64 + lane]);
        const float d = wave_sum(q * k);
        o += exp2f(lg2 * (float)(t - s)) * d * v;
    }
    const float mu = wave_sum(o) * (1.f / 64.f); const float dv = o - mu; const float var = wave_sum(dv * dv) * (1.f / 64.f);
    const float g = bf2f(P[(rb + t) * EW + 1536 + h * 64 + lane]);
    const float y = dv * (1.0f / sqrtf(var + GN_EPS)) * p.in[3][h * 64 + lane] * silu_f(g);
    Y[(rb + t) * DM + h * 64 + lane] = (bf16)f2bf(y);
}
__global__ void __launch_bounds__(256) nk_stickbreak(Params p) {
    const bf16* P = (const bf16*)(p.ws + WS_BIG); bf16* Y = (bf16*)(p.ws + WS_X0);
    const int gw = blockIdx.x * 4 + (threadIdx.x >> 6), lane = threadIdx.x & 63;
    const int t = gw & (SEQ - 1), h = (gw >> 12) & 7, b = gw >> 15; if (b >= BATCH) return;
    const size_t rb = (size_t)b * SEQ;
    const float q = bf2f(P[(rb + t) * EW + 2048 + h * 64 + lane]);
    float o = 0.f, carry = 0.f;
    for (int s = t - 1; s >= 0; --s) {
        const float k = bf2f(P[(rb + s) * EW + 2560 + h * 64 + lane]), v = bf2f(P[(rb + s) * EW + 3072 + h * 64 + lane]);
        const float y = wave_sum(q * k);
        const float lf2 = -softplus2(y);
        o += __builtin_amdgcn_exp2f(y + lf2 + carry) * v;
        carry += lf2;
    }
    Y[(rb + t) * DM + 512 + h * 64 + lane] = (bf16)f2bf(o);
}
__global__ void __launch_bounds__(128) nk_cumsum(Params p) {
    const int i = threadIdx.x; const float* lf = (const float*)(p.ws + WS_LOGF) + (size_t)i * SEQ; float* cu = (float*)(p.ws + WS_CUM) + (size_t)i * SEQ;
    float s = 0.f; for (int t = 0; t < SEQ; ++t) { s += lf[t]; cu[t] = s; }
}
__global__ void __launch_bounds__(256) nk_fox(Params p) {
    const bf16* P = (const bf16*)(p.ws + WS_BIG); bf16* Y = (bf16*)(p.ws + WS_X0);
    const int gw = blockIdx.x * 4 + (threadIdx.x >> 6), lane = threadIdx.x & 63;
    const int t = gw & (SEQ - 1), h = (gw >> 12) & 15, b = gw >> 16; if (b >= BATCH) return;
    const size_t rb = (size_t)b * SEQ; const float* cu = (const float*)(p.ws + WS_CUM) + ((size_t)b * 16 + h) * SEQ;
    const float q = bf2f(P[(rb + t) * QKVW + h * 64 + lane]);
    const float ct = cu[t]; float m = -INFINITY, l = 0.f, o = 0.f;
    for (int s = 0; s <= t; ++s) {
        const float k = bf2f(P[(rb + s) * QKVW + 1024 + h * 64 + lane]), v = bf2f(P[(rb + s) * QKVW + 2048 + h * 64 + lane]);
        const float x = wave_sum(q * k) + (ct - cu[s]) * LOG2E;
        if (x > m) { const float f = __builtin_amdgcn_exp2f(m - x); l *= f; o *= f; m = x; }
        const float pr = __builtin_amdgcn_exp2f(x - m); l += pr; o += pr * v;
    }
    Y[(rb + t) * DM + h * 64 + lane] = (bf16)f2bf(o / l);
}
__global__ void __launch_bounds__(256) nk_router(Params p) {
    __shared__ unsigned lcnt[16], lbase[16]; __shared__ int tinfo[128][2]; __shared__ float tg[128][2]; __shared__ unsigned tpos[128][2];
    unsigned char* ws = p.ws; unsigned* ctl = (unsigned*)(ws + WS_CTL);
    const int lane = threadIdx.x & 63, w = threadIdx.x >> 6;
    if (threadIdx.x < 16) lcnt[threadIdx.x] = 0u;
    __syncthreads();
    const float* part4 = (const float*)(ws + WS_PART) + (size_t)2 * T * 16;
    for (int i = 0; i < 32; ++i) { const int lt = w * 32 + i, row = blockIdx.x * 128 + lt; int e1, e2; float g1, g2;
        router_row(p.out + (size_t)row * DM, (const float*)(ws + WS_ROUTW), part4, row, (float*)(ws + WS_RSTD4), lane, e1, e2, g1, g2);
        if (lane == 0) { tinfo[lt][0] = e1; tinfo[lt][1] = e2; tg[lt][0] = g1; tg[lt][1] = g2; tpos[lt][0] = atomicAdd(&lcnt[e1], 1u); tpos[lt][1] = atomicAdd(&lcnt[8 + e2], 1u); } }
    __syncthreads();
    if (threadIdx.x < 16) lbase[threadIdx.x] = atomicAdd(&ctl[CW_CNT + 64 * threadIdx.x], lcnt[threadIdx.x]);
    __syncthreads();
    if (threadIdx.x < 256) { const int lt = threadIdx.x >> 1, c = threadIdx.x & 1, e = tinfo[lt][c]; const unsigned pos = lbase[c * 8 + e] + tpos[lt][c];
        ((int*)(ws + WS_LIST))[(size_t)(c * 8 + e) * T + pos] = blockIdx.x * 128 + lt; ((float*)(ws + WS_GATE))[(size_t)(c * 8 + e) * T + pos] = tg[lt][c]; }
}
__global__ void __launch_bounds__(256) nk_final(Params p) {
    const int gw = blockIdx.x * 4 + (threadIdx.x >> 6), ngw = gridDim.x * 4, lane = threadIdx.x & 63;
    for (int m = gw; m < T; m += ngw) final_norm_row(p.out + (size_t)m * DM, p.in[18], lane);
}

extern "C" void kernel_launch(void* const* d_in, const int* in_sizes, int n_in, void* d_out, int out_size, void* d_ws, size_t ws_size, hipStream_t stream) {
    if (n_in != 19 || out_size != T * DM || ws_size < WS_END) { fprintf(stderr, "kernel_launch: unexpected shapes (n_in %d out %d ws %zu)\n", n_in, out_size, ws_size); return; }
    (void)in_sizes;
    hipMemsetAsync((char*)d_ws + WS_CTL, 0, CTL_BYTES, stream);
    Params p{};
    for (int i = 0; i < 19; ++i) p.in[i] = (const float*)d_in[i];
    p.out = (float*)d_out; p.ws = (unsigned char*)d_ws; p.ph_lo = 0; p.ph_hi = 0;
    nk_prologue_w<<<1024, 256, 0, stream>>>(p);
    nk_prologue_s<<<1024, 256, 0, stream>>>(p);
    nk_gemm<1><<<dim3(EW / 64, T / 64), 256, 0, stream>>>(p);
    nk_retention<<<BATCH * 8 * SEQ / 4, 256, 0, stream>>>(p);
    nk_stickbreak<<<BATCH * 8 * SEQ / 4, 256, 0, stream>>>(p);
    nk_gemm<3><<<dim3(DM / 64, T / 64), 256, 0, stream>>>(p);
    nk_rowssq<<<1024, 256, 0, stream>>>(p, 0);
    nk_gemm<4><<<dim3(DFF / 64, T / 64), 256, 0, stream>>>(p);
    nk_gemm<5><<<dim3(DM / 64, T / 64), 256, 0, stream>>>(p);
    nk_rowssq<<<1024, 256, 0, stream>>>(p, 1);
    nk_gemm<6><<<dim3(49, T / 64), 256, 0, stream>>>(p);
    nk_cumsum<<<1, 128, 0, stream>>>(p);
    nk_fox<<<BATCH * 16 * SEQ / 4, 256, 0, stream>>>(p);
    nk_gemm<8><<<dim3(DM / 64, T / 64), 256, 0, stream>>>(p);
    nk_rowssq<<<1024, 256, 0, stream>>>(p, 2);
    nk_router<<<T / 128, 256, 0, stream>>>(p);
    for (int c = 0; c < 2; ++c) { p.ph_lo = c;
        nk_gemm<10><<<dim3(DFF / 64, MOE_MAXT * 4), 256, 0, stream>>>(p);
        nk_gemm<11><<<dim3(DM / 64, MOE_MAXT * 4), 256, 0, stream>>>(p); }
    p.ph_lo = 0;
    nk_final<<<1024, 256, 0, stream>>>(p);
}
```

```cpp
#include <hip/hip_runtime.h>
#include <cstdio>
#include <cstdint>

constexpr int DM = 1024, BATCH = 8, SEQ = 4096, T = BATCH * SEQ;
constexpr int HD = 64;
constexpr int EW = 3584;
constexpr int OW = 3088, OWP = 3328;
constexpr int QKVW = 3072;
constexpr int DFF = 2816, NEXP = 8, GU = 2 * DFF;
constexpr float NORM_EPS = 1e-6f, GN_EPS = 1e-5f;
constexpr float LOG2E = 1.4426950408889634f;
constexpr float C2 = 0.125f * LOG2E;
constexpr int MOE_MAXT = 136;

constexpr size_t MiB = 1u << 20;
constexpr size_t WS_CTL = 0, CTL_BYTES = 2 * MiB;
constexpr size_t WS_ROPE = 2 * MiB;
constexpr size_t WS_ROUTW = 3 * MiB;
constexpr size_t WS_RSTD4 = 3 * MiB + 65536;
constexpr size_t WS_LIST = 4 * MiB;
constexpr size_t WS_GATE = 6 * MiB;
constexpr size_t WS_PART = 8 * MiB;
constexpr size_t WS_LOGF = 14 * MiB;
constexpr size_t WS_CUM = 16 * MiB;
constexpr size_t WS_W = 18 * MiB;
constexpr size_t WS_W_IN_E = WS_W;
constexpr size_t WS_W_OUT_E = WS_W_IN_E + (size_t)EW * DM * 2;
constexpr size_t WS_W_GU_E = WS_W_OUT_E + (size_t)DM * DM * 2;
constexpr size_t WS_W_DN_E = WS_W_GU_E + (size_t)GU * DM * 2;
constexpr size_t WS_W_IN_O = WS_W_DN_E + (size_t)DM * DFF * 2;
constexpr size_t WS_W_OUT_O = WS_W_IN_O + (size_t)OWP * DM * 2;
constexpr size_t WS_W_GU_M = WS_W_OUT_O + (size_t)DM * DM * 2;
constexpr size_t WS_W_DN_M = WS_W_GU_M + (size_t)NEXP * GU * DM * 2;
constexpr size_t WS_W_END = WS_W_DN_M + (size_t)NEXP * DM * DFF * 2;
constexpr size_t WS_X0 = 184 * MiB;
constexpr size_t WS_BIG = 248 * MiB;
constexpr size_t WS_HID = WS_BIG + 64 * MiB;
constexpr size_t WS_END = WS_BIG + 251 * MiB;
static_assert(WS_W_END <= WS_X0 && WS_END <= 512 * MiB, "ws map");
static_assert(WS_HID + (size_t)MOE_MAXT * 256 * DFF * 2 <= WS_END, "hidden fits");
constexpr int CW_CNT = 64;
constexpr int CW_BAR = 4096;

typedef unsigned short bf16;
typedef short bf16x8 __attribute__((ext_vector_type(8)));
typedef float f32x4 __attribute__((ext_vector_type(4)));
typedef float f32x16 __attribute__((ext_vector_type(16)));
typedef unsigned u32x4 __attribute__((ext_vector_type(4)));
typedef unsigned u32x2 __attribute__((ext_vector_type(2)));

struct Params { const float* in[19]; float* out; unsigned char* ws; int ph_lo, ph_hi; };

__device__ __forceinline__ unsigned f2bf(float f) { unsigned u = __builtin_bit_cast(unsigned, f); return (u + 0x7fffu + ((u >> 16) & 1u)) >> 16; }
__device__ __forceinline__ unsigned pk2(float lo, float hi) { return f2bf(lo) | (f2bf(hi) << 16); }
__device__ __forceinline__ float bf2f(unsigned short b) { return __builtin_bit_cast(float, (unsigned)b << 16); }
__device__ __forceinline__ float wave_sum(float v) {
#pragma unroll
    for (int o = 1; o < 64; o <<= 1) v += __shfl_xor(v, o);
    return v;
}
__device__ __forceinline__ float silu_f(float x) { return x / (1.f + __expf(-x)); }
__device__ __forceinline__ float softplus2(float y) { return fmaxf(y, 0.f) + __log2f(1.f + __builtin_amdgcn_exp2f(-fabsf(y))); }
__device__ __forceinline__ float rstd_from_part(const float* part, int row) {
    const f32x4* p = (const f32x4*)(part + (size_t)row * 16); float s = 0.f;
#pragma unroll
    for (int i = 0; i < 4; ++i) { const f32x4 v = p[i]; s += (v[0] + v[1]) + (v[2] + v[3]); }
    return 1.0f / sqrtf(s * (1.f / DM) + NORM_EPS);
}
__device__ __forceinline__ bool moe_tile(const unsigned* ctl, int c, int tile, int& e, int& row0, int& nrows) {
    int ts = 0;
#pragma unroll
    for (int i = 0; i < 8; ++i) { const int cn = (int)ctl[CW_CNT + 64 * (c * 8 + i)]; const int nt = (cn + 255) >> 8;
        if (tile >= ts && tile < ts + nt) { e = i; row0 = (tile - ts) * 256; nrows = cn - row0 < 256 ? cn - row0 : 256; return true; }
        ts += nt; }
    return false;
}

__constant__ double c_invfreq[32] = {1, 0.74989420933245587, 0.56234132519034907, 0.42169650342858223, 0.31622776601683794, 0.23713737056616552, 0.17782794100389229, 0.1333521432163324,
    0.10000000000000001, 0.074989420933245579, 0.056234132519034911, 0.042169650342858224, 0.031622776601683791, 0.023713737056616554, 0.017782794100389229, 0.013335214321633241,
    0.01, 0.0074989420933245579, 0.005623413251903491, 0.0042169650342858229, 0.0031622776601683794, 0.0023713737056616554, 0.0017782794100389228, 0.0013335214321633241,
    0.001, 0.00074989420933245586, 0.0005623413251903491, 0.00042169650342858224, 0.00031622776601683794, 0.00023713737056616554, 0.00017782794100389227, 0.0001333521432163324};
__device__ __forceinline__ void rope_entry(int pos, int i, float& c, float& s) {
    const double a = (double)pos * c_invfreq[i];
    const double TWO_PI = 6.283185307179586476925286766559, HALF_PI = 1.5707963267948966192313216916398;
    double r = a - TWO_PI * __builtin_rint(a / TWO_PI);
    const double qd = __builtin_rint(r / HALF_PI); const int q = (int)qd; r -= qd * HALF_PI;
    const double r2 = r * r;
    const double sn = r * (1.0 + r2 * (-1.0 / 6 + r2 * (1.0 / 120 + r2 * (-1.0 / 5040 + r2 * (1.0 / 362880 + r2 * (-1.0 / 39916800 + r2 * (1.0 / 6227020800.0)))))));
    const double cs = 1.0 + r2 * (-0.5 + r2 * (1.0 / 24 + r2 * (-1.0 / 720 + r2 * (1.0 / 40320 + r2 * (-1.0 / 3628800 + r2 * (1.0 / 479001600.0))))));
    const int qq = q & 3; double cc, ss;
    if (qq == 0) { cc = cs; ss = sn; } else if (qq == 1) { cc = -sn; ss = cs; } else if (qq == 2) { cc = -cs; ss = -sn; } else { cc = sn; ss = -cs; }
    c = (float)cc; s = (float)ss;
}
enum { MAP_ID = 0, MAP_INE = 1, MAP_GATE = 2, MAP_UP = 3 };
__device__ __forceinline__ int map_row(int mode, int n) {
    if (mode == MAP_INE) return n < 1024 ? (n & ~63) + 2 * (n & 31) + ((n >> 5) & 1) : n;
    if (mode == MAP_GATE) return (n >> 7) * 256 + (n & 127);
    if (mode == MAP_UP) return (n >> 7) * 256 + 128 + (n & 127);
    return n;
}
template <class LP>
__device__ __forceinline__ void transpose_item(const float* __restrict__ W, int K, int N, bf16* WT, const float* __restrict__ gain, int mode, LP scr, int item, int lane) {
    const int nblk = (N + 31) / 32, kb = item / nblk, nb = item % nblk, k0 = 64 * kb, n0 = 32 * nb;
    const bool nok = n0 + (lane & 31) < N;
#pragma unroll 8
    for (int i = 0; i < 32; ++i) { const int kk = 2 * i + (lane >> 5); float v = nok ? W[(size_t)(k0 + kk) * N + n0 + (lane & 31)] : 0.f; if (gain) v *= gain[k0 + kk]; scr[kk * 33 + (lane & 31)] = v; }
    asm volatile("s_waitcnt lgkmcnt(0)" ::: "memory");
    const int c = lane & 7;
#pragma unroll
    for (int j = 0; j < 4; ++j) { const int n = (lane >> 3) + 8 * j;
        u32x4 o; o.x = pk2(scr[(8 * c + 0) * 33 + n], scr[(8 * c + 1) * 33 + n]); o.y = pk2(scr[(8 * c + 2) * 33 + n], scr[(8 * c + 3) * 33 + n]);
        o.z = pk2(scr[(8 * c + 4) * 33 + n], scr[(8 * c + 5) * 33 + n]); o.w = pk2(scr[(8 * c + 6) * 33 + n], scr[(8 * c + 7) * 33 + n]);
        if (n0 + n < N) *(u32x4*)(WT + (size_t)map_row(mode, n0 + n) * K + k0 + 8 * c) = o; }
    asm volatile("s_waitcnt lgkmcnt(0)" ::: "memory");
}
struct WJob { const float* W; int K, N; bf16* WT; const float* gain; int mode; int items; };
template <class LP>
__device__ __forceinline__ void prologue_weights(const Params& p, LP scr, int gw, int ngw, int lane) {
    unsigned char* ws = p.ws;
    for (int j = 0; j < 7 + 3 * NEXP; ++j) {
        WJob J;
        if (j == 0) J = WJob{p.in[2], DM, EW, (bf16*)(ws + WS_W_IN_E), p.in[1], MAP_INE, 0};
        else if (j == 1) J = WJob{p.in[4], DM, DM, (bf16*)(ws + WS_W_OUT_E), nullptr, MAP_ID, 0};
        else if (j == 2) J = WJob{p.in[6], DM, DFF, (bf16*)(ws + WS_W_GU_E), p.in[5], MAP_GATE, 0};
        else if (j == 3) J = WJob{p.in[7], DM, DFF, (bf16*)(ws + WS_W_GU_E), p.in[5], MAP_UP, 0};
        else if (j == 4) J = WJob{p.in[8], DFF, DM, (bf16*)(ws + WS_W_DN_E), nullptr, MAP_ID, 0};
        else if (j == 5) J = WJob{p.in[10], DM, OW, (bf16*)(ws + WS_W_IN_O), p.in[9], MAP_ID, 0};
        else if (j == 6) J = WJob{p.in[12], DM, DM, (bf16*)(ws + WS_W_OUT_O), nullptr, MAP_ID, 0};
        else { const int k = j - 7, e = k / 3, w = k % 3;
            if (w == 0) J = WJob{p.in[15] + (size_t)e * DM * DFF, DM, DFF, (bf16*)(ws + WS_W_GU_M) + (size_t)e * GU * DM, p.in[13], MAP_GATE, 0};
            else if (w == 1) J = WJob{p.in[16] + (size_t)e * DM * DFF, DM, DFF, (bf16*)(ws + WS_W_GU_M) + (size_t)e * GU * DM, p.in[13], MAP_UP, 0};
            else J = WJob{p.in[17] + (size_t)e * DFF * DM, DFF, DM, (bf16*)(ws + WS_W_DN_M) + (size_t)e * DM * DFF, nullptr, MAP_ID, 0}; }
        J.items = (J.K / 64) * ((J.N + 31) / 32);
        for (int it = gw; it < J.items; it += ngw) transpose_item(J.W, J.K, J.N, J.WT, J.gain, J.mode, scr, it, lane);
    }
}
__device__ __forceinline__ void prologue_small(const Params& p, int gt, int ngt) {
    unsigned char* ws = p.ws;
    { u32x4* z = (u32x4*)((bf16*)(ws + WS_W_IN_O) + (size_t)OW * DM); const int n16 = (OWP - OW) * DM * 2 / 16;
      for (int i = gt; i < n16; i += ngt) z[i] = (u32x4){0u, 0u, 0u, 0u}; }
    { float2* R = (float2*)(ws + WS_ROPE);
      for (int i = gt; i < SEQ * 32; i += ngt) { float c, s; rope_entry(i >> 5, i & 31, c, s); R[i] = make_float2(c, s); } }
    { float* RW = (float*)(ws + WS_ROUTW); const float* wr = p.in[14]; const float* g = p.in[13];
      for (int i = gt; i < NEXP * DM; i += ngt) { const int e = i >> 10, k = i & 1023; RW[i] = wr[k * NEXP + e] * g[k]; } }
}
__device__ __forceinline__ void rms_row_to_bf16(const float* xrow, bf16* orow, int lane) {
    const f32x4* xr = (const f32x4*)xrow + lane;
    f32x4 v[4]; float s = 0.f;
#pragma unroll
    for (int j = 0; j < 4; ++j) { v[j] = xr[64 * j]; s += (v[j][0] * v[j][0] + v[j][1] * v[j][1]) + (v[j][2] * v[j][2] + v[j][3] * v[j][3]); }
    const float rstd = 1.0f / sqrtf(wave_sum(s) * (1.f / DM) + NORM_EPS);
    unsigned long long* o8 = (unsigned long long*)orow + lane;
#pragma unroll
    for (int j = 0; j < 4; ++j) o8[64 * j] = (unsigned long long)pk2(v[j][0] * rstd, v[j][1] * rstd) | ((unsigned long long)pk2(v[j][2] * rstd, v[j][3] * rstd) << 32);
}
__device__ __forceinline__ void final_norm_row(float* row, const float* gain, int lane) {
    f32x4* xr = (f32x4*)row + lane; const f32x4* g = (const f32x4*)gain + lane;
    f32x4 v[4]; float s = 0.f;
#pragma unroll
    for (int j = 0; j < 4; ++j) { v[j] = xr[64 * j]; s += (v[j][0] * v[j][0] + v[j][1] * v[j][1]) + (v[j][2] * v[j][2] + v[j][3] * v[j][3]); }
    const float rstd = 1.0f / sqrtf(wave_sum(s) * (1.f / DM) + NORM_EPS);
#pragma unroll
    for (int j = 0; j < 4; ++j) xr[64 * j] = v[j] * rstd * g[64 * j];
}
__device__ __forceinline__ void router_row(const float* hrow, const float* RW, const float* part4, int row, float* rstd4, int lane, int& e1, int& e2, float& g1, float& g2) {
    const f32x4* xr = (const f32x4*)hrow + lane; f32x4 v[4];
#pragma unroll
    for (int j = 0; j < 4; ++j) v[j] = xr[64 * j];
    float lg[NEXP];
#pragma unroll
    for (int e = 0; e < NEXP; ++e) { const f32x4* w = (const f32x4*)(RW + e * DM) + lane; float s = 0.f;
#pragma unroll
        for (int j = 0; j < 4; ++j) { const f32x4 ww = w[64 * j]; s += (v[j][0] * ww[0] + v[j][1] * ww[1]) + (v[j][2] * ww[2] + v[j][3] * ww[3]); }
        lg[e] = wave_sum(s); }
    const float rstd = rstd_from_part(part4, row);
    if (lane == 0) rstd4[row] = rstd;
    int b1 = 0; float v1 = lg[0];
#pragma unroll
    for (int e = 1; e < NEXP; ++e) if (lg[e] > v1) { v1 = lg[e]; b1 = e; }
    int b2 = -1; float v2 = -INFINITY;
#pragma unroll
    for (int e = 0; e < NEXP; ++e) if (e != b1 && lg[e] > v2) { v2 = lg[e]; b2 = e; }
    e1 = b1; e2 = b2; const float d = (v2 - v1) * rstd;
    g1 = 1.f / (1.f + __expf(d)); g2 = 1.f - g1;
}

__global__ void __launch_bounds__(256) nk_prologue_w(Params p) {
    __shared__ float scr[4][64 * 33];
    const int wave = threadIdx.x >> 6, lane = threadIdx.x & 63;
    prologue_weights(p, &scr[wave][0], blockIdx.x * 4 + wave, gridDim.x * 4, lane);
}
__global__ void __launch_bounds__(256) nk_prologue_s(Params p) {
    prologue_small(p, blockIdx.x * 256 + threadIdx.x, gridDim.x * 256);
    const int gw = blockIdx.x * 4 + (threadIdx.x >> 6), ngw = gridDim.x * 4, lane = threadIdx.x & 63;
    for (int m = gw; m < T; m += ngw) rms_row_to_bf16(p.in[0] + (size_t)m * DM, (bf16*)(p.ws + WS_X0) + (size_t)m * DM, lane);
}
__global__ void __launch_bounds__(256) nk_rowssq(Params p, int which) {
    const int gw = blockIdx.x * 4 + (threadIdx.x >> 6), ngw = gridDim.x * 4, lane = threadIdx.x & 63;
    float* part = (float*)(p.ws + WS_PART) + (size_t)which * T * 16;
    for (int m = gw; m < T; m += ngw) { const f32x4* xr = (const f32x4*)(p.out + (size_t)m * DM) + lane; float s = 0.f;
#pragma unroll
        for (int j = 0; j < 4; ++j) { const f32x4 v = xr[64 * j]; s += (v[0] * v[0] + v[1] * v[1]) + (v[2] * v[2] + v[3] * v[3]); }
        s = wave_sum(s); if (lane < 16) part[(size_t)m * 16 + lane] = lane == 0 ? s : 0.f; }
}
template <int EPI> __global__ void __launch_bounds__(256) nk_gemm(Params p) {
    unsigned char* ws = p.ws; const unsigned* ctl = (const unsigned*)(ws + WS_CTL);
    const int lane = threadIdx.x & 63, w = threadIdx.x >> 6, wm = w >> 1, wn = w & 1, l15 = lane & 15, lq = lane >> 4;
    const int m0 = blockIdx.y * 64 + wm * 32, n0 = blockIdx.x * 64 + wn * 32;
    constexpr bool DUAL = (EPI == 4 || EPI == 10), MOE = (EPI == 10 || EPI == 11);
    constexpr int K = (EPI == 5 || EPI == 11) ? DFF : DM;
    const bf16* A; const bf16* Bt; int e = 0, row0 = 0, nrows = 256; const int c = p.ph_lo;
    if (MOE) { if (!moe_tile(ctl, c, blockIdx.y >> 2, e, row0, nrows)) return; }
    if (EPI == 1) { A = (const bf16*)(ws + WS_X0); Bt = (const bf16*)(ws + WS_W_IN_E); }
    else if (EPI == 3) { A = (const bf16*)(ws + WS_X0); Bt = (const bf16*)(ws + WS_W_OUT_E); }
    else if (EPI == 4) { A = (const bf16*)(ws + WS_BIG); Bt = (const bf16*)(ws + WS_W_GU_E); }
    else if (EPI == 5) { A = (const bf16*)(ws + WS_HID); Bt = (const bf16*)(ws + WS_W_DN_E); }
    else if (EPI == 6) { A = (const bf16*)(ws + WS_X0); Bt = (const bf16*)(ws + WS_W_IN_O); }
    else if (EPI == 8) { A = (const bf16*)(ws + WS_X0); Bt = (const bf16*)(ws + WS_W_OUT_O); }
    else if (EPI == 10) { A = (const bf16*)(ws + WS_BIG); Bt = (const bf16*)(ws + WS_W_GU_M) + (size_t)e * GU * DM; }
    else { A = (const bf16*)(ws + WS_HID); Bt = (const bf16*)(ws + WS_W_DN_M) + (size_t)e * DM * DFF; }
    const int* list = (const int*)(ws + WS_LIST) + (size_t)(c * 8 + e) * T; const float* glist = (const float*)(ws + WS_GATE) + (size_t)(c * 8 + e) * T;
    const bf16* arow[2];
#pragma unroll
    for (int i = 0; i < 2; ++i) { const int m = m0 + 16 * i + l15;
        if (EPI == 10) { const int r = (m & 255); const int tok = list[row0 + (r < nrows ? r : 0)]; arow[i] = A + (size_t)tok * K; }
        else arow[i] = A + (size_t)m * K; }
    const bf16* brow[2];
#pragma unroll
    for (int j = 0; j < 2; ++j) { const int n = n0 + 16 * j + l15; const int br = DUAL ? ((n >> 7) * 256 + (n & 127)) : n; brow[j] = Bt + (size_t)br * K; }
    f32x4 acc[2][2], acc2[2][2];
#pragma unroll
    for (int i = 0; i < 2; ++i)
#pragma unroll
        for (int j = 0; j < 2; ++j) { acc[i][j] = (f32x4){0.f, 0.f, 0.f, 0.f}; acc2[i][j] = (f32x4){0.f, 0.f, 0.f, 0.f}; }
    for (int k0 = 0; k0 < K; k0 += 32) {
        bf16x8 a[2], b[2], b2[2];
#pragma unroll
        for (int i = 0; i < 2; ++i) a[i] = *(const bf16x8*)(arow[i] + k0 + 8 * lq);
#pragma unroll
        for (int j = 0; j < 2; ++j) { b[j] = *(const bf16x8*)(brow[j] + k0 + 8 * lq); if (DUAL) b2[j] = *(const bf16x8*)(brow[j] + (size_t)128 * K + k0 + 8 * lq); }
#pragma unroll
        for (int i = 0; i < 2; ++i)
#pragma unroll
            for (int j = 0; j < 2; ++j) { acc[i][j] = __builtin_amdgcn_mfma_f32_16x16x32_bf16(a[i], b[j], acc[i][j], 0, 0, 0);
                if (DUAL) acc2[i][j] = __builtin_amdgcn_mfma_f32_16x16x32_bf16(a[i], b2[j], acc2[i][j], 0, 0, 0); }
    }
    const float2* rope = (const float2*)(ws + WS_ROPE);
#pragma unroll
    for (int i = 0; i < 2; ++i)
#pragma unroll
        for (int j = 0; j < 2; ++j)
#pragma unroll
            for (int r = 0; r < 4; ++r) {
                const int m = m0 + 16 * i + 4 * lq + r, n = n0 + 16 * j + l15; float v = acc[i][j][r];
                if (EPI == 1) {
                    bf16* O = (bf16*)(ws + WS_BIG);
                    const float vp = __shfl_xor(v, 1);
                    if (n < 1024) { const float2 cs = rope[(m & (SEQ - 1)) * 32 + ((n & 63) >> 1)];
                        v = (n & 1) ? (vp * cs.y + v * cs.x) : (v * cs.x - vp * cs.y);
                        if (n >= 512) v *= 0.125f; }
                    else if (n >= 2048 && n < 2560) v *= C2;
                    O[(size_t)m * EW + n] = (bf16)f2bf(v);
                } else if (EPI == 3 || EPI == 5 || EPI == 8) {
                    const float* resid = (EPI == 3) ? p.in[0] : p.out; const float o = resid[(size_t)m * DM + n] + v;
                    p.out[(size_t)m * DM + n] = o;
                    bf16* hb = (bf16*)(ws + (EPI == 5 ? WS_X0 : WS_BIG)); hb[(size_t)m * DM + n] = (bf16)f2bf(o);
                } else if (EPI == 4) {
                    const float rs = rstd_from_part((const float*)(ws + WS_PART), m);
                    const float g = v * rs, u = acc2[i][j][r] * rs; ((bf16*)(ws + WS_HID))[(size_t)m * DFF + n] = (bf16)f2bf(silu_f(g) * u);
                } else if (EPI == 6) {
                    const float rs = rstd_from_part((const float*)(ws + WS_PART) + (size_t)T * 16, m); v *= rs;
                    if (n < QKVW) { if (n < 1024) v *= C2; ((bf16*)(ws + WS_BIG))[(size_t)m * QKVW + n] = (bf16)f2bf(v); }
                    else if (n < OW) { const int h = n - QKVW; const float z = v + p.in[11][h]; const float lf = fminf(z, 0.f) - log1pf(__expf(-fabsf(z)));
                        ((float*)(ws + WS_LOGF))[((size_t)(m >> 12) * 16 + h) * SEQ + (m & (SEQ - 1))] = lf; }
                } else if (EPI == 10) {
                    const int rr = m & 255; const int tok = list[row0 + (rr < nrows ? rr : 0)]; const float rs = ((const float*)(ws + WS_RSTD4))[tok];
                    const float g = v * rs, u = acc2[i][j][r] * rs; ((bf16*)(ws + WS_HID))[(size_t)m * DFF + n] = (bf16)f2bf(silu_f(g) * u);
                } else if (EPI == 11) {
                    const int rr = m & 255; if (rr < nrows) { const int tok = list[row0 + rr]; const float gt = glist[row0 + rr]; p.out[(size_t)tok * DM + n] += gt * v; }
                }
            }
}
__global__ void __launch_bounds__(256) nk_retention(Params p) {
    const bf16* P = (const bf16*)(p.ws + WS_BIG); bf16* Y = (bf16*)(p.ws + WS_X0);
    const int gw = blockIdx.x * 4 + (threadIdx.x >> 6), lane = threadIdx.x & 63;
    const int t = gw & (SEQ - 1), h = (gw >> 12) & 7, b = gw >> 15; if (b >= BATCH) return;
    const float lg2 = log2f(1.0f - exp2f(-5.0f - (float)h));
    const size_t rb = (size_t)b * SEQ;
    const float q = bf2f(P[(rb + t) * EW + h * 64 + lane]);
    float o = 0.f;
    for (int s = 0; s <= t; ++s) {
        const float k = bf2f(P[(rb + s) * EW + 512 + h * 64 + lane]), v = bf2f(P[(rb + s) * EW + 1024 + h * 64 + lane]);
        const float d = wave_sum(q * k);
        o += exp2f(lg2 * (float)(t - s)) * d * v;
    }
    const float mu = wave_sum(o) * (1.f / 64.f); const float dv = o - mu; const float var = wave_sum(dv * dv) * (1.f / 64.f);
    const float g = bf2f(P[(rb + t) * EW + 1536 + h * 64 + lane]);
    const float y = dv * (1.0f / sqrtf(var + GN_EPS)) * p.in[3][h * 64 + lane] * silu_f(g);
    Y[(rb + t) * DM + h * 64 + lane] = (bf16)f2bf(y);
}
__global__ void __launch_bounds__(256) nk_stickbreak(Params p) {
    const bf16* P = (const bf16*)(p.ws + WS_BIG); bf16* Y = (bf16*)(p.ws + WS_X0);
    const int gw = blockIdx.x * 4 + (threadIdx.x >> 6), lane = threadIdx.x & 63;
    const int t = gw & (SEQ - 1), h = (gw >> 12) & 7, b = gw >> 15; if (b >= BATCH) return;
    const size_t rb = (size_t)b * SEQ;
    const float q = bf2f(P[(rb + t) * EW + 2048 + h * 64 + lane]);
    float o = 0.f, carry = 0.f;
    for (int s = t - 1; s >= 0; --s) {
        const float k = bf2f(P[(rb + s) * EW + 2560 + h * 64 + lane]), v = bf2f(P[(rb + s) * EW + 3072 + h * 64 + lane]);
        const float y = wave_sum(q * k);
        const float lf2 = -softplus2(y);
        o += __builtin_amdgcn_exp2f(y + lf2 + carry) * v;
        carry += lf2;
    }
    Y[(rb + t) * DM + 512 + h * 64 + lane] = (bf16)f2bf(o);
}
__global__ void __launch_bounds__(128) nk_cumsum(Params p) {
    const int i = threadIdx.x; const float* lf = (const float*)(p.ws + WS_LOGF) + (size_t)i * SEQ; float* cu = (float*)(p.ws + WS_CUM) + (size_t)i * SEQ;
    float s = 0.f; for (int t = 0; t < SEQ; ++t) { s += lf[t]; cu[t] = s; }
}
__global__ void __launch_bounds__(256) nk_fox(Params p) {
    const bf16* P = (const bf16*)(p.ws + WS_BIG); bf16* Y = (bf16*)(p.ws + WS_X0);
    const int gw = blockIdx.x * 4 + (threadIdx.x >> 6), lane = threadIdx.x & 63;
    const int t = gw & (SEQ - 1), h = (gw >> 12) & 15, b = gw >> 16; if (b >= BATCH) return;
    const size_t rb = (size_t)b * SEQ; const float* cu = (const float*)(p.ws + WS_CUM) + ((size_t)b * 16 + h) * SEQ;
    const float q = bf2f(P[(rb + t) * QKVW + h * 64 + lane]);
    const float ct = cu[t]; float m = -INFINITY, l = 0.f, o = 0.f;
    for (int s = 0; s <= t; ++s) {
        const float k = bf2f(P[(rb + s) * QKVW + 1024 + h * 64 + lane]), v = bf2f(P[(rb + s) * QKVW + 2048 + h * 64 + lane]);
        const float x = wave_sum(q * k) + (ct - cu[s]) * LOG2E;
        if (x > m) { const float f = __builtin_amdgcn_exp2f(m - x); l *= f; o *= f; m = x; }
        const float pr = __builtin_amdgcn_exp2f(x - m); l += pr; o += pr * v;
    }
    Y[(rb + t) * DM + h * 64 + lane] = (bf16)f2bf(o / l);
}
__global__ void __launch_bounds__(256) nk_router(Params p) {
    __shared__ unsigned lcnt[16], lbase[16]; __shared__ int tinfo[128][2]; __shared__ float tg[128][2]; __shared__ unsigned tpos[128][2];
    unsigned char* ws = p.ws; unsigned* ctl = (unsigned*)(ws + WS_CTL);
    const int lane = threadIdx.x & 63, w = threadIdx.x >> 6;
    if (threadIdx.x < 16) lcnt[threadIdx.x] = 0u;
    __syncthreads();
    const float* part4 = (const float*)(ws + WS_PART) + (size_t)2 * T * 16;
    for (int i = 0; i < 32; ++i) { const int lt = w * 32 + i, row = blockIdx.x * 128 + lt; int e1, e2; float g1, g2;
        router_row(p.out + (size_t)row * DM, (const float*)(ws + WS_ROUTW), part4, row, (float*)(ws + WS_RSTD4), lane, e1, e2, g1, g2);
        if (lane == 0) { tinfo[lt][0] = e1; tinfo[lt][1] = e2; tg[lt][0] = g1; tg[lt][1] = g2; tpos[lt][0] = atomicAdd(&lcnt[e1], 1u); tpos[lt][1] = atomicAdd(&lcnt[8 + e2], 1u); } }
    __syncthreads();
    if (threadIdx.x < 16) lbase[threadIdx.x] = atomicAdd(&ctl[CW_CNT + 64 * threadIdx.x], lcnt[threadIdx.x]);
    __syncthreads();
    if (threadIdx.x < 256) { const int lt = threadIdx.x >> 1, c = threadIdx.x & 1, e = tinfo[lt][c]; const unsigned pos = lbase[c * 8 + e] + tpos[lt][c];
        ((int*)(ws + WS_LIST))[(size_t)(c * 8 + e) * T + pos] = blockIdx.x * 128 + lt; ((float*)(ws + WS_GATE))[(size_t)(c * 8 + e) * T + pos] = tg[lt][c]; }
}
__global__ void __launch_bounds__(256) nk_final(Params p) {
    const int gw = blockIdx.x * 4 + (threadIdx.x >> 6), ngw = gridDim.x * 4, lane = threadIdx.x & 63;
    for (int m = gw; m < T; m += ngw) final_norm_row(p.out + (size_t)m * DM, p.in[18], lane);
}

namespace pg8 {
#define PG8_LAS __attribute__((address_space(3)))
constexpr int BM = 256, BK = 64, HALF = 128, HTB = HALF * BK * 2, STAGE_BYTES = 8 * HTB, NXCD = 8, WGM = 8;
__host__ __device__ __forceinline__ int lds_byte(int r, int c) { const int st = (r >> 4) * 2 + (c >> 5), rr = r & 15, cc = c & 31, ob = rr * 64 + cc * 2; return st * 1024 + (ob ^ (((ob >> 9) & 1) << 5)); }
__host__ __device__ __forceinline__ void stage_rc(int b, int& R, int& C) { const int st = b / 1024, sb = b % 1024, swz = sb ^ (((sb >> 9) & 1) << 5); R = (st >> 1) * 16 + swz / 64; C = (st & 1) * 32 + (swz % 64) / 2; }
__host__ __device__ __forceinline__ int perm32(int rho) { const int n = rho >> 4, i = rho & 15; return 8 * (i >> 2) + 4 * n + (i & 3); }
struct Unit { int pm, pn; };
struct StaticOrder {
    int nM, nN, nwg, G, c;
    __device__ void init(int nM_, int nN_, int G_, int c_) { nM = nM_; nN = nN_; nwg = nM * nN; G = G_; c = c_; }
    __device__ bool next(int i, Unit& u) const {
        const long L = (long)i * G + c; if (L >= nwg) return false;
        int wgid = (int)L; { const int q = nwg / NXCD, r = nwg % NXCD, xcd = wgid % NXCD, off = wgid / NXCD; wgid = (xcd < r ? xcd * (q + 1) : r * (q + 1) + (xcd - r) * q) + off; }
        const int nig = WGM * nN, gid = wgid / nig, fm = gid * WGM, gsz = (nM - fm) < WGM ? (nM - fm) : WGM;
        u.pm = fm + ((wgid % nig) % gsz); u.pn = (wgid % nig) / gsz; return true;
    }
};
struct ProbDense { const bf16* A; const bf16* Bt; int K; static constexpr bool GATHER = false;
    __device__ __forceinline__ const char* a_tile(const Unit& u) const { return (const char*)A + (size_t)u.pm * BM * K * 2; }
    __device__ __forceinline__ const char* b_tile(const Unit& u) const { return (const char*)Bt + (size_t)u.pn * BM * K * 2; }
    __device__ __forceinline__ void a_offsets(const Unit&, const int (&)[2], const int (&)[2], unsigned (&)[2][2]) const {}
};
struct ProbMoeDown { const bf16* A; const bf16* Bt; int K; size_t estride; const unsigned* ctl; int c; static constexpr bool GATHER = false;
    __device__ __forceinline__ const char* a_tile(const Unit& u) const { return (const char*)A + (size_t)u.pm * BM * K * 2; }
    __device__ __forceinline__ const char* b_tile(const Unit& u) const { int e = 0, r0, nr; moe_tile(ctl, c, u.pm, e, r0, nr); return (const char*)Bt + (size_t)e * estride + (size_t)u.pn * BM * K * 2; }
    __device__ __forceinline__ void a_offsets(const Unit&, const int (&)[2], const int (&)[2], unsigned (&)[2][2]) const {}
};
struct ProbMoeGU { const bf16* A; const bf16* Bt; int K; size_t estride; const unsigned* ctl; int c; const int* lists; static constexpr bool GATHER = true;
    __device__ __forceinline__ const char* a_tile(const Unit&) const { return (const char*)A; }
    __device__ __forceinline__ const char* b_tile(const Unit& u) const { int e = 0, r0, nr; moe_tile(ctl, c, u.pm, e, r0, nr); return (const char*)Bt + (size_t)e * estride + (size_t)u.pn * BM * K * 2; }
    __device__ __forceinline__ void a_offsets(const Unit& u, const int (&RA)[2], const int (&CA)[2], unsigned (&off)[2][2]) const {
        int e = 0, r0 = 0, nr = 1; moe_tile(ctl, c, u.pm, e, r0, nr); const int* l = lists + (size_t)(c * 8 + e) * T + r0;
#pragma unroll
        for (int h = 0; h < 2; ++h)
#pragma unroll
            for (int i = 0; i < 2; ++i) { const int r = h * HALF + RA[i]; const int tok = l[r < nr ? r : 0]; off[h][i] = (unsigned)tok * (unsigned)(K * 2) + (unsigned)(CA[i] * 2); }
    }
};

#define PG8_EARGS const f32x4 (&acc)[2][2][4][2], const Unit& u, int wr, int wc, int fr, int fq
__device__ __forceinline__ u32x4 pack8(const f32x4 a, const f32x4 b) { u32x4 w; w.x = pk2(a[0], a[1]); w.y = pk2(a[2], a[3]); w.z = pk2(b[0], b[1]); w.w = pk2(b[2], b[3]); return w; }
__device__ __forceinline__ float quad_rstd(const float* part, int row, int fq) {
    const f32x4 q = *(const f32x4*)(part + (size_t)row * 16 + 4 * fq); float s = (q[0] + q[1]) + (q[2] + q[3]);
    s += __shfl_xor(s, 16); s += __shfl_xor(s, 32); return 1.0f / sqrtf(s * (1.f / DM) + NORM_EPS);
}
struct EpiInEven { static constexpr bool PERM = true; bf16* O; const float2* rope;
    __device__ __forceinline__ void operator()(PG8_EARGS) const {
        const int pn = u.pn, row0 = u.pm * BM + wr * 64 + fr, colb = pn * BM + wc * 32 + 8 * fq;
        const bool rot = pn < 4; const float sc = (pn == 2 || pn == 3) ? 0.125f : ((pn == 8 || pn == 9) ? C2 : 1.f);
#pragma unroll
        for (int ai = 0; ai < 2; ++ai)
#pragma unroll
            for (int m = 0; m < 4; ++m) { const int row = row0 + ai * HALF + m * 16;
                f32x4 cs0 = {1.f, 0.f, 1.f, 0.f}, cs1 = {1.f, 0.f, 1.f, 0.f};
                if (rot) { const f32x4* rp = (const f32x4*)(rope + (size_t)(row & (SEQ - 1)) * 32 + 16 * (wc & 1) + 4 * fq); cs0 = rp[0]; cs1 = rp[1]; }
#pragma unroll
                for (int bj = 0; bj < 2; ++bj) { f32x4 v0 = acc[ai][bj][m][0], v1 = acc[ai][bj][m][1];
                    if (rot) { f32x4 a, b;
                        a[0] = v0[0] * cs0[0] - v0[1] * cs0[1]; a[1] = v0[0] * cs0[1] + v0[1] * cs0[0]; a[2] = v0[2] * cs0[2] - v0[3] * cs0[3]; a[3] = v0[2] * cs0[3] + v0[3] * cs0[2];
                        b[0] = v1[0] * cs1[0] - v1[1] * cs1[1]; b[1] = v1[0] * cs1[1] + v1[1] * cs1[0]; b[2] = v1[2] * cs1[2] - v1[3] * cs1[3]; b[3] = v1[2] * cs1[3] + v1[3] * cs1[2];
                        v0 = a; v1 = b; }
                    v0 = v0 * sc; v1 = v1 * sc;
                    *(u32x4*)(O + (size_t)row * EW + colb + bj * HALF) = pack8(v0, v1); } }
    }
};
struct EpiResid { static constexpr bool PERM = true; const float* resid; float* out; bf16* hb; float* part;
    __device__ __forceinline__ void operator()(PG8_EARGS) const {
        const int row0 = u.pm * BM + wr * 64 + fr, colb = u.pn * BM + wc * 32 + 8 * fq;
#pragma unroll
        for (int ai = 0; ai < 2; ++ai)
#pragma unroll
            for (int m = 0; m < 4; ++m) { const int row = row0 + ai * HALF + m * 16; float ss = 0.f;
#pragma unroll
                for (int bj = 0; bj < 2; ++bj) { const size_t off = (size_t)row * DM + colb + bj * HALF;
                    const f32x4 r0 = *(const f32x4*)(resid + off), r1 = *(const f32x4*)(resid + off + 4);
                    const f32x4 o0 = r0 + acc[ai][bj][m][0], o1 = r1 + acc[ai][bj][m][1];
                    *(f32x4*)(out + off) = o0; *(f32x4*)(out + off + 4) = o1; *(u32x4*)(hb + off) = pack8(o0, o1);
                    ss += (o0[0] * o0[0] + o0[1] * o0[1]) + (o0[2] * o0[2] + o0[3] * o0[3]) + (o1[0] * o1[0] + o1[1] * o1[1]) + (o1[2] * o1[2] + o1[3] * o1[3]); }
                ss += __shfl_xor(ss, 16); ss += __shfl_xor(ss, 32);
                if (fq == 0) part[(size_t)row * 16 + u.pn * 4 + wc] = ss; }
    }
};
struct EpiGU { static constexpr bool PERM = true; bf16* hid; const float* part;
    __device__ __forceinline__ void operator()(PG8_EARGS) const {
        const int row0 = u.pm * BM + wr * 64 + fr, colb = u.pn * HALF + wc * 32 + 8 * fq;
#pragma unroll
        for (int ai = 0; ai < 2; ++ai)
#pragma unroll
            for (int m = 0; m < 4; ++m) { const int row = row0 + ai * HALF + m * 16; const float rs = quad_rstd(part, row, fq);
                f32x4 h0, h1;
#pragma unroll
                for (int e = 0; e < 4; ++e) { h0[e] = silu_f(acc[ai][0][m][0][e] * rs) * (acc[ai][1][m][0][e] * rs); h1[e] = silu_f(acc[ai][0][m][1][e] * rs) * (acc[ai][1][m][1][e] * rs); }
                *(u32x4*)(hid + (size_t)row * DFF + colb) = pack8(h0, h1); }
    }
};
struct EpiInOdd { static constexpr bool PERM = true; bf16* O; const float* part; const float* bias; float* logf;
    __device__ __forceinline__ void operator()(PG8_EARGS) const {
        const int pn = u.pn, row0 = u.pm * BM + wr * 64 + fr, colb = pn * BM + wc * 32 + 8 * fq;
        const float sc = pn < 4 ? C2 : 1.f;
#pragma unroll
        for (int ai = 0; ai < 2; ++ai)
#pragma unroll
            for (int m = 0; m < 4; ++m) { const int row = row0 + ai * HALF + m * 16; const float rs = quad_rstd(part, row, fq);
                if (pn < 12) {
#pragma unroll
                    for (int bj = 0; bj < 2; ++bj) *(u32x4*)(O + (size_t)row * QKVW + colb + bj * HALF) = pack8(acc[ai][bj][m][0] * (rs * sc), acc[ai][bj][m][1] * (rs * sc));
                } else if (wc == 0 && fq < 2) {
#pragma unroll
                    for (int n = 0; n < 2; ++n)
#pragma unroll
                        for (int e = 0; e < 4; ++e) { const int h = 8 * fq + 4 * n + e; const float z = acc[ai][0][m][n][e] * rs + bias[h];
                            logf[((size_t)(row >> 12) * 16 + h) * SEQ + (row & (SEQ - 1))] = fminf(z, 0.f) - log1pf(__expf(-fabsf(z))); }
                } }
    }
};
struct EpiMoeGU { static constexpr bool PERM = true; bf16* hid; const float* rstd4; const unsigned* ctl; int c; const int* lists;
    __device__ __forceinline__ void operator()(PG8_EARGS) const {
        int e = 0, r0 = 0, nr = 1; moe_tile(ctl, c, u.pm, e, r0, nr); const int* l = lists + (size_t)(c * 8 + e) * T + r0;
        const int rl0 = wr * 64 + fr, colb = u.pn * HALF + wc * 32 + 8 * fq;
#pragma unroll
        for (int ai = 0; ai < 2; ++ai)
#pragma unroll
            for (int m = 0; m < 4; ++m) { const int rl = rl0 + ai * HALF + m * 16; const float rs = rstd4[l[rl < nr ? rl : 0]];
                f32x4 h0, h1;
#pragma unroll
                for (int x = 0; x < 4; ++x) { h0[x] = silu_f(acc[ai][0][m][0][x] * rs) * (acc[ai][1][m][0][x] * rs); h1[x] = silu_f(acc[ai][0][m][1][x] * rs) * (acc[ai][1][m][1][x] * rs); }
                *(u32x4*)(hid + (size_t)(u.pm * BM + rl) * DFF + colb) = pack8(h0, h1); }
    }
};
struct EpiMoeDown { static constexpr bool PERM = true; float* out; const unsigned* ctl; int c; const int* lists; const float* gates;
    __device__ __forceinline__ void operator()(PG8_EARGS) const {
        int e = 0, r0 = 0, nr = 0; moe_tile(ctl, c, u.pm, e, r0, nr); const int* l = lists + (size_t)(c * 8 + e) * T + r0; const float* g = gates + (size_t)(c * 8 + e) * T + r0;
        const int rl0 = wr * 64 + fr, colb = u.pn * BM + wc * 32 + 8 * fq;
#pragma unroll
        for (int ai = 0; ai < 2; ++ai)
#pragma unroll
            for (int m = 0; m < 4; ++m) { const int rl = rl0 + ai * HALF + m * 16;
                if (rl < nr) { const int tok = l[rl]; const float gt = g[rl];
#pragma unroll
                    for (int bj = 0; bj < 2; ++bj) { float* o = out + (size_t)tok * DM + colb + bj * HALF;
                        const f32x4 a = *(const f32x4*)o, b = *(const f32x4*)(o + 4);
                        *(f32x4*)o = a + acc[ai][bj][m][0] * gt; *(f32x4*)(o + 4) = b + acc[ai][bj][m][1] * gt; } } }
    }
};

template <class Prob, class Epi, class Sched>
__device__ __forceinline__ void gemm_phase(PG8_LAS unsigned char* lds, const Prob& P, const Sched& S, const Epi& E) {
    const int tid = threadIdx.x, wid = __builtin_amdgcn_readfirstlane(tid >> 6), lane = tid & 63, wr = wid >> 2, wc = wid & 3, fr = lane & 15, fq = lane >> 4;
    const int K = P.K, nt = K / BK;
    unsigned voffA[2], voffB[2]; int RA[2], CA[2];
#pragma unroll
    for (int i = 0; i < 2; ++i) { int R, C; stage_rc(tid * 16 + i * 8192, R, C); const int Rb = Epi::PERM ? ((R & ~31) + perm32(R & 31)) : R;
        voffA[i] = (unsigned)(R * K + C) * 2u; voffB[i] = (unsigned)(Rb * K + C) * 2u; RA[i] = R; CA[i] = C; }
    const size_t kstep = (size_t)(BK * 2);
    const size_t hstep = (size_t)HALF * K * 2;
    const unsigned ldsw = (unsigned)wid * 1024u;
    const int aoff = lds_byte(wr * 64 + fr, fq * 8), boff = lds_byte(wc * 32 + fr, fq * 8);
    unsigned offC[2][2] = {{0u, 0u}, {0u, 0u}}, offN[2][2] = {{0u, 0u}, {0u, 0u}};
#define PG8_SA(b, h) (((b) * 2 + (h)) * HTB)
#define PG8_SB(b, h) ((4 + (b) * 2 + (h)) * HTB)
#define PG8_STAGE(bufoff, gbase, voff) do { _Pragma("unroll") for (int _i = 0; _i < 2; ++_i) \
        __builtin_amdgcn_global_load_lds((const unsigned*)((const char*)(gbase) + (voff)[_i]), (PG8_LAS unsigned*)(lds + (bufoff) + ldsw + _i * 8192), 16, 0, 0); } while (0)
#define PG8_STAGE_A(bufoff, gbase, h, nx) do { _Pragma("unroll") for (int _i = 0; _i < 2; ++_i) { \
        const size_t _o = Prob::GATHER ? (size_t)((nx) ? offN[h][_i] : offC[h][_i]) : (size_t)voffA[_i] + (size_t)(h) * hstep; \
        __builtin_amdgcn_global_load_lds((const unsigned*)((const char*)(gbase) + _o), (PG8_LAS unsigned*)(lds + (bufoff) + ldsw + _i * 8192), 16, 0, 0); } } while (0)
#define PG8_LDA(dst, b, h) do { _Pragma("unroll") for (int m = 0; m < 4; ++m) _Pragma("unroll") for (int k = 0; k < 2; ++k) dst[m][k] = *(const PG8_LAS bf16x8*)(lds + PG8_SA(b, h) + aoff + m * 2048 + k * 1024); } while (0)
#define PG8_LDB(dst, b, h) do { _Pragma("unroll") for (int n = 0; n < 2; ++n) _Pragma("unroll") for (int k = 0; k < 2; ++k) dst[n][k] = *(const PG8_LAS bf16x8*)(lds + PG8_SB(b, h) + boff + n * 2048 + k * 1024); } while (0)
#define PG8_MMA(ai, bj, At, Bt) do { __builtin_amdgcn_s_setprio(1); _Pragma("unroll") for (int m = 0; m < 4; ++m) _Pragma("unroll") for (int n = 0; n < 2; ++n) _Pragma("unroll") for (int k = 0; k < 2; ++k) \
        acc[ai][bj][m][n] = __builtin_amdgcn_mfma_f32_16x16x32_bf16(Bt[n][k], At[m][k], acc[ai][bj][m][n], 0, 0, 0); __builtin_amdgcn_s_setprio(0); } while (0)
#define PG8_WAIT_V(n) asm volatile("s_waitcnt vmcnt(" #n ")" ::: "memory")
#define PG8_WAIT_L(n) asm volatile("s_waitcnt lgkmcnt(" #n ")" ::: "memory")
#define PG8_BAR __builtin_amdgcn_s_barrier()
#define PG8_SCHED __builtin_amdgcn_sched_barrier(0)
    Unit cur, nxt; int ui = 0;
    if (!S.next(0, cur)) return;
    f32x4 acc[2][2][4][2];
#pragma unroll
    for (int a = 0; a < 2; ++a)
#pragma unroll
        for (int b = 0; b < 2; ++b)
#pragma unroll
            for (int m = 0; m < 4; ++m)
#pragma unroll
                for (int n = 0; n < 2; ++n) acc[a][b][m][n] = (f32x4){0.f, 0.f, 0.f, 0.f};
    bf16x8 At[4][2], B0[2][2], B1[2][2];
    const char* cA = P.a_tile(cur); const char* cB = P.b_tile(cur);
    if constexpr (Prob::GATHER) P.a_offsets(cur, RA, CA, offC);
    PG8_STAGE(PG8_SB(0, 0), cB, voffB); PG8_STAGE(PG8_SB(0, 1), cB + hstep, voffB); PG8_STAGE_A(PG8_SA(0, 0), cA, 0, false); PG8_STAGE_A(PG8_SA(0, 1), cA, 1, false);
    if (wr == 1) PG8_BAR;
    PG8_WAIT_V(2); PG8_BAR;
    PG8_STAGE(PG8_SB(1, 0), cB + kstep, voffB); PG8_STAGE_A(PG8_SA(1, 0), cA + kstep, 0, false); PG8_STAGE(PG8_SB(1, 1), cB + hstep + kstep, voffB);
    PG8_WAIT_V(6); PG8_BAR;
    for (;;) {
        const bool has_next = S.next(ui + 1, nxt);
        const char* nA = has_next ? P.a_tile(nxt) : cA; const char* nB = has_next ? P.b_tile(nxt) : cB;
        if constexpr (Prob::GATHER) { if (has_next) P.a_offsets(nxt, RA, CA, offN); else {
#pragma unroll
            for (int h = 0; h < 2; ++h)
#pragma unroll
                for (int i = 0; i < 2; ++i) offN[h][i] = offC[h][i]; } }
        for (int t = 0; t < nt; t += 2) {
            const bool last = (t == nt - 2);
            const char* a1 = cA + (size_t)(t + 1) * kstep;
            const char* a2 = last ? nA : cA + (size_t)(t + 2) * kstep; const char* b2 = last ? nB : cB + (size_t)(t + 2) * kstep;
            const char* a3 = a2 + kstep; const char* b3 = b2 + kstep;
            PG8_LDB(B0, 0, 0); PG8_LDB(B1, 0, 1); PG8_SCHED; PG8_LDA(At, 0, 0); PG8_STAGE_A(PG8_SA(1, 1), a1, 1, false);
            PG8_WAIT_V(8); PG8_WAIT_L(0); PG8_BAR; PG8_MMA(0, 0, At, B0); PG8_MMA(0, 1, At, B1); PG8_BAR; PG8_SCHED;
            PG8_LDA(At, 0, 1); PG8_STAGE(PG8_SB(0, 0), b2, voffB); PG8_STAGE(PG8_SB(0, 1), b2 + hstep, voffB); PG8_STAGE_A(PG8_SA(0, 0), a2, 0, last);
            PG8_WAIT_V(8); PG8_WAIT_L(0); PG8_BAR; PG8_MMA(1, 0, At, B0); PG8_MMA(1, 1, At, B1); PG8_BAR; PG8_SCHED;
            PG8_LDB(B0, 1, 0); PG8_LDB(B1, 1, 1); PG8_SCHED; PG8_LDA(At, 1, 0); PG8_STAGE_A(PG8_SA(0, 1), a2, 1, last);
            PG8_WAIT_V(8); PG8_WAIT_L(0); PG8_BAR; PG8_MMA(0, 0, At, B0); PG8_MMA(0, 1, At, B1); PG8_BAR; PG8_SCHED;
            PG8_LDA(At, 1, 1); PG8_STAGE(PG8_SB(1, 0), b3, voffB); PG8_STAGE(PG8_SB(1, 1), b3 + hstep, voffB); PG8_STAGE_A(PG8_SA(1, 0), a3, 0, last);
            PG8_WAIT_V(8); PG8_WAIT_L(0); PG8_BAR; PG8_MMA(1, 0, At, B0); PG8_MMA(1, 1, At, B1); PG8_BAR; PG8_SCHED;
        }
        if (wr == 0) PG8_BAR;
        E(acc, cur, wr, wc, fr, fq);
        if (!has_next) break;
#pragma unroll
        for (int a = 0; a < 2; ++a)
#pragma unroll
            for (int b = 0; b < 2; ++b)
#pragma unroll
                for (int m = 0; m < 4; ++m)
#pragma unroll
                    for (int n = 0; n < 2; ++n) acc[a][b][m][n] = (f32x4){0.f, 0.f, 0.f, 0.f};
        cur = nxt; cA = nA; cB = nB; ++ui;
        if constexpr (Prob::GATHER) {
#pragma unroll
            for (int h = 0; h < 2; ++h)
#pragma unroll
                for (int i = 0; i < 2; ++i) offC[h][i] = offN[h][i]; }
        if (wr == 1) PG8_BAR;
    }
    PG8_WAIT_V(0);
    PG8_BAR;
#undef PG8_SA
#undef PG8_SB
#undef PG8_STAGE
#undef PG8_STAGE_A
#undef PG8_LDA
#undef PG8_LDB
#undef PG8_MMA
#undef PG8_WAIT_V
#undef PG8_WAIT_L
#undef PG8_BAR
#undef PG8_SCHED
}
}
namespace att {
#define ALAS __attribute__((address_space(3)))
typedef _Float16 f16x8 __attribute__((ext_vector_type(8)));
typedef short s16x4 __attribute__((ext_vector_type(4)));
typedef short v4i16_t __attribute__((ext_vector_type(4)));
constexpr int KSTR = 144, VSTR = 192;
constexpr int KT_BYTES = 64 * KSTR, VT_BYTES = 64 * VSTR, STAGE = KT_BYTES + VT_BYTES;
constexpr int FLAG_OFF = 2 * STAGE;
constexpr int CUM_OFF = 49152;
constexpr float EXIT_T = -152.0f;
__device__ __forceinline__ int crow(int r, int hi) { return (r & 3) + 8 * (r >> 2) + 4 * hi; }
__device__ __forceinline__ bf16x8 vtr2(const ALAS unsigned char* p0, const ALAS unsigned char* p1) {
    const s16x4 a = __builtin_bit_cast(s16x4, __builtin_amdgcn_ds_read_tr16_b64_v4i16((ALAS v4i16_t*)p0));
    const s16x4 b = __builtin_bit_cast(s16x4, __builtin_amdgcn_ds_read_tr16_b64_v4i16((ALAS v4i16_t*)p1));
    return (bf16x8){a[0], a[1], a[2], a[3], b[0], b[1], b[2], b[3]};
}
__device__ __forceinline__ bf16x8 packbf8(const f32x16& p, int b) { u32x4 w; w.x = pk2(p[b], p[b + 1]); w.y = pk2(p[b + 2], p[b + 3]); w.z = pk2(p[b + 4], p[b + 5]); w.w = pk2(p[b + 6], p[b + 7]); return __builtin_bit_cast(bf16x8, w); }
__device__ __forceinline__ f16x8 packh8(const f32x16& p, int b) { f16x8 h;
#pragma unroll
    for (int j = 0; j < 8; ++j) h[j] = (_Float16)p[b + j];
    return h; }
__device__ __forceinline__ void pv_tile(f32x16 (&o)[2], const ALAS unsigned char* vb, int vl, const bf16x8 (&pb)[4]) {
#pragma unroll
    for (int dh = 0; dh < 2; ++dh)
#pragma unroll
        for (int s = 0; s < 4; ++s) { const ALAS unsigned char* a = vb + vl + (16 * s) * VSTR + dh * 64;
            o[dh] = __builtin_amdgcn_mfma_f32_32x32x16_bf16(vtr2(a, a + 8 * VSTR), pb[s], o[dh], 0, 0, 0); }
}
template <int MODE>
__device__ __forceinline__ void unit(ALAS unsigned char* lds, const bf16* Q, const bf16* K, const bf16* V, int pitch, bf16* O, size_t rowbase, int q0, const ALAS float* cum2) {
    const int tid = threadIdx.x, lane = tid & 63, r32 = lane & 31, hi = lane >> 5, wid = __builtin_amdgcn_readfirstlane(tid >> 6);
    const int R0 = q0 + 32 * wid, qrow = R0 + r32;
    bf16x8 qr[4];
#pragma unroll
    for (int d0 = 0; d0 < 4; ++d0) qr[d0] = *(const bf16x8*)(Q + (rowbase + qrow) * pitch + 16 * d0 + 8 * hi);
    const int srow = tid >> 3, sch = tid & 7;
    const bf16* kg = K + (rowbase + srow) * pitch + sch * 8; const bf16* vg = V + (rowbase + srow) * pitch + sch * 8;
    const int kdst = srow * KSTR + sch * 16, vdst = KT_BYTES + srow * VSTR + sch * 16;
    const int kl = r32 * KSTR + 16 * hi;
    const int vl = (4 * hi + ((lane & 15) >> 2)) * VSTR + (16 * ((lane >> 4) & 1) + 4 * (lane & 3)) * 2;
    ALAS unsigned* flags = (ALAS unsigned*)(lds + FLAG_OFF);
    const int jtop = (q0 >> 6) + 3;
    u32x4 kreg = *(const u32x4*)(kg + (size_t)jtop * 64 * pitch), vreg = *(const u32x4*)(vg + (size_t)jtop * 64 * pitch);
    *(ALAS u32x4*)(lds + kdst) = kreg; *(ALAS u32x4*)(lds + vdst) = vreg;
    __syncthreads();
    f32x16 o[2];
#pragma unroll
    for (int r = 0; r < 16; ++r) { o[0][r] = 0.f; o[1][r] = 0.f; }
    float carry = 0.f, m = -INFINITY, l = 0.f;
    const float cq = (MODE == 1) ? cum2[qrow] : 0.f;
    f16x8 M0, M1, ONES;
#pragma unroll
    for (int j = 0; j < 8; ++j) { const int kk = 8 * (j >> 2) + 4 * hi + (j & 3); M0[j] = (kk > r32) ? (_Float16)1.f : (_Float16)0.f; M1[j] = (16 + kk > r32) ? (_Float16)1.f : (_Float16)0.f; ONES[j] = (_Float16)1.f; }
    int cur = 0;
    for (int j = jtop; j >= 0; --j) {
        const bool more = j > 0;
        if (more) { kreg = *(const u32x4*)(kg + (size_t)(j - 1) * 64 * pitch); vreg = *(const u32x4*)(vg + (size_t)(j - 1) * 64 * pitch); }
        const ALAS unsigned char* kb = lds + cur * STAGE; const ALAS unsigned char* vb = kb + KT_BYTES;
        const int key0 = 64 * j;
        if (key0 <= R0 + 31) {
            const bool diag = key0 + 63 >= R0;
            f32x16 p0, p1;
#pragma unroll
            for (int r = 0; r < 16; ++r) { p0[r] = 0.f; p1[r] = 0.f; }
#pragma unroll
            for (int d0 = 0; d0 < 4; ++d0) { const bf16x8 ka = *(const ALAS bf16x8*)(kb + kl + 32 * d0), kc = *(const ALAS bf16x8*)(kb + kl + 32 * KSTR + 32 * d0);
                p0 = __builtin_amdgcn_mfma_f32_32x32x16_bf16(ka, qr[d0], p0, 0, 0, 0); p1 = __builtin_amdgcn_mfma_f32_32x32x16_bf16(kc, qr[d0], p1, 0, 0, 0); }
            bf16x8 pb[4];
            if (MODE == 0) {
                f32x16 l0, l1; float rs = 0.f;
#pragma unroll
                for (int r = 0; r < 16; ++r) { const int key = key0 + crow(r, hi);
                    float a = -softplus2(p0[r]), b = -softplus2(p1[r]);
                    if (diag) { if (!(key < qrow)) a = 0.f; if (!(key + 32 < qrow)) b = 0.f; }
                    l0[r] = a; l1[r] = b; rs += a + b; }
                rs += __shfl_xor(rs, 32);
                const f16x8 lb0 = packh8(l0, 0), lb1 = packh8(l0, 8), lb2 = packh8(l1, 0), lb3 = packh8(l1, 8);
                f32x16 c0, c1;
#pragma unroll
                for (int r = 0; r < 16; ++r) { c0[r] = carry; c1[r] = carry; }
                c0 = __builtin_amdgcn_mfma_f32_32x32x16_f16(M0, lb0, c0, 0, 0, 0); c0 = __builtin_amdgcn_mfma_f32_32x32x16_f16(M1, lb1, c0, 0, 0, 0);
                c0 = __builtin_amdgcn_mfma_f32_32x32x16_f16(ONES, lb2, c0, 0, 0, 0); c0 = __builtin_amdgcn_mfma_f32_32x32x16_f16(ONES, lb3, c0, 0, 0, 0);
                c1 = __builtin_amdgcn_mfma_f32_32x32x16_f16(M0, lb2, c1, 0, 0, 0); c1 = __builtin_amdgcn_mfma_f32_32x32x16_f16(M1, lb3, c1, 0, 0, 0);
#pragma unroll
                for (int r = 0; r < 16; ++r) { const int key = key0 + crow(r, hi);
                    float a = __builtin_amdgcn_exp2f(p0[r] + l0[r] + c0[r]), b = __builtin_amdgcn_exp2f(p1[r] + l1[r] + c1[r]);
                    if (diag) { if (!(key < qrow)) a = 0.f; if (!(key + 32 < qrow)) b = 0.f; }
                    p0[r] = a; p1[r] = b; }
                carry += rs;
            } else {
#pragma unroll
                for (int g = 0; g < 4; ++g) { const f32x4 cb0 = *(const ALAS f32x4*)(cum2 + key0 + 8 * g + 4 * hi), cb1 = *(const ALAS f32x4*)(cum2 + key0 + 32 + 8 * g + 4 * hi);
#pragma unroll
                    for (int e = 0; e < 4; ++e) { p0[4 * g + e] = (p0[4 * g + e] + cq) - cb0[e]; p1[4 * g + e] = (p1[4 * g + e] + cq) - cb1[e]; } }
                if (diag) {
#pragma unroll
                    for (int r = 0; r < 16; ++r) { const int key = key0 + crow(r, hi); if (key > qrow) p0[r] = -INFINITY; if (key + 32 > qrow) p1[r] = -INFINITY; } }
                float mt = fmaxf(p0[0], p1[0]);
#pragma unroll
                for (int r = 1; r < 16; ++r) mt = fmaxf(mt, fmaxf(p0[r], p1[r]));
                mt = fmaxf(mt, __shfl_xor(mt, 32));
                if (__any(mt > m)) { const float mn = fmaxf(m, mt); const float f = __builtin_amdgcn_exp2f(m - mn); l *= f; o[0] = o[0] * f; o[1] = o[1] * f; m = mn; }
                float ls = 0.f;
#pragma unroll
                for (int r = 0; r < 16; ++r) { p0[r] = __builtin_amdgcn_exp2f(p0[r] - m); p1[r] = __builtin_amdgcn_exp2f(p1[r] - m); ls += p0[r] + p1[r]; }
                l += ls;
            }
            pb[0] = packbf8(p0, 0); pb[1] = packbf8(p0, 8); pb[2] = packbf8(p1, 0); pb[3] = packbf8(p1, 8);
            pv_tile(o, vb, vl, pb);
        }
        if (more) { *(ALAS u32x4*)(lds + (cur ^ 1) * STAGE + kdst) = kreg; *(ALAS u32x4*)(lds + (cur ^ 1) * STAGE + vdst) = vreg; }
        if (MODE == 0) { const bool done = __all(carry < EXIT_T); if (lane == 0) flags[cur * 8 + wid] = done ? 1u : 0u; }
        __syncthreads();
        if (MODE == 0) { unsigned a = 1u;
#pragma unroll
            for (int w = 0; w < 8; ++w) a &= flags[cur * 8 + w];
            if (a) break; }
        cur ^= 1;
    }
    float inv = 1.f;
    if (MODE == 1) { l += __shfl_xor(l, 32); inv = 1.0f / l; }
    bf16* orow = O + (rowbase + qrow) * DM;
#pragma unroll
    for (int dh = 0; dh < 2; ++dh)
#pragma unroll
        for (int g = 0; g < 4; ++g) { u32x2 w; w.x = pk2(o[dh][4 * g] * inv, o[dh][4 * g + 1] * inv); w.y = pk2(o[dh][4 * g + 2] * inv, o[dh][4 * g + 3] * inv);
            *(u32x2*)(orow + 32 * dh + 8 * g + 4 * hi) = w; }
    __syncthreads();
}
__device__ __forceinline__ void fox_cum(ALAS float* cum2, const float* lf) {
    const int tid = threadIdx.x, lane = tid & 63, wid = tid >> 6;
    ALAS float* wtot = cum2 + 4096;
    const f32x4 a = *(const f32x4*)(lf + tid * 8), b = *(const f32x4*)(lf + tid * 8 + 4);
    float v[8] = {a[0], a[1], a[2], a[3], b[0], b[1], b[2], b[3]};
#pragma unroll
    for (int i = 1; i < 8; ++i) v[i] += v[i - 1];
    float inc = v[7];
#pragma unroll
    for (int o = 1; o < 64; o <<= 1) { const float n = __shfl_up(inc, o); if (lane >= o) inc += n; }
    if (lane == 63) wtot[wid] = inc;
    __syncthreads();
    float base = inc - v[7];
    for (int w = 0; w < wid; ++w) base += wtot[w];
#pragma unroll
    for (int i = 0; i < 8; ++i) cum2[tid * 8 + i] = (v[i] + base) * LOG2E;
    __syncthreads();
}

constexpr int RSTR = 192;
__device__ __forceinline__ void ret_pass_a(ALAS unsigned char* lds, const bf16* P  , float* loc, float* grp, int bh, int g) {
    const int tid = threadIdx.x, lane = tid & 63, r32 = lane & 31, hi = lane >> 5, wid = __builtin_amdgcn_readfirstlane(tid >> 6);
    const int b = bh >> 3, h = bh & 7; const size_t rowbase = (size_t)b * SEQ;
    const float lg2 = log2f(1.0f - exp2f(-5.0f - (float)h)); const float cd = exp2f(128.f * lg2);
    ALAS unsigned char* kt = lds; ALAS unsigned char* vt = lds + 128 * RSTR;
    const int eh = wid >> 1, dh = wid & 1;
    const int tl = (4 * hi + ((lane & 15) >> 2)) * RSTR + (16 * ((lane >> 4) & 1) + 4 * (lane & 3)) * 2;
    f32x16 R;
#pragma unroll
    for (int r = 0; r < 16; ++r) R[r] = 0.f;
    for (int j = 0; j < 4; ++j) { const int n = 4 * g + j; const size_t tok0 = rowbase + (size_t)n * 128;
#pragma unroll
        for (int i = 0; i < 2; ++i) { const int idx = tid + 512 * i, row = idx >> 3, ch = idx & 7;
            const u32x4 kk = *(const u32x4*)(P + (tok0 + row) * EW + 512 + h * 64 + ch * 8), vv = *(const u32x4*)(P + (tok0 + row) * EW + 1024 + h * 64 + ch * 8);
            const float dk = exp2f((float)(127 - row) * lg2); u32x4 kd;
            kd.x = pk2(bf2f(kk.x & 0xffff) * dk, bf2f(kk.x >> 16) * dk); kd.y = pk2(bf2f(kk.y & 0xffff) * dk, bf2f(kk.y >> 16) * dk);
            kd.z = pk2(bf2f(kk.z & 0xffff) * dk, bf2f(kk.z >> 16) * dk); kd.w = pk2(bf2f(kk.w & 0xffff) * dk, bf2f(kk.w >> 16) * dk);
            *(ALAS u32x4*)(kt + row * RSTR + ch * 16) = kd; *(ALAS u32x4*)(vt + row * RSTR + ch * 16) = vv; }
        __syncthreads();
        if (wid < 4) {
            float* lo = loc + ((size_t)bh * 32 + n) * 4096;
#pragma unroll
            for (int r = 0; r < 16; ++r) lo[(32 * eh + crow(r, hi)) * 64 + 32 * dh + r32] = R[r];
            R = R * cd;
#pragma unroll
            for (int s = 0; s < 8; ++s) { const ALAS unsigned char* va = vt + tl + (16 * s) * RSTR + eh * 64; const ALAS unsigned char* ka = kt + tl + (16 * s) * RSTR + dh * 64;
                R = __builtin_amdgcn_mfma_f32_32x32x16_bf16(vtr2(va, va + 8 * RSTR), vtr2(ka, ka + 8 * RSTR), R, 0, 0, 0); }
        }
        __syncthreads();
    }
    if (wid < 4) { float* go = grp + ((size_t)bh * 8 + g) * 4096;
#pragma unroll
        for (int r = 0; r < 16; ++r) go[(32 * eh + crow(r, hi)) * 64 + 32 * dh + r32] = R[r]; }
}
constexpr int RB_Q = 0, RB_K = 128 * KSTR, RB_G = 2 * 128 * KSTR, RB_V = 3 * 128 * KSTR, RB_S = RB_V + 128 * RSTR, RB_RED = RB_S + 64 * KSTR;
__device__ __forceinline__ void ret_pass_b(ALAS unsigned char* lds, const bf16* P, const float* loc, const float* grp, const float* retnorm, bf16* Y, int bh, int n) {
    const int tid = threadIdx.x, lane = tid & 63, r32 = lane & 31, hi = lane >> 5, wid = __builtin_amdgcn_readfirstlane(tid >> 6);
    const int b = bh >> 3, h = bh & 7; const size_t tok0 = (size_t)b * SEQ + (size_t)n * 128;
    const float lg2 = log2f(1.0f - exp2f(-5.0f - (float)h)); const float cd = exp2f(128.f * lg2), cd4 = exp2f(512.f * lg2);
    const int g = n >> 2, j = n & 3;
    { const int e = tid >> 3, d0 = (tid & 7) * 8; const size_t off = (size_t)e * 64 + d0;
      f32x4 s0 = {0.f, 0.f, 0.f, 0.f}, s1 = {0.f, 0.f, 0.f, 0.f};
      for (int gp = 0; gp < g; ++gp) { const float* gs = grp + ((size_t)bh * 8 + gp) * 4096 + off; s0 = s0 * cd4 + *(const f32x4*)gs; s1 = s1 * cd4 + *(const f32x4*)(gs + 4); }
      const float cj = exp2f(128.f * (float)j * lg2); const float* lo = loc + ((size_t)bh * 32 + n) * 4096 + off;
      s0 = s0 * cj + *(const f32x4*)lo; s1 = s1 * cj + *(const f32x4*)(lo + 4);
      u32x4 w; w.x = pk2(s0[0], s0[1]); w.y = pk2(s0[2], s0[3]); w.z = pk2(s1[0], s1[1]); w.w = pk2(s1[2], s1[3]);
      *(ALAS u32x4*)(lds + RB_S + e * KSTR + d0 * 2) = w; }
#pragma unroll
    for (int i = 0; i < 2; ++i) { const int idx = tid + 512 * i, row = idx >> 3, ch = idx & 7; const bf16* src = P + (tok0 + row) * EW + h * 64 + ch * 8;
        *(ALAS u32x4*)(lds + RB_Q + row * KSTR + ch * 16) = *(const u32x4*)src; *(ALAS u32x4*)(lds + RB_K + row * KSTR + ch * 16) = *(const u32x4*)(src + 512);
        *(ALAS u32x4*)(lds + RB_V + row * RSTR + ch * 16) = *(const u32x4*)(src + 1024); *(ALAS u32x4*)(lds + RB_G + row * KSTR + ch * 16) = *(const u32x4*)(src + 1536); }
    __syncthreads();
    const int qb = wid & 3, eh = wid >> 2, qloc = 32 * qb + r32;
    const int tl = (4 * hi + ((lane & 15) >> 2)) * RSTR + (16 * ((lane >> 4) & 1) + 4 * (lane & 3)) * 2;
    bf16x8 qf[4];
#pragma unroll
    for (int d0 = 0; d0 < 4; ++d0) qf[d0] = *(const ALAS bf16x8*)(lds + RB_Q + qloc * KSTR + 32 * d0 + 16 * hi);
    float dloc[16];
#pragma unroll
    for (int r = 0; r < 16; ++r) dloc[r] = exp2f((float)(r32 - crow(r, hi)) * lg2);
    f32x16 ain, acr;
#pragma unroll
    for (int r = 0; r < 16; ++r) { ain[r] = 0.f; acr[r] = 0.f; }
    for (int kt = 0; kt <= qb; ++kt) {
        f32x16 s;
#pragma unroll
        for (int r = 0; r < 16; ++r) s[r] = 0.f;
#pragma unroll
        for (int d0 = 0; d0 < 4; ++d0) s = __builtin_amdgcn_mfma_f32_32x32x16_bf16(*(const ALAS bf16x8*)(lds + RB_K + (32 * kt + r32) * KSTR + 32 * d0 + 16 * hi), qf[d0], s, 0, 0, 0);
        const float fac = exp2f(32.f * (float)(qb - kt) * lg2);
#pragma unroll
        for (int r = 0; r < 16; ++r) { float v = s[r] * (dloc[r] * fac); if (kt == qb && crow(r, hi) > r32) v = 0.f; s[r] = v; }
        const bf16x8 pb0 = packbf8(s, 0), pb1 = packbf8(s, 8);
        const ALAS unsigned char* va = lds + RB_V + tl + (32 * kt) * RSTR + eh * 64;
        ain = __builtin_amdgcn_mfma_f32_32x32x16_bf16(vtr2(va, va + 8 * RSTR), pb0, ain, 0, 0, 0);
        ain = __builtin_amdgcn_mfma_f32_32x32x16_bf16(vtr2(va + 16 * RSTR, va + 24 * RSTR), pb1, ain, 0, 0, 0);
    }
#pragma unroll
    for (int d0 = 0; d0 < 4; ++d0) acr = __builtin_amdgcn_mfma_f32_32x32x16_bf16(*(const ALAS bf16x8*)(lds + RB_S + (32 * eh + r32) * KSTR + 32 * d0 + 16 * hi), qf[d0], acr, 0, 0, 0);
    const float qd = exp2f((float)(qloc + 1) * lg2);
    float s1 = 0.f, s2 = 0.f;
#pragma unroll
    for (int r = 0; r < 16; ++r) { const float v = ain[r] + qd * acr[r]; ain[r] = v; s1 += v; s2 += v * v; }
    s1 += __shfl_xor(s1, 32); s2 += __shfl_xor(s2, 32);
    ALAS float* red = (ALAS float*)(lds + RB_RED);
    if (hi == 0) { red[(wid * 32 + r32) * 2] = s1; red[(wid * 32 + r32) * 2 + 1] = s2; }
    __syncthreads();
    { const int pw = wid ^ 4; s1 += red[(pw * 32 + r32) * 2]; s2 += red[(pw * 32 + r32) * 2 + 1]; }
    const float mu = s1 * (1.f / 64.f); const float var = fmaxf(s2 * (1.f / 64.f) - mu * mu, 0.f); const float rstd = 1.0f / sqrtf(var + GN_EPS);
    bf16* yrow = Y + (tok0 + qloc) * DM + h * 64 + 32 * eh;
#pragma unroll
    for (int gq = 0; gq < 4; ++gq) { const int e0 = 8 * gq + 4 * hi;
        const u32x2 gv = *(const ALAS u32x2*)(lds + RB_G + qloc * KSTR + (32 * eh + e0) * 2); const f32x4 rn = *(const f32x4*)(retnorm + h * 64 + 32 * eh + e0);
        const float g0 = bf2f(gv.x & 0xffff), g1 = bf2f(gv.x >> 16), g2 = bf2f(gv.y & 0xffff), g3 = bf2f(gv.y >> 16);
        u32x2 w; w.x = pk2((ain[4 * gq] - mu) * rstd * rn[0] * silu_f(g0), (ain[4 * gq + 1] - mu) * rstd * rn[1] * silu_f(g1));
        w.y = pk2((ain[4 * gq + 2] - mu) * rstd * rn[2] * silu_f(g2), (ain[4 * gq + 3] - mu) * rstd * rn[3] * silu_f(g3));
        *(u32x2*)(yrow + e0) = w; }
    __syncthreads();
}
#undef ALAS
}
#define LAS __attribute__((address_space(3)))
#define XB_TMO      128
#define XB_XCNT(j)  (256  + 64 * (j))
#define XB_XSUB(j)  (1280 + 64 * (j))
#define XB_XGEN(j)  (2304 + 64 * (j))
#define XB_TOP      3328
#define XB_TOPGEN   3392
#define XCD_BAR_WORDS 3456
#define XB_SPIN_CAP (1u << 23)
__device__ __forceinline__ unsigned xb_ld(unsigned* p)              { return __hip_atomic_load(p, __ATOMIC_RELAXED, __HIP_MEMORY_SCOPE_AGENT); }
__device__ __forceinline__ unsigned xb_add(unsigned* p, unsigned v) { return __hip_atomic_fetch_add(p, v, __ATOMIC_RELAXED, __HIP_MEMORY_SCOPE_AGENT); }
__device__ __forceinline__ unsigned xb_xcc_id() { return (unsigned)__builtin_amdgcn_s_getreg((3 << 11) | 20) & 0xFu; }
#define XB_SPIN(cond, bar) do { unsigned _sp = 0; while (cond) { __builtin_amdgcn_s_sleep(1); \
    if ((++_sp & 255u) == 0u) { if (xb_ld(&(bar)[XB_TMO])) break; if (_sp > XB_SPIN_CAP) { atomicAdd(&(bar)[XB_TMO], 1u); break; } } } } while (0)
struct XcdBarrier { unsigned* bar; unsigned x; volatile LAS unsigned* st; };
__device__ __forceinline__ XcdBarrier xcd_barrier_post(unsigned* bar, volatile LAS unsigned* st) {
    XcdBarrier b; b.bar = bar; b.x = xb_xcc_id(); b.st = st;
    if (threadIdx.x == 0) (void)xb_add(&bar[XB_XCNT(b.x)], 1u);
    return b;
}
__device__ __forceinline__ void xcd_barrier_complete(unsigned* bar, unsigned x, unsigned& nloc, unsigned& nx) {
    const unsigned G = gridDim.x * gridDim.y * gridDim.z;
    unsigned sum, cnt, mine, sp = 0u;
    for (;;) {
        sum = 0u; cnt = 0u; mine = 0u;
#pragma unroll
        for (unsigned j = 0; j < 16; ++j) { const unsigned c = xb_ld(&bar[XB_XCNT(j)]); sum += c; cnt += (c > 0u) ? 1u : 0u; mine = (j == x) ? c : mine; }
        if (sum == G) break;
        __builtin_amdgcn_s_sleep(1);
        if ((++sp & 255u) == 0u) { if (xb_ld(&bar[XB_TMO])) break; if (sp > XB_SPIN_CAP) { atomicAdd(&bar[XB_TMO], 1u); break; } }
    }
    nloc = mine > 0u ? mine : 1u; nx = cnt > 0u ? cnt : 1u;
}
__device__ __forceinline__ void xcd_barrier(const XcdBarrier& b) {
    asm volatile("s_waitcnt vmcnt(0)" ::: "memory");
    __syncthreads();
    if (threadIdx.x == 0) {
        unsigned* bar = b.bar;
        __builtin_amdgcn_s_waitcnt(0);
        unsigned nloc = b.st[0], nx = b.st[1];
        if (nloc == 0u) { xcd_barrier_complete(bar, b.x, nloc, nx); b.st[0] = nloc; b.st[1] = nx; }
        const unsigned old = xb_add(&bar[XB_XSUB(b.x)], 1u);
        const unsigned gen = old / nloc;
        if (old + 1u == (gen + 1u) * nloc) {
            __builtin_amdgcn_fence(__ATOMIC_RELEASE, "agent");
            asm volatile("s_waitcnt vmcnt(0)" ::: "memory");
            const unsigned og = xb_add(&bar[XB_TOP], 1u);
            const unsigned tg = og / nx;
            if (og + 1u == (tg + 1u) * nx) xb_add(&bar[XB_TOPGEN], 1u);
            else XB_SPIN(xb_ld(&bar[XB_TOPGEN]) == tg, bar);
            __builtin_amdgcn_fence(__ATOMIC_ACQUIRE, "agent");
            xb_add(&bar[XB_XGEN(b.x)], 1u);
            asm volatile("s_waitcnt vmcnt(0)" ::: "memory");
        } else {
            XB_SPIN(xb_ld(&bar[XB_XGEN(b.x)]) == gen, bar);
            __builtin_amdgcn_fence(__ATOMIC_ACQUIRE, "agent");
            asm volatile("s_waitcnt vmcnt(0)" ::: "memory");
        }
    }
    __syncthreads();
}

constexpr int NWAVES = 8, NTHR = NWAVES * 64;
constexpr int RING_BYTES = 131072, MISC_OFF = RING_BYTES + 320, LDS_BYTES = 147456;
constexpr int NPHASE = 16;

__device__ __forceinline__ void mixer_even_simple(unsigned char* ws, const float* retnorm, int gw, int ngw, int lane) {
    const bf16* P = (const bf16*)(ws + WS_BIG); bf16* Y = (bf16*)(ws + WS_X0);
    for (int idx = gw; idx < BATCH * 8 * SEQ; idx += ngw) {
        const int t = idx & (SEQ - 1), h = (idx >> 12) & 7, b = idx >> 15; const size_t rb = (size_t)b * SEQ;
        { const float lg2 = log2f(1.0f - exp2f(-5.0f - (float)h));
          const float q = bf2f(P[(rb + t) * EW + h * 64 + lane]); float o = 0.f;
          for (int s = 0; s <= t; ++s) { const float k = bf2f(P[(rb + s) * EW + 512 + h * 64 + lane]), v = bf2f(P[(rb + s) * EW + 1024 + h * 64 + lane]);
              o += exp2f(lg2 * (float)(t - s)) * wave_sum(q * k) * v; }
          const float mu = wave_sum(o) * (1.f / 64.f); const float dv = o - mu; const float var = wave_sum(dv * dv) * (1.f / 64.f);
          const float g = bf2f(P[(rb + t) * EW + 1536 + h * 64 + lane]);
          Y[(rb + t) * DM + h * 64 + lane] = (bf16)f2bf(dv * (1.0f / sqrtf(var + GN_EPS)) * retnorm[h * 64 + lane] * silu_f(g)); }
        { const float q = bf2f(P[(rb + t) * EW + 2048 + h * 64 + lane]); float o = 0.f, carry = 0.f;
          for (int s = t - 1; s >= 0; --s) { const float k = bf2f(P[(rb + s) * EW + 2560 + h * 64 + lane]), v = bf2f(P[(rb + s) * EW + 3072 + h * 64 + lane]);
              const float y = wave_sum(q * k); const float lf2 = -softplus2(y); o += __builtin_amdgcn_exp2f(y + lf2 + carry) * v; carry += lf2; }
          Y[(rb + t) * DM + 512 + h * 64 + lane] = (bf16)f2bf(o); }
    }
}
__device__ __forceinline__ void fox_simple(unsigned char* ws, LAS float* cum, int vcu, int wave, int lane) {
    const bf16* P = (const bf16*)(ws + WS_BIG); bf16* Y = (bf16*)(ws + WS_X0);
    const int bh = vcu >> 1, b = bh >> 4, h = bh & 15; const size_t rb = (size_t)b * SEQ;
    const float* lf = (const float*)(ws + WS_LOGF) + (size_t)bh * SEQ;
    if (wave == 0) { float run = 0.f;
        for (int j = 0; j < 64; ++j) run += lf[lane * 64 + j];
        float inc = run;
#pragma unroll
        for (int o = 1; o < 64; o <<= 1) { const float n = __shfl_up(inc, o); if (lane >= o) inc += n; }
        float acc = inc - run;
        for (int j = 0; j < 64; ++j) { acc += lf[lane * 64 + j]; cum[lane * 64 + j] = acc; } }
    __syncthreads();
    for (int t = (vcu & 1) + 2 * wave; t < SEQ; t += 16) {
        const float q = bf2f(P[(rb + t) * QKVW + h * 64 + lane]); const float ct = cum[t]; float m = -INFINITY, l = 0.f, o = 0.f;
        for (int s = 0; s <= t; ++s) { const float k = bf2f(P[(rb + s) * QKVW + 1024 + h * 64 + lane]), v = bf2f(P[(rb + s) * QKVW + 2048 + h * 64 + lane]);
            const float x = wave_sum(q * k) + (ct - cum[s]) * LOG2E;
            if (x > m) { const float f = __builtin_amdgcn_exp2f(m - x); l *= f; o *= f; m = x; }
            const float pr = __builtin_amdgcn_exp2f(x - m); l += pr; o += pr * v; }
        Y[(rb + t) * DM + h * 64 + lane] = (bf16)f2bf(o / l); }
    __syncthreads();
}
__device__ __forceinline__ void router_phase(unsigned char* ws, const float* hres, LAS unsigned* rl, int vcu, int wave, int lane) {
    unsigned* ctl = (unsigned*)(ws + WS_CTL); const int tid = threadIdx.x;
    LAS unsigned* lcnt = rl; LAS unsigned* lbase = rl + 16; LAS int* tinfo = (LAS int*)(rl + 32); LAS float* tg = (LAS float*)(rl + 32 + 256); LAS unsigned* tpos = rl + 32 + 512;
    if (tid < 16) lcnt[tid] = 0u;
    __syncthreads();
    const float* part4 = (const float*)(ws + WS_PART) + (size_t)2 * T * 16;
    for (int i = 0; i < 16; ++i) { const int lt = wave * 16 + i, row = vcu * 128 + lt; int e1, e2; float g1, g2;
        router_row(hres + (size_t)row * DM, (const float*)(ws + WS_ROUTW), part4, row, (float*)(ws + WS_RSTD4), lane, e1, e2, g1, g2);
        if (lane == 0) { tinfo[lt * 2] = e1; tinfo[lt * 2 + 1] = e2; tg[lt * 2] = g1; tg[lt * 2 + 1] = g2;
            tpos[lt * 2] = __hip_atomic_fetch_add(&lcnt[e1], 1u, __ATOMIC_RELAXED, __HIP_MEMORY_SCOPE_WORKGROUP); tpos[lt * 2 + 1] = __hip_atomic_fetch_add(&lcnt[8 + e2], 1u, __ATOMIC_RELAXED, __HIP_MEMORY_SCOPE_WORKGROUP); } }
    __syncthreads();
    if (tid < 16) lbase[tid] = __hip_atomic_fetch_add(&ctl[CW_CNT + 64 * tid], lcnt[tid], __ATOMIC_RELAXED, __HIP_MEMORY_SCOPE_AGENT);
    __syncthreads();
    if (tid < 256) { const int lt = tid >> 1, c = tid & 1, e = tinfo[tid]; const unsigned pos = lbase[c * 8 + e] + tpos[tid];
        ((int*)(ws + WS_LIST))[(size_t)(c * 8 + e) * T + pos] = vcu * 128 + lt; ((float*)(ws + WS_GATE))[(size_t)(c * 8 + e) * T + pos] = tg[tid]; }
    __syncthreads();
}

typedef const __attribute__((address_space(4))) Params* KParams;
__device__ __forceinline__ KParams kargs() { unsigned long long v = (unsigned long long)__builtin_amdgcn_kernarg_segment_ptr(); asm volatile("" : "+s"(v)); return (KParams)v; }
__global__ void __launch_bounds__(NTHR, 2) mega_fwd(Params p_unused) {
    extern __shared__ __attribute__((aligned(16))) unsigned char lds_raw[];
    LAS unsigned char* lds = (LAS unsigned char*)lds_raw;
    const int tid = threadIdx.x, lane = tid & 63, wave = __builtin_amdgcn_readfirstlane(tid >> 6);
    for (int i = tid; i < (LDS_BYTES - RING_BYTES) / 4; i += NTHR) ((LAS unsigned*)(lds + RING_BYTES))[i] = 0u;
    __syncthreads();
    XcdBarrier bar = xcd_barrier_post((unsigned*)(kargs()->ws + WS_CTL) + CW_BAR, (volatile LAS unsigned*)(lds + MISC_OFF) + 8);
#ifndef PH_MASK
#define PH_MASK 0xffff
#endif
#define IN(k) (((PH_MASK >> (k)) & 1) && kargs()->ph_lo <= (k) && (k) < kargs()->ph_hi)
#define SEAM(k) do { if (IN(k) && IN((k) + 1)) xcd_barrier(bar); } while (0)
#define GRID_VARS const int G = gridDim.x, bx = blockIdx.x; const int vcu = (G % 8 == 0) ? (bx % 8) * (G / 8) + bx / 8 : bx; const int gw = vcu * NWAVES + wave, ngw = G * NWAVES; (void)gw; (void)ngw; (void)vcu; \
    KParams kp = kargs(); unsigned char* ws = kp->ws; (void)ws

    if (IN(0)) { GRID_VARS; Params p; for (int i = 0; i < 19; ++i) p.in[i] = kp->in[i]; p.out = kp->out; p.ws = ws; p.ph_lo = 0; p.ph_hi = 0;
        prologue_weights(p, (LAS float*)(lds + wave * 16384), gw, ngw, lane);
        prologue_small(p, bx * NTHR + tid, G * NTHR);
        const float* x = kp->in[0]; bf16* X0 = (bf16*)(ws + WS_X0);
        for (int m = gw; m < T; m += ngw) rms_row_to_bf16(x + (size_t)m * DM, X0 + (size_t)m * DM, lane);
    }
    SEAM(0);
    if (IN(1)) { GRID_VARS; pg8::ProbDense P{(const bf16*)(ws + WS_X0), (const bf16*)(ws + WS_W_IN_E), DM}; pg8::StaticOrder S; S.init(T / 256, EW / 256, G, bx);
        pg8::EpiInEven E{(bf16*)(ws + WS_BIG), (const float2*)(ws + WS_ROPE)}; pg8::gemm_phase(lds, P, S, E); }
    SEAM(1);
#ifdef MIX_SIMPLE
    if (IN(2)) { GRID_VARS; mixer_even_simple(ws, kp->in[3], gw, ngw, lane); }
    SEAM(2);
    SEAM(3);
#else
    if (IN(2)) { GRID_VARS; const bf16* Pj = (const bf16*)(ws + WS_BIG); float* loc = kp->out; float* grp = kp->out + (size_t)8 * 1024 * 1024;
        for (int k = 0; k < 2; ++k) { const int u = vcu + 256 * k; att::ret_pass_a(lds, Pj, loc, grp, u >> 3, u & 7); }
        for (int k = 0; k < 2; ++k) { const int u = vcu + 256 * k, bh = u >> 4, qb = u & 15, h = bh & 7;
            att::unit<0>(lds, Pj + 2048 + h * 64, Pj + 2560 + h * 64, Pj + 3072 + h * 64, EW, (bf16*)(ws + WS_X0) + 512 + h * 64, (size_t)(bh >> 3) * SEQ, qb * 256, nullptr); } }
    SEAM(2);
    if (IN(3)) { GRID_VARS; const bf16* Pj = (const bf16*)(ws + WS_BIG); const float* loc = kp->out; const float* grp = kp->out + (size_t)8 * 1024 * 1024; const float* rn = kp->in[3];
        for (int k = 0; k < 8; ++k) { const int u = vcu + 256 * k; att::ret_pass_b(lds, Pj, loc, grp, rn, (bf16*)(ws + WS_X0), u >> 5, u & 31); }
        for (int k = 2; k < 4; ++k) { const int u = vcu + 256 * k, bh = u >> 4, qb = u & 15, h = bh & 7;
            att::unit<0>(lds, Pj + 2048 + h * 64, Pj + 2560 + h * 64, Pj + 3072 + h * 64, EW, (bf16*)(ws + WS_X0) + 512 + h * 64, (size_t)(bh >> 3) * SEQ, qb * 256, nullptr); } }
    SEAM(3);
#endif
    if (IN(4)) { GRID_VARS; pg8::ProbDense P{(const bf16*)(ws + WS_X0), (const bf16*)(ws + WS_W_OUT_E), DM}; pg8::StaticOrder S; S.init(T / 256, DM / 256, G, bx);
        pg8::EpiResid E{kp->in[0], kp->out, (bf16*)(ws + WS_BIG), (float*)(ws + WS_PART)}; pg8::gemm_phase(lds, P, S, E); }
    SEAM(4);
    if (IN(5)) { GRID_VARS; pg8::ProbDense P{(const bf16*)(ws + WS_BIG), (const bf16*)(ws + WS_W_GU_E), DM}; pg8::StaticOrder S; S.init(T / 256, GU / 256, G, bx);
        pg8::EpiGU E{(bf16*)(ws + WS_HID), (const float*)(ws + WS_PART)}; pg8::gemm_phase(lds, P, S, E); }
    SEAM(5);
    if (IN(6)) { GRID_VARS; pg8::ProbDense P{(const bf16*)(ws + WS_HID), (const bf16*)(ws + WS_W_DN_E), DFF}; pg8::StaticOrder S; S.init(T / 256, DM / 256, G, bx);
        pg8::EpiResid E{kp->out, kp->out, (bf16*)(ws + WS_X0), (float*)(ws + WS_PART) + (size_t)T * 16}; pg8::gemm_phase(lds, P, S, E); }
    SEAM(6);
    if (IN(7)) { GRID_VARS; pg8::ProbDense P{(const bf16*)(ws + WS_X0), (const bf16*)(ws + WS_W_IN_O), DM}; pg8::StaticOrder S; S.init(T / 256, OWP / 256, G, bx);
        pg8::EpiInOdd E{(bf16*)(ws + WS_BIG), (const float*)(ws + WS_PART) + (size_t)T * 16, kp->in[11], (float*)(ws + WS_LOGF)}; pg8::gemm_phase(lds, P, S, E); }
    SEAM(7);
#ifdef FOX_SIMPLE
    if (IN(8)) { GRID_VARS; fox_simple(ws, (LAS float*)lds, vcu, wave, lane); }
#else
    if (IN(8)) { GRID_VARS; const bf16* Pj = (const bf16*)(ws + WS_BIG); const int bh = vcu >> 1, h = bh & 15;
        LAS float* cum2 = (LAS float*)(lds + att::CUM_OFF);
        att::fox_cum(cum2, (const float*)(ws + WS_LOGF) + (size_t)bh * SEQ);
        for (int k = 0; k < 8; ++k) { const int s = 4 * (vcu & 1) + (k >> 1), qb = (k & 1) ? 15 - s : s;
            att::unit<1>(lds, Pj + h * 64, Pj + 1024 + h * 64, Pj + 2048 + h * 64, QKVW, (bf16*)(ws + WS_X0) + h * 64, (size_t)(bh >> 4) * SEQ, qb * 256, cum2); } }
#endif
    SEAM(8);
    if (IN(9)) { GRID_VARS; pg8::ProbDense P{(const bf16*)(ws + WS_X0), (const bf16*)(ws + WS_W_OUT_O), DM}; pg8::StaticOrder S; S.init(T / 256, DM / 256, G, bx);
        pg8::EpiResid E{kp->out, kp->out, (bf16*)(ws + WS_BIG), (float*)(ws + WS_PART) + (size_t)2 * T * 16}; pg8::gemm_phase(lds, P, S, E); }
    SEAM(9);
    if (IN(10)) { GRID_VARS; if (G == 256) router_phase(ws, kp->out, (LAS unsigned*)lds, vcu, wave, lane); }
    SEAM(10);
    for (int c = 0; c < 2; ++c) {
        if (IN(11 + 2 * c)) { GRID_VARS; const unsigned* ctl = (const unsigned*)(ws + WS_CTL); int ntile = 0;
#pragma unroll
            for (int e = 0; e < 8; ++e) ntile += ((int)ctl[CW_CNT + 64 * (c * 8 + e)] + 255) >> 8;
            pg8::ProbMoeGU P{(const bf16*)(ws + WS_BIG), (const bf16*)(ws + WS_W_GU_M), DM, (size_t)GU * DM * 2, ctl, c, (const int*)(ws + WS_LIST)}; pg8::StaticOrder S; S.init(ntile, GU / 256, G, bx);
            pg8::EpiMoeGU E{(bf16*)(ws + WS_HID), (const float*)(ws + WS_RSTD4), ctl, c, (const int*)(ws + WS_LIST)}; pg8::gemm_phase(lds, P, S, E); }
        SEAM(11 + 2 * c);
        if (IN(12 + 2 * c)) { GRID_VARS; const unsigned* ctl = (const unsigned*)(ws + WS_CTL); int ntile = 0;
#pragma unroll
            for (int e = 0; e < 8; ++e) ntile += ((int)ctl[CW_CNT + 64 * (c * 8 + e)] + 255) >> 8;
            pg8::ProbMoeDown P{(const bf16*)(ws + WS_HID), (const bf16*)(ws + WS_W_DN_M), DFF, (size_t)DM * DFF * 2, ctl, c}; pg8::StaticOrder S; S.init(ntile, DM / 256, G, bx);
            pg8::EpiMoeDown E{kp->out, ctl, c, (const int*)(ws + WS_LIST), (const float*)(ws + WS_GATE)}; pg8::gemm_phase(lds, P, S, E); }
        SEAM(12 + 2 * c);
    }
    if (IN(15)) { GRID_VARS; float* out = kp->out; const float* fg = kp->in[18]; for (int m = gw; m < T; m += ngw) final_norm_row(out + (size_t)m * DM, fg, lane); }
#undef IN
#undef SEAM
#undef GRID_VARS
}

#ifndef MK_N_LAUNCHES
#define MK_N_LAUNCHES 1
#endif
extern "C" void kernel_launch(void* const* d_in, const int* in_sizes, int n_in, void* d_out, int out_size, void* d_ws, size_t ws_size, hipStream_t stream) {
    static int grid = 0;
    if (grid == 0) {
        if (n_in != 19 || out_size != T * DM || ws_size < WS_END) { fprintf(stderr, "kernel_launch: unexpected shapes (n_in %d out %d ws %zu)\n", n_in, out_size, ws_size); grid = -1; return; }
        int dev = 0, cus = 0, per_cu = 0;
        if (hipGetDevice(&dev) != hipSuccess || hipDeviceGetAttribute(&cus, hipDeviceAttributeMultiprocessorCount, dev) != hipSuccess) { grid = -1; return; }
        if (hipFuncSetAttribute((const void*)mega_fwd, hipFuncAttributeMaxDynamicSharedMemorySize, LDS_BYTES) != hipSuccess) { fprintf(stderr, "kernel_launch: hipFuncSetAttribute failed\n"); grid = -1; return; }
        if (hipOccupancyMaxActiveBlocksPerMultiprocessor(&per_cu, (const void*)mega_fwd, NTHR, LDS_BYTES) != hipSuccess || per_cu < 1) { fprintf(stderr, "kernel_launch: occupancy query says %d\n", per_cu); }
        (void)hipGetLastError();
        grid = cus;
        if (grid != 256) fprintf(stderr, "kernel_launch: %d CUs; the router phase assumes 256\n", grid);
    }
    if (grid < 0) return;
    (void)in_sizes;
    if (hipMemsetAsync((char*)d_ws + WS_CTL, 0, CTL_BYTES, stream) != hipSuccess) return;
    Params p{};
    for (int i = 0; i < 19; ++i) p.in[i] = (const float*)d_in[i];
    p.out = (float*)d_out; p.ws = (unsigned char*)d_ws;
#if MK_N_LAUNCHES == 1
    p.ph_lo = 0; p.ph_hi = NPHASE;
    hipLaunchKernelGGL(mega_fwd, dim3(grid), dim3(NTHR), LDS_BYTES, stream, p);
#else
    for (int k = 0; k < NPHASE; ++k) { p.ph_lo = k; p.ph_hi = k + 1; hipLaunchKernelGGL(mega_fwd, dim3(grid), dim3(NTHR), LDS_BYTES, stream, p); }
#endif
}
```

```cpp
#include <hip/hip_runtime.h>
#include <cstdio>
#include <cstdint>

constexpr int DM = 1024, BATCH = 8, SEQ = 4096, T = BATCH * SEQ;
constexpr int HD = 64;
constexpr int EW = 3584;
constexpr int OW = 3088, OWP = 3328;
constexpr int QKVW = 3072;
constexpr int DFF = 2816, NEXP = 8, GU = 2 * DFF;
constexpr float NORM_EPS = 1e-6f, GN_EPS = 1e-5f;
constexpr float LOG2E = 1.4426950408889634f;
constexpr float C2 = 0.125f * LOG2E;
constexpr int MOE_MAXT = 136;

constexpr size_t MiB = 1u << 20;
constexpr size_t WS_CTL = 0, CTL_BYTES = 2 * MiB;
constexpr size_t WS_ROPE = 2 * MiB;
constexpr size_t WS_ROUTW = 3 * MiB;
constexpr size_t WS_RSTD4 = 3 * MiB + 65536;
constexpr size_t WS_LIST = 4 * MiB;
constexpr size_t WS_GATE = 6 * MiB;
constexpr size_t WS_PART = 8 * MiB;
constexpr size_t WS_LOGF = 14 * MiB;
constexpr size_t WS_CUM = 16 * MiB;
constexpr size_t WS_W = 18 * MiB;
constexpr size_t WS_W_IN_E = WS_W;
constexpr size_t WS_W_OUT_E = WS_W_IN_E + (size_t)EW * DM * 2;
constexpr size_t WS_W_GU_E = WS_W_OUT_E + (size_t)DM * DM * 2;
constexpr size_t WS_W_DN_E = WS_W_GU_E + (size_t)GU * DM * 2;
constexpr size_t WS_W_IN_O = WS_W_DN_E + (size_t)DM * DFF * 2;
constexpr size_t WS_W_OUT_O = WS_W_IN_O + (size_t)OWP * DM * 2;
constexpr size_t WS_W_GU_M = WS_W_OUT_O + (size_t)DM * DM * 2;
constexpr size_t WS_W_DN_M = WS_W_GU_M + (size_t)NEXP * GU * DM * 2;
constexpr size_t WS_W_END = WS_W_DN_M + (size_t)NEXP * DM * DFF * 2;
constexpr size_t WS_X0 = 184 * MiB;
constexpr size_t WS_BIG = 248 * MiB;
constexpr size_t WS_HID = WS_BIG + 64 * MiB;
constexpr size_t WS_END = WS_BIG + 251 * MiB;
static_assert(WS_W_END <= WS_X0 && WS_END <= 512 * MiB, "ws map");
static_assert(WS_HID + (size_t)MOE_MAXT * 256 * DFF * 2 <= WS_END, "hidden fits");
constexpr int CW_CNT = 64;
constexpr int CW_BAR = 4096;

typedef unsigned short bf16;
typedef short bf16x8 __attribute__((ext_vector_type(8)));
typedef float f32x4 __attribute__((ext_vector_type(4)));
typedef float f32x16 __attribute__((ext_vector_type(16)));
typedef unsigned u32x4 __attribute__((ext_vector_type(4)));
typedef unsigned u32x2 __attribute__((ext_vector_type(2)));

struct Params { const float* in[19]; float* out; unsigned char* ws; int ph_lo, ph_hi, li, pad; };

__device__ __forceinline__ unsigned f2bf(float f) { unsigned u = __builtin_bit_cast(unsigned, f); return (u + 0x7fffu + ((u >> 16) & 1u)) >> 16; }
__device__ __forceinline__ unsigned pk2(float lo, float hi) { return f2bf(lo) | (f2bf(hi) << 16); }
__device__ __forceinline__ float bf2f(unsigned short b) { return __builtin_bit_cast(float, (unsigned)b << 16); }
__device__ __forceinline__ float wave_sum(float v) {
#pragma unroll
    for (int o = 1; o < 64; o <<= 1) v += __shfl_xor(v, o);
    return v;
}
__device__ __forceinline__ float silu_f(float x) { return x / (1.f + __expf(-x)); }
__device__ __forceinline__ float softplus2(float y) { return fmaxf(y, 0.f) + __log2f(1.f + __builtin_amdgcn_exp2f(-fabsf(y))); }
__device__ __forceinline__ float rstd_from_part(const float* part, int row) {
    const f32x4* p = (const f32x4*)(part + (size_t)row * 16); float s = 0.f;
#pragma unroll
    for (int i = 0; i < 4; ++i) { const f32x4 v = p[i]; s += (v[0] + v[1]) + (v[2] + v[3]); }
    return 1.0f / sqrtf(s * (1.f / DM) + NORM_EPS);
}
__device__ __forceinline__ bool moe_tile(const unsigned* ctl, int c, int tile, int& e, int& row0, int& nrows) {
    int ts = 0;
#pragma unroll
    for (int i = 0; i < 8; ++i) { const int cn = (int)ctl[CW_CNT + 64 * (c * 8 + i)]; const int nt = (cn + 255) >> 8;
        if (tile >= ts && tile < ts + nt) { e = i; row0 = (tile - ts) * 256; nrows = cn - row0 < 256 ? cn - row0 : 256; return true; }
        ts += nt; }
    return false;
}

__constant__ double c_invfreq[32] = {1, 0.74989420933245587, 0.56234132519034907, 0.42169650342858223, 0.31622776601683794, 0.23713737056616552, 0.17782794100389229, 0.1333521432163324,
    0.10000000000000001, 0.074989420933245579, 0.056234132519034911, 0.042169650342858224, 0.031622776601683791, 0.023713737056616554, 0.017782794100389229, 0.013335214321633241,
    0.01, 0.0074989420933245579, 0.005623413251903491, 0.0042169650342858229, 0.0031622776601683794, 0.0023713737056616554, 0.0017782794100389228, 0.0013335214321633241,
    0.001, 0.00074989420933245586, 0.0005623413251903491, 0.00042169650342858224, 0.00031622776601683794, 0.00023713737056616554, 0.00017782794100389227, 0.0001333521432163324};
__device__ __forceinline__ void rope_entry(int pos, int i, float& c, float& s) {
    const double a = (double)pos * c_invfreq[i];
    const double TWO_PI = 6.283185307179586476925286766559, HALF_PI = 1.5707963267948966192313216916398;
    double r = a - TWO_PI * __builtin_rint(a / TWO_PI);
    const double qd = __builtin_rint(r / HALF_PI); const int q = (int)qd; r -= qd * HALF_PI;
    const double r2 = r * r;
    const double sn = r * (1.0 + r2 * (-1.0 / 6 + r2 * (1.0 / 120 + r2 * (-1.0 / 5040 + r2 * (1.0 / 362880 + r2 * (-1.0 / 39916800 + r2 * (1.0 / 6227020800.0)))))));
    const double cs = 1.0 + r2 * (-0.5 + r2 * (1.0 / 24 + r2 * (-1.0 / 720 + r2 * (1.0 / 40320 + r2 * (-1.0 / 3628800 + r2 * (1.0 / 479001600.0))))));
    const int qq = q & 3; double cc, ss;
    if (qq == 0) { cc = cs; ss = sn; } else if (qq == 1) { cc = -sn; ss = cs; } else if (qq == 2) { cc = -cs; ss = -sn; } else { cc = sn; ss = -cs; }
    c = (float)cc; s = (float)ss;
}
enum { MAP_ID = 0, MAP_INE = 1, MAP_GATE = 2, MAP_UP = 3 };
__device__ __forceinline__ int map_row(int mode, int n) {
    if (mode == MAP_INE) return n < 1024 ? (n & ~63) + 2 * (n & 31) + ((n >> 5) & 1) : n;
    if (mode == MAP_GATE) return (n >> 7) * 256 + (n & 127);
    if (mode == MAP_UP) return (n >> 7) * 256 + 128 + (n & 127);
    return n;
}
constexpr int TR_SCR_BYTES = 64 * 65 * 4;
template <class LP>
__device__ __forceinline__ void transpose_item(const float* __restrict__ W, int K, int N, bf16* WT, const float* __restrict__ gain, int mode, LP scr, int item, int lane) {
    const int nblk = (N + 63) / 64, kb = item / nblk, nb = item % nblk, k0 = 64 * kb, n0 = 64 * nb;
    const int lr = lane >> 4, lc = (lane & 15) * 4;
    const bool nok = n0 + lc < N;
    f32x4 v[16];
#pragma unroll
    for (int i = 0; i < 16; ++i) v[i] = nok ? *(const f32x4*)(W + (size_t)(k0 + 4 * i + lr) * N + n0 + lc) : (f32x4){0.f, 0.f, 0.f, 0.f};
#pragma unroll
    for (int i = 0; i < 16; ++i)
#pragma unroll
        for (int e = 0; e < 4; ++e) scr[(4 * i + lr) * 65 + lc + e] = v[i][e];
    asm volatile("s_waitcnt lgkmcnt(0)" ::: "memory");
    const int c = lane & 7;
    f32x4 g0 = {1.f, 1.f, 1.f, 1.f}, g1 = {1.f, 1.f, 1.f, 1.f};
    if (gain) { g0 = *(const f32x4*)(gain + k0 + 8 * c); g1 = *(const f32x4*)(gain + k0 + 8 * c + 4); }
#pragma unroll
    for (int j = 0; j < 8; ++j) { const int n = (lane >> 3) + 8 * j;
        u32x4 o; o.x = pk2(scr[(8 * c + 0) * 65 + n] * g0[0], scr[(8 * c + 1) * 65 + n] * g0[1]); o.y = pk2(scr[(8 * c + 2) * 65 + n] * g0[2], scr[(8 * c + 3) * 65 + n] * g0[3]);
        o.z = pk2(scr[(8 * c + 4) * 65 + n] * g1[0], scr[(8 * c + 5) * 65 + n] * g1[1]); o.w = pk2(scr[(8 * c + 6) * 65 + n] * g1[2], scr[(8 * c + 7) * 65 + n] * g1[3]);
        if (n0 + n < N) *(u32x4*)(WT + (size_t)map_row(mode, n0 + n) * K + k0 + 8 * c) = o; }
    asm volatile("s_waitcnt lgkmcnt(0)" ::: "memory");
}
struct WJob { const float* W; int K, N; bf16* WT; const float* gain; int mode; int items; };
template <class LP>
__device__ __forceinline__ void prologue_weights(const Params& p, LP scr, int gw, int ngw, int lane) {
    unsigned char* ws = p.ws;
    for (int j = 0; j < 7 + 3 * NEXP; ++j) {
        WJob J;
        if (j == 0) J = WJob{p.in[2], DM, EW, (bf16*)(ws + WS_W_IN_E), p.in[1], MAP_INE, 0};
        else if (j == 1) J = WJob{p.in[4], DM, DM, (bf16*)(ws + WS_W_OUT_E), nullptr, MAP_ID, 0};
        else if (j == 2) J = WJob{p.in[6], DM, DFF, (bf16*)(ws + WS_W_GU_E), p.in[5], MAP_GATE, 0};
        else if (j == 3) J = WJob{p.in[7], DM, DFF, (bf16*)(ws + WS_W_GU_E), p.in[5], MAP_UP, 0};
        else if (j == 4) J = WJob{p.in[8], DFF, DM, (bf16*)(ws + WS_W_DN_E), nullptr, MAP_ID, 0};
        else if (j == 5) J = WJob{p.in[10], DM, OW, (bf16*)(ws + WS_W_IN_O), p.in[9], MAP_ID, 0};
        else if (j == 6) J = WJob{p.in[12], DM, DM, (bf16*)(ws + WS_W_OUT_O), nullptr, MAP_ID, 0};
        else { const int k = j - 7, e = k / 3, w = k % 3;
            if (w == 0) J = WJob{p.in[15] + (size_t)e * DM * DFF, DM, DFF, (bf16*)(ws + WS_W_GU_M) + (size_t)e * GU * DM, p.in[13], MAP_GATE, 0};
            else if (w == 1) J = WJob{p.in[16] + (size_t)e * DM * DFF, DM, DFF, (bf16*)(ws + WS_W_GU_M) + (size_t)e * GU * DM, p.in[13], MAP_UP, 0};
            else J = WJob{p.in[17] + (size_t)e * DFF * DM, DFF, DM, (bf16*)(ws + WS_W_DN_M) + (size_t)e * DM * DFF, nullptr, MAP_ID, 0}; }
        J.items = (J.K / 64) * ((J.N + 63) / 64);
        for (int it = gw; it < J.items; it += ngw) transpose_item(J.W, J.K, J.N, J.WT, J.gain, J.mode, scr, it, lane);
    }
}
__device__ __forceinline__ void prologue_small(const Params& p, int gt, int ngt) {
    unsigned char* ws = p.ws;
    { u32x4* z = (u32x4*)((bf16*)(ws + WS_W_IN_O) + (size_t)OW * DM); const int n16 = (OWP - OW) * DM * 2 / 16;
      for (int i = gt; i < n16; i += ngt) z[i] = (u32x4){0u, 0u, 0u, 0u}; }
    { float2* R = (float2*)(ws + WS_ROPE);
      for (int i = gt; i < SEQ * 32; i += ngt) { float c, s; rope_entry(i >> 5, i & 31, c, s); R[i] = make_float2(c, s); } }
    { float* RW = (float*)(ws + WS_ROUTW); const float* wr = p.in[14]; const float* g = p.in[13];
      for (int i = gt; i < NEXP * DM; i += ngt) { const int e = i >> 10, k = i & 1023; RW[i] = wr[k * NEXP + e] * g[k]; } }
}
__device__ __forceinline__ void rms_row_to_bf16(const float* xrow, bf16* orow, int lane) {
    const f32x4* xr = (const f32x4*)xrow + lane;
    f32x4 v[4]; float s = 0.f;
#pragma unroll
    for (int j = 0; j < 4; ++j) { v[j] = xr[64 * j]; s += (v[j][0] * v[j][0] + v[j][1] * v[j][1]) + (v[j][2] * v[j][2] + v[j][3] * v[j][3]); }
    const float rstd = 1.0f / sqrtf(wave_sum(s) * (1.f / DM) + NORM_EPS);
    unsigned long long* o8 = (unsigned long long*)orow + lane;
#pragma unroll
    for (int j = 0; j < 4; ++j) o8[64 * j] = (unsigned long long)pk2(v[j][0] * rstd, v[j][1] * rstd) | ((unsigned long long)pk2(v[j][2] * rstd, v[j][3] * rstd) << 32);
}
__device__ __forceinline__ void final_norm_row(float* row, const float* gain, int lane) {
    f32x4* xr = (f32x4*)row + lane; const f32x4* g = (const f32x4*)gain + lane;
    f32x4 v[4]; float s = 0.f;
#pragma unroll
    for (int j = 0; j < 4; ++j) { v[j] = xr[64 * j]; s += (v[j][0] * v[j][0] + v[j][1] * v[j][1]) + (v[j][2] * v[j][2] + v[j][3] * v[j][3]); }
    const float rstd = 1.0f / sqrtf(wave_sum(s) * (1.f / DM) + NORM_EPS);
#pragma unroll
    for (int j = 0; j < 4; ++j) xr[64 * j] = v[j] * rstd * g[64 * j];
}
__device__ __forceinline__ void router_row(const float* hrow, const float* RW, const float* part4, int row, float* rstd4, int lane, int& e1, int& e2, float& g1, float& g2) {
    const f32x4* xr = (const f32x4*)hrow + lane; f32x4 v[4];
#pragma unroll
    for (int j = 0; j < 4; ++j) v[j] = xr[64 * j];
    float lg[NEXP];
#pragma unroll
    for (int e = 0; e < NEXP; ++e) { const f32x4* w = (const f32x4*)(RW + e * DM) + lane; float s = 0.f;
#pragma unroll
        for (int j = 0; j < 4; ++j) { const f32x4 ww = w[64 * j]; s += (v[j][0] * ww[0] + v[j][1] * ww[1]) + (v[j][2] * ww[2] + v[j][3] * ww[3]); }
        lg[e] = wave_sum(s); }
    const float rstd = rstd_from_part(part4, row);
    if (lane == 0) rstd4[row] = rstd;
    int b1 = 0; float v1 = lg[0];
#pragma unroll
    for (int e = 1; e < NEXP; ++e) if (lg[e] > v1) { v1 = lg[e]; b1 = e; }
    int b2 = -1; float v2 = -INFINITY;
#pragma unroll
    for (int e = 0; e < NEXP; ++e) if (e != b1 && lg[e] > v2) { v2 = lg[e]; b2 = e; }
    e1 = b1; e2 = b2; const float d = (v2 - v1) * rstd;
    g1 = 1.f / (1.f + __expf(d)); g2 = 1.f - g1;
}

__global__ void __launch_bounds__(128) nk_prologue_w(Params p) {
    __shared__ float scr[2][64 * 65];
    const int wave = threadIdx.x >> 6, lane = threadIdx.x & 63;
    prologue_weights(p, &scr[wave][0], blockIdx.x * 2 + wave, gridDim.x * 2, lane);
}
__global__ void __launch_bounds__(256) nk_prologue_s(Params p) {
    prologue_small(p, blockIdx.x * 256 + threadIdx.x, gridDim.x * 256);
    const int gw = blockIdx.x * 4 + (threadIdx.x >> 6), ngw = gridDim.x * 4, lane = threadIdx.x & 63;
    for (int m = gw; m < T; m += ngw) rms_row_to_bf16(p.in[0] + (size_t)m * DM, (bf16*)(p.ws + WS_X0) + (size_t)m * DM, lane);
}
__global__ void __launch_bounds__(256) nk_rowssq(Params p, int which) {
    const int gw = blockIdx.x * 4 + (threadIdx.x >> 6), ngw = gridDim.x * 4, lane = threadIdx.x & 63;
    float* part = (float*)(p.ws + WS_PART) + (size_t)which * T * 16;
    for (int m = gw; m < T; m += ngw) { const f32x4* xr = (const f32x4*)(p.out + (size_t)m * DM) + lane; float s = 0.f;
#pragma unroll
        for (int j = 0; j < 4; ++j) { const f32x4 v = xr[64 * j]; s += (v[0] * v[0] + v[1] * v[1]) + (v[2] * v[2] + v[3] * v[3]); }
        s = wave_sum(s); if (lane < 16) part[(size_t)m * 16 + lane] = lane == 0 ? s : 0.f; }
}
template <int EPI> __global__ void __launch_bounds__(256) nk_gemm(Params p) {
    unsigned char* ws = p.ws; const unsigned* ctl = (const unsigned*)(ws + WS_CTL);
    const int lane = threadIdx.x & 63, w = threadIdx.x >> 6, wm = w >> 1, wn = w & 1, l15 = lane & 15, lq = lane >> 4;
    const int m0 = blockIdx.y * 64 + wm * 32, n0 = blockIdx.x * 64 + wn * 32;
    constexpr bool DUAL = (EPI == 4 || EPI == 10), MOE = (EPI == 10 || EPI == 11);
    constexpr int K = (EPI == 5 || EPI == 11) ? DFF : DM;
    const bf16* A; const bf16* Bt; int e = 0, row0 = 0, nrows = 256; const int c = p.ph_lo;
    if (MOE) { if (!moe_tile(ctl, c, blockIdx.y >> 2, e, row0, nrows)) return; }
    if (EPI == 1) { A = (const bf16*)(ws + WS_X0); Bt = (const bf16*)(ws + WS_W_IN_E); }
    else if (EPI == 3) { A = (const bf16*)(ws + WS_X0); Bt = (const bf16*)(ws + WS_W_OUT_E); }
    else if (EPI == 4) { A = (const bf16*)(ws + WS_BIG); Bt = (const bf16*)(ws + WS_W_GU_E); }
    else if (EPI == 5) { A = (const bf16*)(ws + WS_HID); Bt = (const bf16*)(ws + WS_W_DN_E); }
    else if (EPI == 6) { A = (const bf16*)(ws + WS_X0); Bt = (const bf16*)(ws + WS_W_IN_O); }
    else if (EPI == 8) { A = (const bf16*)(ws + WS_X0); Bt = (const bf16*)(ws + WS_W_OUT_O); }
    else if (EPI == 10) { A = (const bf16*)(ws + WS_BIG); Bt = (const bf16*)(ws + WS_W_GU_M) + (size_t)e * GU * DM; }
    else { A = (const bf16*)(ws + WS_HID); Bt = (const bf16*)(ws + WS_W_DN_M) + (size_t)e * DM * DFF; }
    const int* list = (const int*)(ws + WS_LIST) + (size_t)(c * 8 + e) * T; const float* glist = (const float*)(ws + WS_GATE) + (size_t)(c * 8 + e) * T;
    const bf16* arow[2];
#pragma unroll
    for (int i = 0; i < 2; ++i) { const int m = m0 + 16 * i + l15;
        if (EPI == 10) { const int r = (m & 255); const int tok = list[row0 + (r < nrows ? r : 0)]; arow[i] = A + (size_t)tok * K; }
        else arow[i] = A + (size_t)m * K; }
    const bf16* brow[2];
#pragma unroll
    for (int j = 0; j < 2; ++j) { const int n = n0 + 16 * j + l15; const int br = DUAL ? ((n >> 7) * 256 + (n & 127)) : n; brow[j] = Bt + (size_t)br * K; }
    f32x4 acc[2][2], acc2[2][2];
#pragma unroll
    for (int i = 0; i < 2; ++i)
#pragma unroll
        for (int j = 0; j < 2; ++j) { acc[i][j] = (f32x4){0.f, 0.f, 0.f, 0.f}; acc2[i][j] = (f32x4){0.f, 0.f, 0.f, 0.f}; }
    for (int k0 = 0; k0 < K; k0 += 32) {
        bf16x8 a[2], b[2], b2[2];
#pragma unroll
        for (int i = 0; i < 2; ++i) a[i] = *(const bf16x8*)(arow[i] + k0 + 8 * lq);
#pragma unroll
        for (int j = 0; j < 2; ++j) { b[j] = *(const bf16x8*)(brow[j] + k0 + 8 * lq); if (DUAL) b2[j] = *(const bf16x8*)(brow[j] + (size_t)128 * K + k0 + 8 * lq); }
#pragma unroll
        for (int i = 0; i < 2; ++i)
#pragma unroll
            for (int j = 0; j < 2; ++j) { acc[i][j] = __builtin_amdgcn_mfma_f32_16x16x32_bf16(a[i], b[j], acc[i][j], 0, 0, 0);
                if (DUAL) acc2[i][j] = __builtin_amdgcn_mfma_f32_16x16x32_bf16(a[i], b2[j], acc2[i][j], 0, 0, 0); }
    }
    const float2* rope = (const float2*)(ws + WS_ROPE);
#pragma unroll
    for (int i = 0; i < 2; ++i)
#pragma unroll
        for (int j = 0; j < 2; ++j)
#pragma unroll
            for (int r = 0; r < 4; ++r) {
                const int m = m0 + 16 * i + 4 * lq + r, n = n0 + 16 * j + l15; float v = acc[i][j][r];
                if (EPI == 1) {
                    bf16* O = (bf16*)(ws + WS_BIG);
                    const float vp = __shfl_xor(v, 1);
                    if (n < 1024) { const float2 cs = rope[(m & (SEQ - 1)) * 32 + ((n & 63) >> 1)];
                        v = (n & 1) ? (vp * cs.y + v * cs.x) : (v * cs.x - vp * cs.y);
                        if (n >= 512) v *= 0.125f; }
                    else if (n >= 2048 && n < 2560) v *= C2;
                    O[(size_t)m * EW + n] = (bf16)f2bf(v);
                } else if (EPI == 3 || EPI == 5 || EPI == 8) {
                    const float* resid = (EPI == 3) ? p.in[0] : p.out; const float o = resid[(size_t)m * DM + n] + v;
                    p.out[(size_t)m * DM + n] = o;
                    bf16* hb = (bf16*)(ws + (EPI == 5 ? WS_X0 : WS_BIG)); hb[(size_t)m * DM + n] = (bf16)f2bf(o);
                } else if (EPI == 4) {
                    const float rs = rstd_from_part((const float*)(ws + WS_PART), m);
                    const float g = v * rs, u = acc2[i][j][r] * rs; ((bf16*)(ws + WS_HID))[(size_t)m * DFF + n] = (bf16)f2bf(silu_f(g) * u);
                } else if (EPI == 6) {
                    const float rs = rstd_from_part((const float*)(ws + WS_PART) + (size_t)T * 16, m); v *= rs;
                    if (n < QKVW) { if (n < 1024) v *= C2; ((bf16*)(ws + WS_BIG))[(size_t)m * QKVW + n] = (bf16)f2bf(v); }
                    else if (n < OW) { const int h = n - QKVW; const float z = v + p.in[11][h]; const float lf = fminf(z, 0.f) - log1pf(__expf(-fabsf(z)));
                        ((float*)(ws + WS_LOGF))[((size_t)(m >> 12) * 16 + h) * SEQ + (m & (SEQ - 1))] = lf; }
                } else if (EPI == 10) {
                    const int rr = m & 255; const int tok = list[row0 + (rr < nrows ? rr : 0)]; const float rs = ((const float*)(ws + WS_RSTD4))[tok];
                    const float g = v * rs, u = acc2[i][j][r] * rs; ((bf16*)(ws + WS_HID))[(size_t)m * DFF + n] = (bf16)f2bf(silu_f(g) * u);
                } else if (EPI == 11) {
                    const int rr = m & 255; if (rr < nrows) { const int tok = list[row0 + rr]; const float gt = glist[row0 + rr]; p.out[(size_t)tok * DM + n] += gt * v; }
                }
            }
}
__global__ void __launch_bounds__(256) nk_retention(Params p) {
    const bf16* P = (const bf16*)(p.ws + WS_BIG); bf16* Y = (bf16*)(p.ws + WS_X0);
    const int gw = blockIdx.x * 4 + (threadIdx.x >> 6), lane = threadIdx.x & 63;
    const int t = gw & (SEQ - 1), h = (gw >> 12) & 7, b = gw >> 15; if (b >= BATCH) return;
    const float lg2 = log2f(1.0f - exp2f(-5.0f - (float)h));
    const size_t rb = (size_t)b * SEQ;
    const float q = bf2f(P[(rb + t) * EW + h * 64 + lane]);
    float o = 0.f;
    for (int s = 0; s <= t; ++s) {
        const float k = bf2f(P[(rb + s) * EW + 512 + h * 64 + lane]), v = bf2f(P[(rb + s) * EW + 1024 + h * 64 + lane]);
        const float d = wave_sum(q * k);
        o += exp2f(lg2 * (float)(t - s)) * d * v;
    }
    const float mu = wave_sum(o) * (1.f / 64.f); const float dv = o - mu; const float var = wave_sum(dv * dv) * (1.f / 64.f);
    const float g = bf2f(P[(rb + t) * EW + 1536 + h * 64 + lane]);
    const float y = dv * (1.0f / sqrtf(var + GN_EPS)) * p.in[3][h * 64 + lane] * silu_f(g);
    Y[(rb + t) * DM + h * 64 + lane] = (bf16)f2bf(y);
}
__global__ void __launch_bounds__(256) nk_stickbreak(Params p) {
    const bf16* P = (const bf16*)(p.ws + WS_BIG); bf16* Y = (bf16*)(p.ws + WS_X0);
    const int gw = blockIdx.x * 4 + (threadIdx.x >> 6), lane = threadIdx.x & 63;
    const int t = gw & (SEQ - 1), h = (gw >> 12) & 7, b = gw >> 15; if (b >= BATCH) return;
    const size_t rb = (size_t)b * SEQ;
    const float q = bf2f(P[(rb + t) * EW + 2048 + h * 64 + lane]);
    float o = 0.f, carry = 0.f;
    for (int s = t - 1; s >= 0; --s) {
        const float k = bf2f(P[(rb + s) * EW + 2560 + h * 64 + lane]), v = bf2f(P[(rb + s) * EW + 3072 + h * 64 + lane]);
        const float y = wave_sum(q * k);
        const float lf2 = -softplus2(y);
        o += __builtin_amdgcn_exp2f(y + lf2 + carry) * v;
        carry += lf2;
    }
    Y[(rb + t) * DM + 512 + h * 64 + lane] = (bf16)f2bf(o);
}
__global__ void __launch_bounds__(128) nk_cumsum(Params p) {
    const int i = threadIdx.x; const float* lf = (const float*)(p.ws + WS_LOGF) + (size_t)i * SEQ; float* cu = (float*)(p.ws + WS_CUM) + (size_t)i * SEQ;
    float s = 0.f; for (int t = 0; t < SEQ; ++t) { s += lf[t]; cu[t] = s; }
}
__global__ void __launch_bounds__(256) nk_fox(Params p) {
    const bf16* P = (const bf16*)(p.ws + WS_BIG); bf16* Y = (bf16*)(p.ws + WS_X0);
    const int gw = blockIdx.x * 4 + (threadIdx.x >> 6), lane = threadIdx.x & 63;
    const int t = gw & (SEQ - 1), h = (gw >> 12) & 15, b = gw >> 16; if (b >= BATCH) return;
    const size_t rb = (size_t)b * SEQ; const float* cu = (const float*)(p.ws + WS_CUM) + ((size_t)b * 16 + h) * SEQ;
    const float q = bf2f(P[(rb + t) * QKVW + h * 64 + lane]);
    const float ct = cu[t]; float m = -INFINITY, l = 0.f, o = 0.f;
    for (int s = 0; s <= t; ++s) {
        const float k = bf2f(P[(rb + s) * QKVW + 1024 + h * 64 + lane]), v = bf2f(P[(rb + s) * QKVW + 2048 + h * 64 + lane]);
        const float x = wave_sum(q * k) + (ct - cu[s]) * LOG2E;
        if (x > m) { const float f = __builtin_amdgcn_exp2f(m - x); l *= f; o *= f; m = x; }
        const float pr = __builtin_amdgcn_exp2f(x - m); l += pr; o += pr * v;
    }
    Y[(rb + t) * DM + h * 64 + lane] = (bf16)f2bf(o / l);
}
__global__ void __launch_bounds__(256) nk_router(Params p) {
    __shared__ unsigned lcnt[16], lbase[16]; __shared__ int tinfo[128][2]; __shared__ float tg[128][2]; __shared__ unsigned tpos[128][2];
    unsigned char* ws = p.ws; unsigned* ctl = (unsigned*)(ws + WS_CTL);
    const int lane = threadIdx.x & 63, w = threadIdx.x >> 6;
    if (threadIdx.x < 16) lcnt[threadIdx.x] = 0u;
    __syncthreads();
    const float* part4 = (const float*)(ws + WS_PART) + (size_t)2 * T * 16;
    for (int i = 0; i < 32; ++i) { const int lt = w * 32 + i, row = blockIdx.x * 128 + lt; int e1, e2; float g1, g2;
        router_row(p.out + (size_t)row * DM, (const float*)(ws + WS_ROUTW), part4, row, (float*)(ws + WS_RSTD4), lane, e1, e2, g1, g2);
        if (lane == 0) { tinfo[lt][0] = e1; tinfo[lt][1] = e2; tg[lt][0] = g1; tg[lt][1] = g2; tpos[lt][0] = atomicAdd(&lcnt[e1], 1u); tpos[lt][1] = atomicAdd(&lcnt[8 + e2], 1u); } }
    __syncthreads();
    if (threadIdx.x < 16) lbase[threadIdx.x] = atomicAdd(&ctl[CW_CNT + 64 * threadIdx.x], lcnt[threadIdx.x]);
    __syncthreads();
    if (threadIdx.x < 256) { const int lt = threadIdx.x >> 1, c = threadIdx.x & 1, e = tinfo[lt][c]; const unsigned pos = lbase[c * 8 + e] + tpos[lt][c];
        ((int*)(ws + WS_LIST))[(size_t)(c * 8 + e) * T + pos] = blockIdx.x * 128 + lt; ((float*)(ws + WS_GATE))[(size_t)(c * 8 + e) * T + pos] = tg[lt][c]; }
}
__global__ void __launch_bounds__(256) nk_final(Params p) {
    const int gw = blockIdx.x * 4 + (threadIdx.x >> 6), ngw = gridDim.x * 4, lane = threadIdx.x & 63;
    for (int m = gw; m < T; m += ngw) final_norm_row(p.out + (size_t)m * DM, p.in[18], lane);
}

namespace pg8 {
#define PG8_LAS __attribute__((address_space(3)))
constexpr int BM = 256, BK = 64, HALF = 128, HTB = HALF * BK * 2, STAGE_BYTES = 8 * HTB, NXCD = 8, WGM = 8;
__host__ __device__ __forceinline__ int lds_byte(int r, int c) { const int st = (r >> 4) * 2 + (c >> 5), rr = r & 15, cc = c & 31, ob = rr * 64 + cc * 2; return st * 1024 + (ob ^ (((ob >> 9) & 1) << 5)); }
__host__ __device__ __forceinline__ void stage_rc(int b, int& R, int& C) { const int st = b / 1024, sb = b % 1024, swz = sb ^ (((sb >> 9) & 1) << 5); R = (st >> 1) * 16 + swz / 64; C = (st & 1) * 32 + (swz % 64) / 2; }
__host__ __device__ __forceinline__ int perm32(int rho) { const int n = rho >> 4, i = rho & 15; return 8 * (i >> 2) + 4 * n + (i & 3); }
struct Unit { int pm, pn; };
struct StaticOrder {
    int nM, nN, nwg, G, c;
    __device__ void init(int nM_, int nN_, int G_, int c_) { nM = nM_; nN = nN_; nwg = nM * nN; G = G_; c = c_; }
    __device__ bool next(int i, Unit& u) const {
        const long L = (long)i * G + c; if (L >= nwg) return false;
        int wgid = (int)L; { const int q = nwg / NXCD, r = nwg % NXCD, xcd = wgid % NXCD, off = wgid / NXCD; wgid = (xcd < r ? xcd * (q + 1) : r * (q + 1) + (xcd - r) * q) + off; }
        const int nig = WGM * nN, gid = wgid / nig, fm = gid * WGM, gsz = (nM - fm) < WGM ? (nM - fm) : WGM;
        u.pm = fm + ((wgid % nig) % gsz); u.pn = (wgid % nig) / gsz; return true;
    }
};
struct ProbDense { const bf16* A; const bf16* Bt; int K; static constexpr bool GATHER = false;
    __device__ __forceinline__ const char* a_tile(const Unit& u) const { return (const char*)A + (size_t)u.pm * BM * K * 2; }
    __device__ __forceinline__ const char* b_tile(const Unit& u) const { return (const char*)Bt + (size_t)u.pn * BM * K * 2; }
    __device__ __forceinline__ void a_offsets(const Unit&, const int (&)[2], const int (&)[2], unsigned (&)[2][2]) const {}
};
struct ProbMoeDown { const bf16* A; const bf16* Bt; int K; size_t estride; const unsigned* ctl; int c; static constexpr bool GATHER = false;
    __device__ __forceinline__ const char* a_tile(const Unit& u) const { return (const char*)A + (size_t)u.pm * BM * K * 2; }
    __device__ __forceinline__ const char* b_tile(const Unit& u) const { int e = 0, r0, nr; moe_tile(ctl, c, u.pm, e, r0, nr); return (const char*)Bt + (size_t)e * estride + (size_t)u.pn * BM * K * 2; }
    __device__ __forceinline__ void a_offsets(const Unit&, const int (&)[2], const int (&)[2], unsigned (&)[2][2]) const {}
};
struct ProbMoeGU { const bf16* A; const bf16* Bt; int K; size_t estride; const unsigned* ctl; int c; const int* lists; static constexpr bool GATHER = true;
    __device__ __forceinline__ const char* a_tile(const Unit&) const { return (const char*)A; }
    __device__ __forceinline__ const char* b_tile(const Unit& u) const { int e = 0, r0, nr; moe_tile(ctl, c, u.pm, e, r0, nr); return (const char*)Bt + (size_t)e * estride + (size_t)u.pn * BM * K * 2; }
    __device__ __forceinline__ void a_offsets(const Unit& u, const int (&RA)[2], const int (&CA)[2], unsigned (&off)[2][2]) const {
        int e = 0, r0 = 0, nr = 1; moe_tile(ctl, c, u.pm, e, r0, nr); const int* l = lists + (size_t)(c * 8 + e) * T + r0;
#pragma unroll
        for (int h = 0; h < 2; ++h)
#pragma unroll
            for (int i = 0; i < 2; ++i) { const int r = h * HALF + RA[i]; const int tok = l[r < nr ? r : 0]; off[h][i] = (unsigned)tok * (unsigned)(K * 2) + (unsigned)(CA[i] * 2); }
    }
};

#define PG8_EARGS const f32x4 (&acc)[2][2][4][2], const Unit& u, int wr, int wc, int fr, int fq
__device__ __forceinline__ u32x4 pack8(const f32x4 a, const f32x4 b) { u32x4 w; w.x = pk2(a[0], a[1]); w.y = pk2(a[2], a[3]); w.z = pk2(b[0], b[1]); w.w = pk2(b[2], b[3]); return w; }
__device__ __forceinline__ float quad_rstd(const float* part, int row, int fq) {
    const f32x4 q = *(const f32x4*)(part + (size_t)row * 16 + 4 * fq); float s = (q[0] + q[1]) + (q[2] + q[3]);
    s += __shfl_xor(s, 16); s += __shfl_xor(s, 32); return 1.0f / sqrtf(s * (1.f / DM) + NORM_EPS);
}
#define PG8_BATCH_FENCE() do { asm volatile("" ::: "memory"); __builtin_amdgcn_sched_barrier(0); } while (0)
struct EpiInEven { static constexpr bool PERM = true; bf16* O; const float2* rope;
    __device__ __forceinline__ void operator()(PG8_EARGS) const {
        const int pn = u.pn, row0 = u.pm * BM + wr * 64 + fr, colb = pn * BM + wc * 32 + 8 * fq;
        if (pn < 4) {
            const float sc = (pn >= 2) ? 0.125f : 1.f;
#pragma unroll
            for (int ai = 0; ai < 2; ++ai) {
                f32x4 cs[4][2];
#pragma unroll
                for (int m = 0; m < 4; ++m) { const int row = row0 + ai * HALF + m * 16; const f32x4* rp = (const f32x4*)(rope + (size_t)(row & (SEQ - 1)) * 32 + 16 * (wc & 1) + 4 * fq); cs[m][0] = rp[0]; cs[m][1] = rp[1]; }
                PG8_BATCH_FENCE();
#pragma unroll
                for (int m = 0; m < 4; ++m) { const int row = row0 + ai * HALF + m * 16; const f32x4 cs0 = cs[m][0], cs1 = cs[m][1];
#pragma unroll
                    for (int bj = 0; bj < 2; ++bj) { const f32x4 v0 = acc[ai][bj][m][0], v1 = acc[ai][bj][m][1]; f32x4 a, b;
                        a[0] = v0[0] * cs0[0] - v0[1] * cs0[1]; a[1] = v0[0] * cs0[1] + v0[1] * cs0[0]; a[2] = v0[2] * cs0[2] - v0[3] * cs0[3]; a[3] = v0[2] * cs0[3] + v0[3] * cs0[2];
                        b[0] = v1[0] * cs1[0] - v1[1] * cs1[1]; b[1] = v1[0] * cs1[1] + v1[1] * cs1[0]; b[2] = v1[2] * cs1[2] - v1[3] * cs1[3]; b[3] = v1[2] * cs1[3] + v1[3] * cs1[2];
                        *(u32x4*)(O + (size_t)row * EW + colb + bj * HALF) = pack8(a * sc, b * sc); } } }
        } else {
            const float sc = (pn == 8 || pn == 9) ? C2 : 1.f;
#pragma unroll
            for (int ai = 0; ai < 2; ++ai)
#pragma unroll
                for (int m = 0; m < 4; ++m) { const int row = row0 + ai * HALF + m * 16;
#pragma unroll
                    for (int bj = 0; bj < 2; ++bj) *(u32x4*)(O + (size_t)row * EW + colb + bj * HALF) = pack8(acc[ai][bj][m][0] * sc, acc[ai][bj][m][1] * sc); }
        }
    }
};
struct EpiResid { static constexpr bool PERM = true; const float* resid; float* out; bf16* hb; float* part;
    __device__ __forceinline__ void operator()(PG8_EARGS) const {
        const int row0 = u.pm * BM + wr * 64 + fr, colb = u.pn * BM + wc * 32 + 8 * fq;
#pragma unroll
        for (int ai = 0; ai < 2; ++ai) {
            f32x4 rr[4][2][2];
#pragma unroll
            for (int m = 0; m < 4; ++m)
#pragma unroll
                for (int bj = 0; bj < 2; ++bj) { const size_t off = (size_t)(row0 + ai * HALF + m * 16) * DM + colb + bj * HALF; rr[m][bj][0] = *(const f32x4*)(resid + off); rr[m][bj][1] = *(const f32x4*)(resid + off + 4); }
            PG8_BATCH_FENCE();
#pragma unroll
            for (int m = 0; m < 4; ++m) { const int row = row0 + ai * HALF + m * 16; float ss = 0.f;
#pragma unroll
                for (int bj = 0; bj < 2; ++bj) { const size_t off = (size_t)row * DM + colb + bj * HALF;
                    const f32x4 o0 = rr[m][bj][0] + acc[ai][bj][m][0], o1 = rr[m][bj][1] + acc[ai][bj][m][1];
                    *(f32x4*)(out + off) = o0; *(f32x4*)(out + off + 4) = o1; *(u32x4*)(hb + off) = pack8(o0, o1);
                    ss += (o0[0] * o0[0] + o0[1] * o0[1]) + (o0[2] * o0[2] + o0[3] * o0[3]) + (o1[0] * o1[0] + o1[1] * o1[1]) + (o1[2] * o1[2] + o1[3] * o1[3]); }
                ss += __shfl_xor(ss, 16); ss += __shfl_xor(ss, 32);
                if (fq == 0) part[(size_t)row * 16 + u.pn * 4 + wc] = ss; }
            PG8_BATCH_FENCE(); }
    }
};
__device__ __forceinline__ float fast_silu(float x) { return x * __builtin_amdgcn_rcpf(1.f + __builtin_amdgcn_exp2f(-LOG2E * x)); }
struct EpiGU { static constexpr bool PERM = true; bf16* hid; const float* part;
    __device__ __forceinline__ void operator()(PG8_EARGS) const {
        const int row0 = u.pm * BM + wr * 64 + fr, colb = u.pn * HALF + wc * 32 + 8 * fq;
        f32x4 q[2][4];
#pragma unroll
        for (int ai = 0; ai < 2; ++ai)
#pragma unroll
            for (int m = 0; m < 4; ++m) q[ai][m] = *(const f32x4*)(part + (size_t)(row0 + ai * HALF + m * 16) * 16 + 4 * fq);
        PG8_BATCH_FENCE();
#pragma unroll
        for (int ai = 0; ai < 2; ++ai)
#pragma unroll
            for (int m = 0; m < 4; ++m) { const int row = row0 + ai * HALF + m * 16; float s = (q[ai][m][0] + q[ai][m][1]) + (q[ai][m][2] + q[ai][m][3]);
                s += __shfl_xor(s, 16); s += __shfl_xor(s, 32); const float rs = 1.0f / sqrtf(s * (1.f / DM) + NORM_EPS);
                f32x4 h0, h1;
#pragma unroll
                for (int e = 0; e < 4; ++e) { h0[e] = fast_silu(acc[ai][0][m][0][e] * rs) * (acc[ai][1][m][0][e] * rs); h1[e] = fast_silu(acc[ai][0][m][1][e] * rs) * (acc[ai][1][m][1][e] * rs); }
                *(u32x4*)(hid + (size_t)row * DFF + colb) = pack8(h0, h1); }
    }
};
struct EpiInOdd { static constexpr bool PERM = true; bf16* O; const float* part; const float* bias; float* logf;
    __device__ __forceinline__ void operator()(PG8_EARGS) const {
        const int pn = u.pn, row0 = u.pm * BM + wr * 64 + fr, colb = pn * BM + wc * 32 + 8 * fq;
        const float sc = pn < 4 ? C2 : 1.f;
        f32x4 q[2][4]; float rs[2][4];
#pragma unroll
        for (int ai = 0; ai < 2; ++ai)
#pragma unroll
            for (int m = 0; m < 4; ++m) q[ai][m] = *(const f32x4*)(part + (size_t)(row0 + ai * HALF + m * 16) * 16 + 4 * fq);
        PG8_BATCH_FENCE();
#pragma unroll
        for (int ai = 0; ai < 2; ++ai)
#pragma unroll
            for (int m = 0; m < 4; ++m) { float s = (q[ai][m][0] + q[ai][m][1]) + (q[ai][m][2] + q[ai][m][3]); s += __shfl_xor(s, 16); s += __shfl_xor(s, 32); rs[ai][m] = 1.0f / sqrtf(s * (1.f / DM) + NORM_EPS); }
        if (pn < 12) {
#pragma unroll
            for (int ai = 0; ai < 2; ++ai)
#pragma unroll
                for (int m = 0; m < 4; ++m) { const int row = row0 + ai * HALF + m * 16;
#pragma unroll
                    for (int bj = 0; bj < 2; ++bj) *(u32x4*)(O + (size_t)row * QKVW + colb + bj * HALF) = pack8(acc[ai][bj][m][0] * (rs[ai][m] * sc), acc[ai][bj][m][1] * (rs[ai][m] * sc)); }
        } else if (wc == 0 && fq < 2) {
            f32x4 b0 = *(const f32x4*)(bias + 8 * fq), b1 = *(const f32x4*)(bias + 8 * fq + 4);
#pragma unroll
            for (int ai = 0; ai < 2; ++ai)
#pragma unroll
                for (int m = 0; m < 4; ++m) { const int row = row0 + ai * HALF + m * 16;
#pragma unroll
                    for (int n = 0; n < 2; ++n)
#pragma unroll
                        for (int e = 0; e < 4; ++e) { const int h = 8 * fq + 4 * n + e; const float z = acc[ai][0][m][n][e] * rs[ai][m] + (n ? b1[e] : b0[e]);
                            logf[((size_t)(row >> 12) * 16 + h) * SEQ + (row & (SEQ - 1))] = fminf(z, 0.f) - __logf(1.f + __expf(-fabsf(z))); } }
        }
    }
};
struct EpiMoeGU { static constexpr bool PERM = true; bf16* hid; const float* rstd4; const unsigned* ctl; int c; const int* lists;
    __device__ __forceinline__ void operator()(PG8_EARGS) const {
        int e = 0, r0 = 0, nr = 1; moe_tile(ctl, c, u.pm, e, r0, nr); const int* l = lists + (size_t)(c * 8 + e) * T + r0;
        const int rl0 = wr * 64 + fr, colb = u.pn * HALF + wc * 32 + 8 * fq;
        int tk[2][4]; float rs[2][4];
#pragma unroll
        for (int ai = 0; ai < 2; ++ai)
#pragma unroll
            for (int m = 0; m < 4; ++m) { const int rl = rl0 + ai * HALF + m * 16; tk[ai][m] = l[rl < nr ? rl : 0]; }
        PG8_BATCH_FENCE();
#pragma unroll
        for (int ai = 0; ai < 2; ++ai)
#pragma unroll
            for (int m = 0; m < 4; ++m) rs[ai][m] = rstd4[tk[ai][m]];
        PG8_BATCH_FENCE();
#pragma unroll
        for (int ai = 0; ai < 2; ++ai)
#pragma unroll
            for (int m = 0; m < 4; ++m) { const int rl = rl0 + ai * HALF + m * 16; const float r = rs[ai][m];
                f32x4 h0, h1;
#pragma unroll
                for (int x = 0; x < 4; ++x) { h0[x] = fast_silu(acc[ai][0][m][0][x] * r) * (acc[ai][1][m][0][x] * r); h1[x] = fast_silu(acc[ai][0][m][1][x] * r) * (acc[ai][1][m][1][x] * r); }
                *(u32x4*)(hid + (size_t)(u.pm * BM + rl) * DFF + colb) = pack8(h0, h1); }
    }
};
struct EpiMoeDown { static constexpr bool PERM = true; float* out; const unsigned* ctl; int c; const int* lists; const float* gates;
    __device__ __forceinline__ void operator()(PG8_EARGS) const {
        int e = 0, r0 = 0, nr = 0; moe_tile(ctl, c, u.pm, e, r0, nr); const int* l = lists + (size_t)(c * 8 + e) * T + r0; const float* g = gates + (size_t)(c * 8 + e) * T + r0;
        const int rl0 = wr * 64 + fr, colb = u.pn * BM + wc * 32 + 8 * fq;
        int tk[2][4]; float gt[2][4];
#pragma unroll
        for (int ai = 0; ai < 2; ++ai)
#pragma unroll
            for (int m = 0; m < 4; ++m) { const int rl = rl0 + ai * HALF + m * 16; const bool ok = rl < nr; tk[ai][m] = l[ok ? rl : 0]; gt[ai][m] = ok ? g[ok ? rl : 0] : 0.f; }
        PG8_BATCH_FENCE();
#pragma unroll
        for (int ai = 0; ai < 2; ++ai) {
            f32x4 rr[4][2][2];
#pragma unroll
            for (int m = 0; m < 4; ++m)
#pragma unroll
                for (int bj = 0; bj < 2; ++bj) { const float* o = out + (size_t)tk[ai][m] * DM + colb + bj * HALF; rr[m][bj][0] = *(const f32x4*)o; rr[m][bj][1] = *(const f32x4*)(o + 4); }
            PG8_BATCH_FENCE();
#pragma unroll
            for (int m = 0; m < 4; ++m) { const int rl = rl0 + ai * HALF + m * 16;
                if (rl < nr) {
#pragma unroll
                    for (int bj = 0; bj < 2; ++bj) { float* o = out + (size_t)tk[ai][m] * DM + colb + bj * HALF;
                        *(f32x4*)o = rr[m][bj][0] + acc[ai][bj][m][0] * gt[ai][m]; *(f32x4*)(o + 4) = rr[m][bj][1] + acc[ai][bj][m][1] * gt[ai][m]; } } }
            PG8_BATCH_FENCE(); }
    }
};

template <class Prob, class Epi, class Sched>
__device__ __forceinline__ void gemm_phase(PG8_LAS unsigned char* lds, const Prob& P, const Sched& S, const Epi& E) {
    const int tid = threadIdx.x, wid = __builtin_amdgcn_readfirstlane(tid >> 6), lane = tid & 63, wr = wid >> 2, wc = wid & 3, fr = lane & 15, fq = lane >> 4;
    const int K = P.K, nt = K / BK;
    unsigned voffA[2], voffB[2]; int RA[2], CA[2];
#pragma unroll
    for (int i = 0; i < 2; ++i) { int R, C; stage_rc(tid * 16 + i * 8192, R, C); const int Rb = Epi::PERM ? ((R & ~31) + perm32(R & 31)) : R;
        voffA[i] = (unsigned)(R * K + C) * 2u; voffB[i] = (unsigned)(Rb * K + C) * 2u; RA[i] = R; CA[i] = C; }
    const size_t kstep = (size_t)(BK * 2);
    const size_t hstep = (size_t)HALF * K * 2;
    const unsigned ldsw = (unsigned)wid * 1024u;
    const int aoff = lds_byte(wr * 64 + fr, fq * 8), boff = lds_byte(wc * 32 + fr, fq * 8);
    unsigned offC[2][2] = {{0u, 0u}, {0u, 0u}}, offN[2][2] = {{0u, 0u}, {0u, 0u}};
#define PG8_SA(b, h) (((b) * 2 + (h)) * HTB)
#define PG8_SB(b, h) ((4 + (b) * 2 + (h)) * HTB)
#define PG8_STAGE(bufoff, gbase, voff) do { _Pragma("unroll") for (int _i = 0; _i < 2; ++_i) \
        __builtin_amdgcn_global_load_lds((const unsigned*)((const char*)(gbase) + (voff)[_i]), (PG8_LAS unsigned*)(lds + (bufoff) + ldsw + _i * 8192), 16, 0, 0); } while (0)
#define PG8_STAGE_A(bufoff, gbase, h, nx) do { _Pragma("unroll") for (int _i = 0; _i < 2; ++_i) { \
        const size_t _o = Prob::GATHER ? (size_t)((nx) ? offN[h][_i] : offC[h][_i]) : (size_t)voffA[_i] + (size_t)(h) * hstep; \
        __builtin_amdgcn_global_load_lds((const unsigned*)((const char*)(gbase) + _o), (PG8_LAS unsigned*)(lds + (bufoff) + ldsw + _i * 8192), 16, 0, 0); } } while (0)
#define PG8_LDA(dst, b, h) do { _Pragma("unroll") for (int m = 0; m < 4; ++m) _Pragma("unroll") for (int k = 0; k < 2; ++k) dst[m][k] = *(const PG8_LAS bf16x8*)(lds + PG8_SA(b, h) + aoff + m * 2048 + k * 1024); } while (0)
#define PG8_LDB(dst, b, h) do { _Pragma("unroll") for (int n = 0; n < 2; ++n) _Pragma("unroll") for (int k = 0; k < 2; ++k) dst[n][k] = *(const PG8_LAS bf16x8*)(lds + PG8_SB(b, h) + boff + n * 2048 + k * 1024); } while (0)
#define PG8_MMA(ai, bj, At, Bt) do { __builtin_amdgcn_s_setprio(1); _Pragma("unroll") for (int m = 0; m < 4; ++m) _Pragma("unroll") for (int n = 0; n < 2; ++n) _Pragma("unroll") for (int k = 0; k < 2; ++k) \
        acc[ai][bj][m][n] = __builtin_amdgcn_mfma_f32_16x16x32_bf16(Bt[n][k], At[m][k], acc[ai][bj][m][n], 0, 0, 0); __builtin_amdgcn_s_setprio(0); } while (0)
#define PG8_WAIT_V(n) asm volatile("s_waitcnt vmcnt(" #n ")" ::: "memory")
#define PG8_WAIT_L(n) asm volatile("s_waitcnt lgkmcnt(" #n ")" ::: "memory")
#define PG8_BAR __builtin_amdgcn_s_barrier()
#define PG8_SCHED __builtin_amdgcn_sched_barrier(0)
    Unit cur, nxt; int ui = 0;
    if (!S.next(0, cur)) return;
    f32x4 acc[2][2][4][2];
#pragma unroll
    for (int a = 0; a < 2; ++a)
#pragma unroll
        for (int b = 0; b < 2; ++b)
#pragma unroll
            for (int m = 0; m < 4; ++m)
#pragma unroll
                for (int n = 0; n < 2; ++n) acc[a][b][m][n] = (f32x4){0.f, 0.f, 0.f, 0.f};
    bf16x8 At[4][2], B0[2][2], B1[2][2];
    const char* cA = P.a_tile(cur); const char* cB = P.b_tile(cur);
    if constexpr (Prob::GATHER) P.a_offsets(cur, RA, CA, offC);
    PG8_STAGE(PG8_SB(0, 0), cB, voffB); PG8_STAGE(PG8_SB(0, 1), cB + hstep, voffB); PG8_STAGE_A(PG8_SA(0, 0), cA, 0, false); PG8_STAGE_A(PG8_SA(0, 1), cA, 1, false);
    if (wr == 1) PG8_BAR;
    PG8_WAIT_V(2); PG8_BAR;
    PG8_STAGE(PG8_SB(1, 0), cB + kstep, voffB); PG8_STAGE_A(PG8_SA(1, 0), cA + kstep, 0, false); PG8_STAGE(PG8_SB(1, 1), cB + hstep + kstep, voffB);
    PG8_WAIT_V(6); PG8_BAR;
    for (;;) {
        const bool has_next = S.next(ui + 1, nxt);
        const char* nA = has_next ? P.a_tile(nxt) : cA; const char* nB = has_next ? P.b_tile(nxt) : cB;
        if constexpr (Prob::GATHER) { if (has_next) P.a_offsets(nxt, RA, CA, offN); else {
#pragma unroll
            for (int h = 0; h < 2; ++h)
#pragma unroll
                for (int i = 0; i < 2; ++i) offN[h][i] = offC[h][i]; } }
        for (int t = 0; t < nt; t += 2) {
            const bool last = (t == nt - 2);
            const char* a1 = cA + (size_t)(t + 1) * kstep;
            const char* a2 = last ? nA : cA + (size_t)(t + 2) * kstep; const char* b2 = last ? nB : cB + (size_t)(t + 2) * kstep;
            const char* a3 = a2 + kstep; const char* b3 = b2 + kstep;
            PG8_LDB(B0, 0, 0); PG8_LDB(B1, 0, 1); PG8_SCHED; PG8_LDA(At, 0, 0); PG8_STAGE_A(PG8_SA(1, 1), a1, 1, false);
            PG8_WAIT_V(8); PG8_WAIT_L(0); PG8_BAR; PG8_MMA(0, 0, At, B0); PG8_MMA(0, 1, At, B1); PG8_BAR; PG8_SCHED;
            PG8_LDA(At, 0, 1); PG8_STAGE(PG8_SB(0, 0), b2, voffB); PG8_STAGE(PG8_SB(0, 1), b2 + hstep, voffB); PG8_STAGE_A(PG8_SA(0, 0), a2, 0, last);
            PG8_WAIT_V(8); PG8_WAIT_L(0); PG8_BAR; PG8_MMA(1, 0, At, B0); PG8_MMA(1, 1, At, B1); PG8_BAR; PG8_SCHED;
            PG8_LDB(B0, 1, 0); PG8_LDB(B1, 1, 1); PG8_SCHED; PG8_LDA(At, 1, 0); PG8_STAGE_A(PG8_SA(0, 1), a2, 1, last);
            PG8_WAIT_V(8); PG8_WAIT_L(0); PG8_BAR; PG8_MMA(0, 0, At, B0); PG8_MMA(0, 1, At, B1); PG8_BAR; PG8_SCHED;
            PG8_LDA(At, 1, 1); PG8_STAGE(PG8_SB(1, 0), b3, voffB); PG8_STAGE(PG8_SB(1, 1), b3 + hstep, voffB); PG8_STAGE_A(PG8_SA(1, 0), a3, 0, last);
            PG8_WAIT_V(8); PG8_WAIT_L(0); PG8_BAR; PG8_MMA(1, 0, At, B0); PG8_MMA(1, 1, At, B1); PG8_BAR; PG8_SCHED;
        }
        if (wr == 0) PG8_BAR;
        E(acc, cur, wr, wc, fr, fq);
        if (!has_next) break;
#pragma unroll
        for (int a = 0; a < 2; ++a)
#pragma unroll
            for (int b = 0; b < 2; ++b)
#pragma unroll
                for (int m = 0; m < 4; ++m)
#pragma unroll
                    for (int n = 0; n < 2; ++n) acc[a][b][m][n] = (f32x4){0.f, 0.f, 0.f, 0.f};
        cur = nxt; cA = nA; cB = nB; ++ui;
        if constexpr (Prob::GATHER) {
#pragma unroll
            for (int h = 0; h < 2; ++h)
#pragma unroll
                for (int i = 0; i < 2; ++i) offC[h][i] = offN[h][i]; }
        if (wr == 1) PG8_BAR;
    }
    PG8_WAIT_V(0);
    PG8_BAR;
#undef PG8_SA
#undef PG8_SB
#undef PG8_STAGE
#undef PG8_STAGE_A
#undef PG8_LDA
#undef PG8_LDB
#undef PG8_MMA
#undef PG8_WAIT_V
#undef PG8_WAIT_L
#undef PG8_BAR
#undef PG8_SCHED
}
}
namespace att {
#define ALAS __attribute__((address_space(3)))
typedef _Float16 f16x8 __attribute__((ext_vector_type(8)));
typedef short s16x4 __attribute__((ext_vector_type(4)));
typedef short v4i16_t __attribute__((ext_vector_type(4)));
constexpr int KSTR = 144, VSTR = 192;
constexpr int KT_BYTES = 64 * KSTR, VT_BYTES = 64 * VSTR, STAGE = KT_BYTES + VT_BYTES;
constexpr int FLAG_OFF = 2 * STAGE;
constexpr int CUM_OFF = 49152;
constexpr float EXIT_T = -152.0f;
__device__ __forceinline__ int crow(int r, int hi) { return (r & 3) + 8 * (r >> 2) + 4 * hi; }
__device__ __forceinline__ bf16x8 vtr2(const ALAS unsigned char* p0, const ALAS unsigned char* p1) {
    const s16x4 a = __builtin_bit_cast(s16x4, __builtin_amdgcn_ds_read_tr16_b64_v4i16((ALAS v4i16_t*)p0));
    const s16x4 b = __builtin_bit_cast(s16x4, __builtin_amdgcn_ds_read_tr16_b64_v4i16((ALAS v4i16_t*)p1));
    return (bf16x8){a[0], a[1], a[2], a[3], b[0], b[1], b[2], b[3]};
}
__device__ __forceinline__ bf16x8 packbf8(const f32x16& p, int b) { u32x4 w; w.x = pk2(p[b], p[b + 1]); w.y = pk2(p[b + 2], p[b + 3]); w.z = pk2(p[b + 4], p[b + 5]); w.w = pk2(p[b + 6], p[b + 7]); return __builtin_bit_cast(bf16x8, w); }
__device__ __forceinline__ f16x8 packh8(const f32x16& p, int b) { f16x8 h;
#pragma unroll
    for (int j = 0; j < 8; ++j) h[j] = (_Float16)p[b + j];
    return h; }
__device__ __forceinline__ void pv_tile(f32x16 (&o)[2], const ALAS unsigned char* vb, int vl, const bf16x8 (&pb)[4]) {
#pragma unroll
    for (int dh = 0; dh < 2; ++dh)
#pragma unroll
        for (int s = 0; s < 4; ++s) { const ALAS unsigned char* a = vb + vl + (16 * s) * VSTR + dh * 64;
            o[dh] = __builtin_amdgcn_mfma_f32_32x32x16_bf16(vtr2(a, a + 8 * VSTR), pb[s], o[dh], 0, 0, 0); }
}
template <int MODE>
__device__ __forceinline__ void unit(ALAS unsigned char* lds, const bf16* Q, const bf16* K, const bf16* V, int pitch, bf16* O, size_t rowbase, int q0, const ALAS float* cum2) {
    const int tid = threadIdx.x, lane = tid & 63, r32 = lane & 31, hi = lane >> 5, wid = __builtin_amdgcn_readfirstlane(tid >> 6);
    const int R0 = q0 + 32 * wid, qrow = R0 + r32;
    bf16x8 qr[4];
#pragma unroll
    for (int d0 = 0; d0 < 4; ++d0) qr[d0] = *(const bf16x8*)(Q + (rowbase + qrow) * pitch + 16 * d0 + 8 * hi);
    const int srow = tid >> 3, sch = tid & 7;
    const bf16* kg = K + (rowbase + srow) * pitch + sch * 8; const bf16* vg = V + (rowbase + srow) * pitch + sch * 8;
    const int kdst = srow * KSTR + sch * 16, vdst = KT_BYTES + srow * VSTR + sch * 16;
    const int kl = r32 * KSTR + 16 * hi;
    const int vl = (4 * hi + ((lane & 15) >> 2)) * VSTR + (16 * ((lane >> 4) & 1) + 4 * (lane & 3)) * 2;
    ALAS unsigned* flags = (ALAS unsigned*)(lds + FLAG_OFF);
    const int jtop = (q0 >> 6) + 3;
    u32x4 kreg = *(const u32x4*)(kg + (size_t)jtop * 64 * pitch), vreg = *(const u32x4*)(vg + (size_t)jtop * 64 * pitch);
    *(ALAS u32x4*)(lds + kdst) = kreg; *(ALAS u32x4*)(lds + vdst) = vreg;
    __syncthreads();
    f32x16 o[2];
#pragma unroll
    for (int r = 0; r < 16; ++r) { o[0][r] = 0.f; o[1][r] = 0.f; }
    float carry = 0.f, m = -INFINITY, l = 0.f;
    const float cq = (MODE == 1) ? cum2[qrow] : 0.f;
    f16x8 M0, M1, ONES;
#pragma unroll
    for (int j = 0; j < 8; ++j) { const int kk = 8 * (j >> 2) + 4 * hi + (j & 3); M0[j] = (kk > r32) ? (_Float16)1.f : (_Float16)0.f; M1[j] = (16 + kk > r32) ? (_Float16)1.f : (_Float16)0.f; ONES[j] = (_Float16)1.f; }
    int cur = 0;
    for (int j = jtop; j >= 0; --j) {
        const bool more = j > 0;
        if (more) { kreg = *(const u32x4*)(kg + (size_t)(j - 1) * 64 * pitch); vreg = *(const u32x4*)(vg + (size_t)(j - 1) * 64 * pitch); }
        const ALAS unsigned char* kb = lds + cur * STAGE; const ALAS unsigned char* vb = kb + KT_BYTES;
        const int key0 = 64 * j;
        if (key0 <= R0 + 31) {
            const bool diag = key0 + 63 >= R0;
            f32x16 p0, p1;
#pragma unroll
            for (int r = 0; r < 16; ++r) { p0[r] = 0.f; p1[r] = 0.f; }
#pragma unroll
            for (int d0 = 0; d0 < 4; ++d0) { const bf16x8 ka = *(const ALAS bf16x8*)(kb + kl + 32 * d0), kc = *(const ALAS bf16x8*)(kb + kl + 32 * KSTR + 32 * d0);
                p0 = __builtin_amdgcn_mfma_f32_32x32x16_bf16(ka, qr[d0], p0, 0, 0, 0); p1 = __builtin_amdgcn_mfma_f32_32x32x16_bf16(kc, qr[d0], p1, 0, 0, 0); }
            bf16x8 pb[4];
            if (MODE == 0) {
                f32x16 l0, l1; float rs = 0.f;
#pragma unroll
                for (int r = 0; r < 16; ++r) { const int key = key0 + crow(r, hi);
                    float a = -softplus2(p0[r]), b = -softplus2(p1[r]);
                    if (diag) { if (!(key < qrow)) a = 0.f; if (!(key + 32 < qrow)) b = 0.f; }
                    l0[r] = a; l1[r] = b; rs += a + b; }
                rs += __shfl_xor(rs, 32);
                const f16x8 lb0 = packh8(l0, 0), lb1 = packh8(l0, 8), lb2 = packh8(l1, 0), lb3 = packh8(l1, 8);
                f32x16 c0, c1;
#pragma unroll
                for (int r = 0; r < 16; ++r) { c0[r] = carry; c1[r] = carry; }
                c0 = __builtin_amdgcn_mfma_f32_32x32x16_f16(M0, lb0, c0, 0, 0, 0); c0 = __builtin_amdgcn_mfma_f32_32x32x16_f16(M1, lb1, c0, 0, 0, 0);
                c0 = __builtin_amdgcn_mfma_f32_32x32x16_f16(ONES, lb2, c0, 0, 0, 0); c0 = __builtin_amdgcn_mfma_f32_32x32x16_f16(ONES, lb3, c0, 0, 0, 0);
                c1 = __builtin_amdgcn_mfma_f32_32x32x16_f16(M0, lb2, c1, 0, 0, 0); c1 = __builtin_amdgcn_mfma_f32_32x32x16_f16(M1, lb3, c1, 0, 0, 0);
#pragma unroll
                for (int r = 0; r < 16; ++r) { const int key = key0 + crow(r, hi);
                    float a = __builtin_amdgcn_exp2f(p0[r] + l0[r] + c0[r]), b = __builtin_amdgcn_exp2f(p1[r] + l1[r] + c1[r]);
                    if (diag) { if (!(key < qrow)) a = 0.f; if (!(key + 32 < qrow)) b = 0.f; }
                    p0[r] = a; p1[r] = b; }
                carry += rs;
            } else {
#pragma unroll
                for (int g = 0; g < 4; ++g) { const f32x4 cb0 = *(const ALAS f32x4*)(cum2 + key0 + 8 * g + 4 * hi), cb1 = *(const ALAS f32x4*)(cum2 + key0 + 32 + 8 * g + 4 * hi);
#pragma unroll
                    for (int e = 0; e < 4; ++e) { p0[4 * g + e] = (p0[4 * g + e] + cq) - cb0[e]; p1[4 * g + e] = (p1[4 * g + e] + cq) - cb1[e]; } }
                if (diag) {
#pragma unroll
                    for (int r = 0; r < 16; ++r) { const int key = key0 + crow(r, hi); if (key > qrow) p0[r] = -INFINITY; if (key + 32 > qrow) p1[r] = -INFINITY; } }
                float mt = fmaxf(p0[0], p1[0]);
#pragma unroll
                for (int r = 1; r < 16; ++r) mt = fmaxf(mt, fmaxf(p0[r], p1[r]));
                mt = fmaxf(mt, __shfl_xor(mt, 32));
                if (__any(mt > m)) { const float mn = fmaxf(m, mt); const float f = __builtin_amdgcn_exp2f(m - mn); l *= f; o[0] = o[0] * f; o[1] = o[1] * f; m = mn; }
                float ls = 0.f;
#pragma unroll
                for (int r = 0; r < 16; ++r) { p0[r] = __builtin_amdgcn_exp2f(p0[r] - m); p1[r] = __builtin_amdgcn_exp2f(p1[r] - m); ls += p0[r] + p1[r]; }
                l += ls;
            }
            pb[0] = packbf8(p0, 0); pb[1] = packbf8(p0, 8); pb[2] = packbf8(p1, 0); pb[3] = packbf8(p1, 8);
            pv_tile(o, vb, vl, pb);
        }
        if (more) { *(ALAS u32x4*)(lds + (cur ^ 1) * STAGE + kdst) = kreg; *(ALAS u32x4*)(lds + (cur ^ 1) * STAGE + vdst) = vreg; }
        if (MODE == 0) { const bool done = __all(carry < EXIT_T); if (lane == 0) flags[cur * 8 + wid] = done ? 1u : 0u; }
        __syncthreads();
        if (MODE == 0) { unsigned a = 1u;
#pragma unroll
            for (int w = 0; w < 8; ++w) a &= flags[cur * 8 + w];
            if (a) break; }
        cur ^= 1;
    }
    float inv = 1.f;
    if (MODE == 1) { l += __shfl_xor(l, 32); inv = 1.0f / l; }
    bf16* orow = O + (rowbase + qrow) * DM;
#pragma unroll
    for (int dh = 0; dh < 2; ++dh)
#pragma unroll
        for (int g = 0; g < 4; ++g) { u32x2 w; w.x = pk2(o[dh][4 * g] * inv, o[dh][4 * g + 1] * inv); w.y = pk2(o[dh][4 * g + 2] * inv, o[dh][4 * g + 3] * inv);
            *(u32x2*)(orow + 32 * dh + 8 * g + 4 * hi) = w; }
    __syncthreads();
}
__device__ __forceinline__ void fox_cum(ALAS float* cum2, const float* lf) {
    const int tid = threadIdx.x, lane = tid & 63, wid = tid >> 6;
    ALAS float* wtot = cum2 + 4096;
    const f32x4 a = *(const f32x4*)(lf + tid * 8), b = *(const f32x4*)(lf + tid * 8 + 4);
    float v[8] = {a[0], a[1], a[2], a[3], b[0], b[1], b[2], b[3]};
#pragma unroll
    for (int i = 1; i < 8; ++i) v[i] += v[i - 1];
    float inc = v[7];
#pragma unroll
    for (int o = 1; o < 64; o <<= 1) { const float n = __shfl_up(inc, o); if (lane >= o) inc += n; }
    if (lane == 63) wtot[wid] = inc;
    __syncthreads();
    float base = inc - v[7];
    for (int w = 0; w < wid; ++w) base += wtot[w];
#pragma unroll
    for (int i = 0; i < 8; ++i) cum2[tid * 8 + i] = (v[i] + base) * LOG2E;
    __syncthreads();
}

constexpr int RSTR = 192;
__device__ __forceinline__ void ret_pass_a(ALAS unsigned char* lds, const bf16* P  , float* loc, float* grp, int bh, int g) {
    const int tid = threadIdx.x, lane = tid & 63, r32 = lane & 31, hi = lane >> 5, wid = __builtin_amdgcn_readfirstlane(tid >> 6);
    const int b = bh >> 3, h = bh & 7; const size_t rowbase = (size_t)b * SEQ;
    const float lg2 = log2f(1.0f - exp2f(-5.0f - (float)h)); const float cd = exp2f(128.f * lg2);
    ALAS unsigned char* kt = lds; ALAS unsigned char* vt = lds + 128 * RSTR;
    const int eh = wid >> 1, dh = wid & 1;
    const int tl = (4 * hi + ((lane & 15) >> 2)) * RSTR + (16 * ((lane >> 4) & 1) + 4 * (lane & 3)) * 2;
    f32x16 R;
#pragma unroll
    for (int r = 0; r < 16; ++r) R[r] = 0.f;
    for (int j = 0; j < 4; ++j) { const int n = 4 * g + j; const size_t tok0 = rowbase + (size_t)n * 128;
#pragma unroll
        for (int i = 0; i < 2; ++i) { const int idx = tid + 512 * i, row = idx >> 3, ch = idx & 7;
            const u32x4 kk = *(const u32x4*)(P + (tok0 + row) * EW + 512 + h * 64 + ch * 8), vv = *(const u32x4*)(P + (tok0 + row) * EW + 1024 + h * 64 + ch * 8);
            const float dk = exp2f((float)(127 - row) * lg2); u32x4 kd;
            kd.x = pk2(bf2f(kk.x & 0xffff) * dk, bf2f(kk.x >> 16) * dk); kd.y = pk2(bf2f(kk.y & 0xffff) * dk, bf2f(kk.y >> 16) * dk);
            kd.z = pk2(bf2f(kk.z & 0xffff) * dk, bf2f(kk.z >> 16) * dk); kd.w = pk2(bf2f(kk.w & 0xffff) * dk, bf2f(kk.w >> 16) * dk);
            *(ALAS u32x4*)(kt + row * RSTR + ch * 16) = kd; *(ALAS u32x4*)(vt + row * RSTR + ch * 16) = vv; }
        __syncthreads();
        if (wid < 4) {
            float* lo = loc + ((size_t)bh * 32 + n) * 4096;
#pragma unroll
            for (int r = 0; r < 16; ++r) lo[(32 * eh + crow(r, hi)) * 64 + 32 * dh + r32] = R[r];
            R = R * cd;
#pragma unroll
            for (int s = 0; s < 8; ++s) { const ALAS unsigned char* va = vt + tl + (16 * s) * RSTR + eh * 64; const ALAS unsigned char* ka = kt + tl + (16 * s) * RSTR + dh * 64;
                R = __builtin_amdgcn_mfma_f32_32x32x16_bf16(vtr2(va, va + 8 * RSTR), vtr2(ka, ka + 8 * RSTR), R, 0, 0, 0); }
        }
        __syncthreads();
    }
    if (wid < 4) { float* go = grp + ((size_t)bh * 8 + g) * 4096;
#pragma unroll
        for (int r = 0; r < 16; ++r) go[(32 * eh + crow(r, hi)) * 64 + 32 * dh + r32] = R[r]; }
}
constexpr int RB_Q = 0, RB_K = 128 * KSTR, RB_G = 2 * 128 * KSTR, RB_V = 3 * 128 * KSTR, RB_S = RB_V + 128 * RSTR, RB_RED = RB_S + 64 * KSTR;
__device__ __forceinline__ void ret_pass_b(ALAS unsigned char* lds, const bf16* P, const float* loc, const float* grp, const float* retnorm, bf16* Y, int bh, int n) {
    const int tid = threadIdx.x, lane = tid & 63, r32 = lane & 31, hi = lane >> 5, wid = __builtin_amdgcn_readfirstlane(tid >> 6);
    const int b = bh >> 3, h = bh & 7; const size_t tok0 = (size_t)b * SEQ + (size_t)n * 128;
    const float lg2 = log2f(1.0f - exp2f(-5.0f - (float)h)); const float cd = exp2f(128.f * lg2), cd4 = exp2f(512.f * lg2);
    const int g = n >> 2, j = n & 3;
    { const int e = tid >> 3, d0 = (tid & 7) * 8; const size_t off = (size_t)e * 64 + d0;
      f32x4 s0 = {0.f, 0.f, 0.f, 0.f}, s1 = {0.f, 0.f, 0.f, 0.f};
      for (int gp = 0; gp < g; ++gp) { const float* gs = grp + ((size_t)bh * 8 + gp) * 4096 + off; s0 = s0 * cd4 + *(const f32x4*)gs; s1 = s1 * cd4 + *(const f32x4*)(gs + 4); }
      const float cj = exp2f(128.f * (float)j * lg2); const float* lo = loc + ((size_t)bh * 32 + n) * 4096 + off;
      s0 = s0 * cj + *(const f32x4*)lo; s1 = s1 * cj + *(const f32x4*)(lo + 4);
      u32x4 w; w.x = pk2(s0[0], s0[1]); w.y = pk2(s0[2], s0[3]); w.z = pk2(s1[0], s1[1]); w.w = pk2(s1[2], s1[3]);
      *(ALAS u32x4*)(lds + RB_S + e * KSTR + d0 * 2) = w; }
#pragma unroll
    for (int i = 0; i < 2; ++i) { const int idx = tid + 512 * i, row = idx >> 3, ch = idx & 7; const bf16* src = P + (tok0 + row) * EW + h * 64 + ch * 8;
        *(ALAS u32x4*)(lds + RB_Q + row * KSTR + ch * 16) = *(const u32x4*)src; *(ALAS u32x4*)(lds + RB_K + row * KSTR + ch * 16) = *(const u32x4*)(src + 512);
        *(ALAS u32x4*)(lds + RB_V + row * RSTR + ch * 16) = *(const u32x4*)(src + 1024); *(ALAS u32x4*)(lds + RB_G + row * KSTR + ch * 16) = *(const u32x4*)(src + 1536); }
    __syncthreads();
    const int qb = wid & 3, eh = wid >> 2, qloc = 32 * qb + r32;
    const int tl = (4 * hi + ((lane & 15) >> 2)) * RSTR + (16 * ((lane >> 4) & 1) + 4 * (lane & 3)) * 2;
    bf16x8 qf[4];
#pragma unroll
    for (int d0 = 0; d0 < 4; ++d0) qf[d0] = *(const ALAS bf16x8*)(lds + RB_Q + qloc * KSTR + 32 * d0 + 16 * hi);
    float dloc[16];
#pragma unroll
    for (int r = 0; r < 16; ++r) dloc[r] = exp2f((float)(r32 - crow(r, hi)) * lg2);
    f32x16 ain, acr;
#pragma unroll
    for (int r = 0; r < 16; ++r) { ain[r] = 0.f; acr[r] = 0.f; }
    for (int kt = 0; kt <= qb; ++kt) {
        f32x16 s;
#pragma unroll
        for (int r = 0; r < 16; ++r) s[r] = 0.f;
#pragma unroll
        for (int d0 = 0; d0 < 4; ++d0) s = __builtin_amdgcn_mfma_f32_32x32x16_bf16(*(const ALAS bf16x8*)(lds + RB_K + (32 * kt + r32) * KSTR + 32 * d0 + 16 * hi), qf[d0], s, 0, 0, 0);
        const float fac = exp2f(32.f * (float)(qb - kt) * lg2);
#pragma unroll
        for (int r = 0; r < 16; ++r) { float v = s[r] * (dloc[r] * fac); if (kt == qb && crow(r, hi) > r32) v = 0.f; s[r] = v; }
        const bf16x8 pb0 = packbf8(s, 0), pb1 = packbf8(s, 8);
        const ALAS unsigned char* va = lds + RB_V + tl + (32 * kt) * RSTR + eh * 64;
        ain = __builtin_amdgcn_mfma_f32_32x32x16_bf16(vtr2(va, va + 8 * RSTR), pb0, ain, 0, 0, 0);
        ain = __builtin_amdgcn_mfma_f32_32x32x16_bf16(vtr2(va + 16 * RSTR, va + 24 * RSTR), pb1, ain, 0, 0, 0);
    }
#pragma unroll
    for (int d0 = 0; d0 < 4; ++d0) acr = __builtin_amdgcn_mfma_f32_32x32x16_bf16(*(const ALAS bf16x8*)(lds + RB_S + (32 * eh + r32) * KSTR + 32 * d0 + 16 * hi), qf[d0], acr, 0, 0, 0);
    const float qd = exp2f((float)(qloc + 1) * lg2);
    float s1 = 0.f, s2 = 0.f;
#pragma unroll
    for (int r = 0; r < 16; ++r) { const float v = ain[r] + qd * acr[r]; ain[r] = v; s1 += v; s2 += v * v; }
    s1 += __shfl_xor(s1, 32); s2 += __shfl_xor(s2, 32);
    ALAS float* red = (ALAS float*)(lds + RB_RED);
    if (hi == 0) { red[(wid * 32 + r32) * 2] = s1; red[(wid * 32 + r32) * 2 + 1] = s2; }
    __syncthreads();
    { const int pw = wid ^ 4; s1 += red[(pw * 32 + r32) * 2]; s2 += red[(pw * 32 + r32) * 2 + 1]; }
    const float mu = s1 * (1.f / 64.f); const float var = fmaxf(s2 * (1.f / 64.f) - mu * mu, 0.f); const float rstd = 1.0f / sqrtf(var + GN_EPS);
    bf16* yrow = Y + (tok0 + qloc) * DM + h * 64 + 32 * eh;
#pragma unroll
    for (int gq = 0; gq < 4; ++gq) { const int e0 = 8 * gq + 4 * hi;
        const u32x2 gv = *(const ALAS u32x2*)(lds + RB_G + qloc * KSTR + (32 * eh + e0) * 2); const f32x4 rn = *(const f32x4*)(retnorm + h * 64 + 32 * eh + e0);
        const float g0 = bf2f(gv.x & 0xffff), g1 = bf2f(gv.x >> 16), g2 = bf2f(gv.y & 0xffff), g3 = bf2f(gv.y >> 16);
        u32x2 w; w.x = pk2((ain[4 * gq] - mu) * rstd * rn[0] * silu_f(g0), (ain[4 * gq + 1] - mu) * rstd * rn[1] * silu_f(g1));
        w.y = pk2((ain[4 * gq + 2] - mu) * rstd * rn[2] * silu_f(g2), (ain[4 * gq + 3] - mu) * rstd * rn[3] * silu_f(g3));
        *(u32x2*)(yrow + e0) = w; }
    __syncthreads();
}
#undef ALAS
}
#define LAS __attribute__((address_space(3)))
#define XB_TMO      128
#define XB_XCNT(j)  (256  + 64 * (j))
#define XB_XSUB(j)  (1280 + 64 * (j))
#define XB_XGEN(j)  (2304 + 64 * (j))
#define XB_TOP      3328
#define XB_TOPGEN   3392
#define XCD_BAR_WORDS 3456
#define XB_SPIN_CAP (1u << 23)
__device__ __forceinline__ unsigned xb_ld(unsigned* p)              { return __hip_atomic_load(p, __ATOMIC_RELAXED, __HIP_MEMORY_SCOPE_AGENT); }
__device__ __forceinline__ unsigned xb_add(unsigned* p, unsigned v) { return __hip_atomic_fetch_add(p, v, __ATOMIC_RELAXED, __HIP_MEMORY_SCOPE_AGENT); }
__device__ __forceinline__ unsigned xb_xcc_id() { return (unsigned)__builtin_amdgcn_s_getreg((3 << 11) | 20) & 0xFu; }
#define XB_SPIN(cond, bar) do { unsigned _sp = 0; while (cond) { __builtin_amdgcn_s_sleep(1); \
    if ((++_sp & 255u) == 0u) { if (xb_ld(&(bar)[XB_TMO])) break; if (_sp > XB_SPIN_CAP) { atomicAdd(&(bar)[XB_TMO], 1u); break; } } } } while (0)
struct XcdBarrier { unsigned* bar; unsigned x; volatile LAS unsigned* st; };
__device__ __forceinline__ XcdBarrier xcd_barrier_post(unsigned* bar, volatile LAS unsigned* st) {
    XcdBarrier b; b.bar = bar; b.x = xb_xcc_id(); b.st = st;
    if (threadIdx.x == 0) (void)xb_add(&bar[XB_XCNT(b.x)], 1u);
    return b;
}
__device__ __forceinline__ void xcd_barrier_complete(unsigned* bar, unsigned x, unsigned& nloc, unsigned& nx) {
    const unsigned G = gridDim.x * gridDim.y * gridDim.z;
    unsigned sum, cnt, mine, sp = 0u;
    for (;;) {
        sum = 0u; cnt = 0u; mine = 0u;
#pragma unroll
        for (unsigned j = 0; j < 16; ++j) { const unsigned c = xb_ld(&bar[XB_XCNT(j)]); sum += c; cnt += (c > 0u) ? 1u : 0u; mine = (j == x) ? c : mine; }
        if (sum == G) break;
        __builtin_amdgcn_s_sleep(1);
        if ((++sp & 255u) == 0u) { if (xb_ld(&bar[XB_TMO])) break; if (sp > XB_SPIN_CAP) { atomicAdd(&bar[XB_TMO], 1u); break; } }
    }
    nloc = mine > 0u ? mine : 1u; nx = cnt > 0u ? cnt : 1u;
}
__device__ __forceinline__ void xcd_barrier(const XcdBarrier& b) {
    asm volatile("s_waitcnt vmcnt(0)" ::: "memory");
    __syncthreads();
    if (threadIdx.x == 0) {
        unsigned* bar = b.bar;
        __builtin_amdgcn_s_waitcnt(0);
        unsigned nloc = b.st[0], nx = b.st[1];
        if (nloc == 0u) { xcd_barrier_complete(bar, b.x, nloc, nx); b.st[0] = nloc; b.st[1] = nx; }
        const unsigned old = xb_add(&bar[XB_XSUB(b.x)], 1u);
        const unsigned gen = old / nloc;
        if (old + 1u == (gen + 1u) * nloc) {
            __builtin_amdgcn_fence(__ATOMIC_RELEASE, "agent");
            asm volatile("s_waitcnt vmcnt(0)" ::: "memory");
            const unsigned og = xb_add(&bar[XB_TOP], 1u);
            const unsigned tg = og / nx;
            if (og + 1u == (tg + 1u) * nx) xb_add(&bar[XB_TOPGEN], 1u);
            else XB_SPIN(xb_ld(&bar[XB_TOPGEN]) == tg, bar);
            __builtin_amdgcn_fence(__ATOMIC_ACQUIRE, "agent");
            xb_add(&bar[XB_XGEN(b.x)], 1u);
            asm volatile("s_waitcnt vmcnt(0)" ::: "memory");
        } else {
            XB_SPIN(xb_ld(&bar[XB_XGEN(b.x)]) == gen, bar);
            __builtin_amdgcn_fence(__ATOMIC_ACQUIRE, "agent");
            asm volatile("s_waitcnt vmcnt(0)" ::: "memory");
        }
    }
    __syncthreads();
}

constexpr int NWAVES = 8, NTHR = NWAVES * 64;
constexpr int RING_BYTES = 131072, LDS_BYTES = 147456, MISC_OFF = LDS_BYTES - 256;
constexpr int NPHASE = 16;

__device__ __forceinline__ void mixer_even_simple(unsigned char* ws, const float* retnorm, int gw, int ngw, int lane) {
    const bf16* P = (const bf16*)(ws + WS_BIG); bf16* Y = (bf16*)(ws + WS_X0);
    for (int idx = gw; idx < BATCH * 8 * SEQ; idx += ngw) {
        const int t = idx & (SEQ - 1), h = (idx >> 12) & 7, b = idx >> 15; const size_t rb = (size_t)b * SEQ;
        { const float lg2 = log2f(1.0f - exp2f(-5.0f - (float)h));
          const float q = bf2f(P[(rb + t) * EW + h * 64 + lane]); float o = 0.f;
          for (int s = 0; s <= t; ++s) { const float k = bf2f(P[(rb + s) * EW + 512 + h * 64 + lane]), v = bf2f(P[(rb + s) * EW + 1024 + h * 64 + lane]);
              o += exp2f(lg2 * (float)(t - s)) * wave_sum(q * k) * v; }
          const float mu = wave_sum(o) * (1.f / 64.f); const float dv = o - mu; const float var = wave_sum(dv * dv) * (1.f / 64.f);
          const float g = bf2f(P[(rb + t) * EW + 1536 + h * 64 + lane]);
          Y[(rb + t) * DM + h * 64 + lane] = (bf16)f2bf(dv * (1.0f / sqrtf(var + GN_EPS)) * retnorm[h * 64 + lane] * silu_f(g)); }
        { const float q = bf2f(P[(rb + t) * EW + 2048 + h * 64 + lane]); float o = 0.f, carry = 0.f;
          for (int s = t - 1; s >= 0; --s) { const float k = bf2f(P[(rb + s) * EW + 2560 + h * 64 + lane]), v = bf2f(P[(rb + s) * EW + 3072 + h * 64 + lane]);
              const float y = wave_sum(q * k); const float lf2 = -softplus2(y); o += __builtin_amdgcn_exp2f(y + lf2 + carry) * v; carry += lf2; }
          Y[(rb + t) * DM + 512 + h * 64 + lane] = (bf16)f2bf(o); }
    }
}
__device__ __forceinline__ void fox_simple(unsigned char* ws, LAS float* cum, int vcu, int wave, int lane) {
    const bf16* P = (const bf16*)(ws + WS_BIG); bf16* Y = (bf16*)(ws + WS_X0);
    const int bh = vcu >> 1, b = bh >> 4, h = bh & 15; const size_t rb = (size_t)b * SEQ;
    const float* lf = (const float*)(ws + WS_LOGF) + (size_t)bh * SEQ;
    if (wave == 0) { float run = 0.f;
        for (int j = 0; j < 64; ++j) run += lf[lane * 64 + j];
        float inc = run;
#pragma unroll
        for (int o = 1; o < 64; o <<= 1) { const float n = __shfl_up(inc, o); if (lane >= o) inc += n; }
        float acc = inc - run;
        for (int j = 0; j < 64; ++j) { acc += lf[lane * 64 + j]; cum[lane * 64 + j] = acc; } }
    __syncthreads();
    for (int t = (vcu & 1) + 2 * wave; t < SEQ; t += 16) {
        const float q = bf2f(P[(rb + t) * QKVW + h * 64 + lane]); const float ct = cum[t]; float m = -INFINITY, l = 0.f, o = 0.f;
        for (int s = 0; s <= t; ++s) { const float k = bf2f(P[(rb + s) * QKVW + 1024 + h * 64 + lane]), v = bf2f(P[(rb + s) * QKVW + 2048 + h * 64 + lane]);
            const float x = wave_sum(q * k) + (ct - cum[s]) * LOG2E;
            if (x > m) { const float f = __builtin_amdgcn_exp2f(m - x); l *= f; o *= f; m = x; }
            const float pr = __builtin_amdgcn_exp2f(x - m); l += pr; o += pr * v; }
        Y[(rb + t) * DM + h * 64 + lane] = (bf16)f2bf(o / l); }
    __syncthreads();
}
__device__ __forceinline__ void router_phase(unsigned char* ws, const float* hres, LAS unsigned* rl, int vcu, int wave, int lane) {
    unsigned* ctl = (unsigned*)(ws + WS_CTL); const int tid = threadIdx.x;
    LAS unsigned* lcnt = rl; LAS unsigned* lbase = rl + 16; LAS int* tinfo = (LAS int*)(rl + 32); LAS float* tg = (LAS float*)(rl + 32 + 256); LAS unsigned* tpos = rl + 32 + 512;
    if (tid < 16) lcnt[tid] = 0u;
    __syncthreads();
    const float* part4 = (const float*)(ws + WS_PART) + (size_t)2 * T * 16;
    for (int i = 0; i < 16; ++i) { const int lt = wave * 16 + i, row = vcu * 128 + lt; int e1, e2; float g1, g2;
        router_row(hres + (size_t)row * DM, (const float*)(ws + WS_ROUTW), part4, row, (float*)(ws + WS_RSTD4), lane, e1, e2, g1, g2);
        if (lane == 0) { tinfo[lt * 2] = e1; tinfo[lt * 2 + 1] = e2; tg[lt * 2] = g1; tg[lt * 2 + 1] = g2;
            tpos[lt * 2] = __hip_atomic_fetch_add(&lcnt[e1], 1u, __ATOMIC_RELAXED, __HIP_MEMORY_SCOPE_WORKGROUP); tpos[lt * 2 + 1] = __hip_atomic_fetch_add(&lcnt[8 + e2], 1u, __ATOMIC_RELAXED, __HIP_MEMORY_SCOPE_WORKGROUP); } }
    __syncthreads();
    if (tid < 16) lbase[tid] = __hip_atomic_fetch_add(&ctl[CW_CNT + 64 * tid], lcnt[tid], __ATOMIC_RELAXED, __HIP_MEMORY_SCOPE_AGENT);
    __syncthreads();
    if (tid < 256) { const int lt = tid >> 1, c = tid & 1, e = tinfo[tid]; const unsigned pos = lbase[c * 8 + e] + tpos[tid];
        ((int*)(ws + WS_LIST))[(size_t)(c * 8 + e) * T + pos] = vcu * 128 + lt; ((float*)(ws + WS_GATE))[(size_t)(c * 8 + e) * T + pos] = tg[tid]; }
    __syncthreads();
}

typedef const __attribute__((address_space(4))) Params* KParams;
__device__ __forceinline__ KParams kargs() { unsigned long long v = (unsigned long long)__builtin_amdgcn_kernarg_segment_ptr(); asm volatile("" : "+s"(v)); return (KParams)v; }
__global__ void __launch_bounds__(NTHR, 2) mega_fwd(Params p_unused) {
    extern __shared__ __attribute__((aligned(16))) unsigned char lds_raw[];
    LAS unsigned char* lds = (LAS unsigned char*)lds_raw;
    const int tid = threadIdx.x, lane = tid & 63, wave = __builtin_amdgcn_readfirstlane(tid >> 6);
    if (tid < 64) ((LAS unsigned*)(lds + MISC_OFF))[tid] = 0u;
    __syncthreads();
    XcdBarrier bar = xcd_barrier_post((unsigned*)(kargs()->ws + WS_CTL) + CW_BAR + kargs()->li * XCD_BAR_WORDS, (volatile LAS unsigned*)(lds + MISC_OFF) + 8);
#ifndef PH_MASK
#define PH_MASK 0xffff
#endif
#define IN(k) (((PH_MASK >> (k)) & 1) && kargs()->ph_lo <= (k) && (k) < kargs()->ph_hi)
#define SEAM(k) do { if (IN(k) && IN((k) + 1)) xcd_barrier(bar); } while (0)
#define GRID_VARS const int G = gridDim.x, bx = blockIdx.x; const int vcu = (G % 8 == 0) ? (bx % 8) * (G / 8) + bx / 8 : bx; const int gw = vcu * NWAVES + wave, ngw = G * NWAVES; (void)gw; (void)ngw; (void)vcu; \
    KParams kp = kargs(); unsigned char* ws = kp->ws; (void)ws

    if (IN(0)) { GRID_VARS; Params p; for (int i = 0; i < 19; ++i) p.in[i] = kp->in[i]; p.out = kp->out; p.ws = ws; p.ph_lo = 0; p.ph_hi = 0; p.li = 0; p.pad = 0;
        prologue_weights(p, (LAS float*)(lds + wave * TR_SCR_BYTES), gw, ngw, lane);
        prologue_small(p, bx * NTHR + tid, G * NTHR);
        const float* x = kp->in[0]; bf16* X0 = (bf16*)(ws + WS_X0);
        for (int m = gw; m < T; m += ngw) rms_row_to_bf16(x + (size_t)m * DM, X0 + (size_t)m * DM, lane);
    }
    SEAM(0);
    if (IN(1)) { GRID_VARS; pg8::ProbDense P{(const bf16*)(ws + WS_X0), (const bf16*)(ws + WS_W_IN_E), DM}; pg8::StaticOrder S; S.init(T / 256, EW / 256, G, bx);
        pg8::EpiInEven E{(bf16*)(ws + WS_BIG), (const float2*)(ws + WS_ROPE)}; pg8::gemm_phase(lds, P, S, E); }
    SEAM(1);
#ifdef MIX_SIMPLE
    if (IN(2)) { GRID_VARS; mixer_even_simple(ws, kp->in[3], gw, ngw, lane); }
    SEAM(2);
    SEAM(3);
#else
    if (IN(2)) { GRID_VARS; const bf16* Pj = (const bf16*)(ws + WS_BIG); float* loc = kp->out; float* grp = kp->out + (size_t)8 * 1024 * 1024;
        for (int k = 0; k < 2; ++k) { const int u = vcu + 256 * k; att::ret_pass_a(lds, Pj, loc, grp, u >> 3, u & 7); }
        for (int k = 0; k < 2; ++k) { const int u = vcu + 256 * k, bh = u >> 4, qb = u & 15, h = bh & 7;
            att::unit<0>(lds, Pj + 2048 + h * 64, Pj + 2560 + h * 64, Pj + 3072 + h * 64, EW, (bf16*)(ws + WS_X0) + 512 + h * 64, (size_t)(bh >> 3) * SEQ, qb * 256, nullptr); } }
    SEAM(2);
    if (IN(3)) { GRID_VARS; const bf16* Pj = (const bf16*)(ws + WS_BIG); const float* loc = kp->out; const float* grp = kp->out + (size_t)8 * 1024 * 1024; const float* rn = kp->in[3];
        for (int k = 0; k < 8; ++k) { const int u = vcu + 256 * k; att::ret_pass_b(lds, Pj, loc, grp, rn, (bf16*)(ws + WS_X0), u >> 5, u & 31); }
        for (int k = 2; k < 4; ++k) { const int u = vcu + 256 * k, bh = u >> 4, qb = u & 15, h = bh & 7;
            att::unit<0>(lds, Pj + 2048 + h * 64, Pj + 2560 + h * 64, Pj + 3072 + h * 64, EW, (bf16*)(ws + WS_X0) + 512 + h * 64, (size_t)(bh >> 3) * SEQ, qb * 256, nullptr); } }
    SEAM(3);
#endif
    if (IN(4)) { GRID_VARS; pg8::ProbDense P{(const bf16*)(ws + WS_X0), (const bf16*)(ws + WS_W_OUT_E), DM}; pg8::StaticOrder S; S.init(T / 256, DM / 256, G, bx);
        pg8::EpiResid E{kp->in[0], kp->out, (bf16*)(ws + WS_BIG), (float*)(ws + WS_PART)}; pg8::gemm_phase(lds, P, S, E); }
    SEAM(4);
    if (IN(5)) { GRID_VARS; pg8::ProbDense P{(const bf16*)(ws + WS_BIG), (const bf16*)(ws + WS_W_GU_E), DM}; pg8::StaticOrder S; S.init(T / 256, GU / 256, G, bx);
        pg8::EpiGU E{(bf16*)(ws + WS_HID), (const float*)(ws + WS_PART)}; pg8::gemm_phase(lds, P, S, E); }
    SEAM(5);
    if (IN(6)) { GRID_VARS; pg8::ProbDense P{(const bf16*)(ws + WS_HID), (const bf16*)(ws + WS_W_DN_E), DFF}; pg8::StaticOrder S; S.init(T / 256, DM / 256, G, bx);
        pg8::EpiResid E{kp->out, kp->out, (bf16*)(ws + WS_X0), (float*)(ws + WS_PART) + (size_t)T * 16}; pg8::gemm_phase(lds, P, S, E); }
    SEAM(6);
    if (IN(7)) { GRID_VARS; pg8::ProbDense P{(const bf16*)(ws + WS_X0), (const bf16*)(ws + WS_W_IN_O), DM}; pg8::StaticOrder S; S.init(T / 256, OWP / 256, G, bx);
        pg8::EpiInOdd E{(bf16*)(ws + WS_BIG), (const float*)(ws + WS_PART) + (size_t)T * 16, kp->in[11], (float*)(ws + WS_LOGF)}; pg8::gemm_phase(lds, P, S, E); }
    SEAM(7);
#ifdef FOX_SIMPLE
    if (IN(8)) { GRID_VARS; fox_simple(ws, (LAS float*)lds, vcu, wave, lane); }
#else
    if (IN(8)) { GRID_VARS; const bf16* Pj = (const bf16*)(ws + WS_BIG); const int bh = vcu >> 1, h = bh & 15;
        LAS float* cum2 = (LAS float*)(lds + att::CUM_OFF);
        att::fox_cum(cum2, (const float*)(ws + WS_LOGF) + (size_t)bh * SEQ);
        for (int k = 0; k < 8; ++k) { const int s = 4 * (vcu & 1) + (k >> 1), qb = (k & 1) ? 15 - s : s;
            att::unit<1>(lds, Pj + h * 64, Pj + 1024 + h * 64, Pj + 2048 + h * 64, QKVW, (bf16*)(ws + WS_X0) + h * 64, (size_t)(bh >> 4) * SEQ, qb * 256, cum2); } }
#endif
    SEAM(8);
    if (IN(9)) { GRID_VARS; pg8::ProbDense P{(const bf16*)(ws + WS_X0), (const bf16*)(ws + WS_W_OUT_O), DM}; pg8::StaticOrder S; S.init(T / 256, DM / 256, G, bx);
        pg8::EpiResid E{kp->out, kp->out, (bf16*)(ws + WS_BIG), (float*)(ws + WS_PART) + (size_t)2 * T * 16}; pg8::gemm_phase(lds, P, S, E); }
    SEAM(9);
    if (IN(10)) { GRID_VARS; if (G == 256) router_phase(ws, kp->out, (LAS unsigned*)lds, vcu, wave, lane); }
    SEAM(10);
#define MOE_PASS(c) do { \
        if (IN(11 + 2 * c)) { GRID_VARS; const unsigned* ctl = (const unsigned*)(ws + WS_CTL); int ntile = 0; \
        _Pragma("unroll") \
            for (int e = 0; e < 8; ++e) ntile += ((int)ctl[CW_CNT + 64 * (c * 8 + e)] + 255) >> 8; \
            pg8::ProbMoeGU P{(const bf16*)(ws + WS_BIG), (const bf16*)(ws + WS_W_GU_M), DM, (size_t)GU * DM * 2, ctl, c, (const int*)(ws + WS_LIST)}; pg8::StaticOrder S; S.init(ntile, GU / 256, G, bx); \
            pg8::EpiMoeGU E{(bf16*)(ws + WS_HID), (const float*)(ws + WS_RSTD4), ctl, c, (const int*)(ws + WS_LIST)}; pg8::gemm_phase(lds, P, S, E); } \
        SEAM(11 + 2 * c); \
        if (IN(12 + 2 * c)) { GRID_VARS; const unsigned* ctl = (const unsigned*)(ws + WS_CTL); int ntile = 0; \
        _Pragma("unroll") \
            for (int e = 0; e < 8; ++e) ntile += ((int)ctl[CW_CNT + 64 * (c * 8 + e)] + 255) >> 8; \
            pg8::ProbMoeDown P{(const bf16*)(ws + WS_HID), (const bf16*)(ws + WS_W_DN_M), DFF, (size_t)DM * DFF * 2, ctl, c}; pg8::StaticOrder S; S.init(ntile, DM / 256, G, bx); \
            pg8::EpiMoeDown E{kp->out, ctl, c, (const int*)(ws + WS_LIST), (const float*)(ws + WS_GATE)}; pg8::gemm_phase(lds, P, S, E); } \
        SEAM(12 + 2 * c); \
    } while (0)
    MOE_PASS(0);
    MOE_PASS(1);
#undef MOE_PASS
    if (IN(15)) { GRID_VARS; float* out = kp->out; const float* fg = kp->in[18]; for (int m = gw; m < T; m += ngw) final_norm_row(out + (size_t)m * DM, fg, lane); }
#undef IN
#undef SEAM
#undef GRID_VARS
}

#ifndef MK_N_LAUNCHES
#define MK_N_LAUNCHES 1
#endif
extern "C" void kernel_launch(void* const* d_in, const int* in_sizes, int n_in, void* d_out, int out_size, void* d_ws, size_t ws_size, hipStream_t stream) {
    static int grid = 0;
    if (grid == 0) {
        if (n_in != 19 || out_size != T * DM || ws_size < WS_END) { fprintf(stderr, "kernel_launch: unexpected shapes (n_in %d out %d ws %zu)\n", n_in, out_size, ws_size); grid = -1; return; }
        int dev = 0, cus = 0, per_cu = 0;
        if (hipGetDevice(&dev) != hipSuccess || hipDeviceGetAttribute(&cus, hipDeviceAttributeMultiprocessorCount, dev) != hipSuccess) { grid = -1; return; }
        if (hipFuncSetAttribute((const void*)mega_fwd, hipFuncAttributeMaxDynamicSharedMemorySize, LDS_BYTES) != hipSuccess) { fprintf(stderr, "kernel_launch: hipFuncSetAttribute failed\n"); grid = -1; return; }
        if (hipOccupancyMaxActiveBlocksPerMultiprocessor(&per_cu, (const void*)mega_fwd, NTHR, LDS_BYTES) != hipSuccess || per_cu < 1) { fprintf(stderr, "kernel_launch: occupancy query says %d\n", per_cu); }
        (void)hipGetLastError();
        grid = cus;
        if (grid != 256) fprintf(stderr, "kernel_launch: %d CUs; the router phase assumes 256\n", grid);
    }
    if (grid < 0) return;
    (void)in_sizes;
    if (hipMemsetAsync((char*)d_ws + WS_CTL, 0, CTL_BYTES, stream) != hipSuccess) return;
    Params p{};
    for (int i = 0; i < 19; ++i) p.in[i] = (const float*)d_in[i];
    p.out = (float*)d_out; p.ws = (unsigned char*)d_ws;
#if defined(EXP_PHASE)
    p.ph_lo = 0; p.ph_hi = EXP_PHASE + 1; p.li = 0; hipLaunchKernelGGL(mega_fwd, dim3(grid), dim3(NTHR), LDS_BYTES, stream, p);
    p.ph_lo = EXP_PHASE; p.ph_hi = EXP_PHASE + 1; p.li = 1; hipLaunchKernelGGL(mega_fwd, dim3(grid), dim3(NTHR), LDS_BYTES, stream, p);
    p.ph_lo = EXP_PHASE + 1; p.ph_hi = NPHASE; p.li = 2; hipLaunchKernelGGL(mega_fwd, dim3(grid), dim3(NTHR), LDS_BYTES, stream, p);
#elif MK_N_LAUNCHES == 1
    p.ph_lo = 0; p.ph_hi = NPHASE; p.li = 0;
    hipLaunchKernelGGL(mega_fwd, dim3(grid), dim3(NTHR), LDS_BYTES, stream, p);
#else
    for (int k = 0; k < NPHASE; ++k) { p.ph_lo = k; p.ph_hi = k + 1; p.li = 0; hipLaunchKernelGGL(mega_fwd, dim3(grid), dim3(NTHR), LDS_BYTES, stream, p); }
#endif
}
```

```cpp
#include <hip/hip_runtime.h>
#include <cstdio>
#include <cstdint>

constexpr int DM = 1024, BATCH = 8, SEQ = 4096, T = BATCH * SEQ;
constexpr int HD = 64;
constexpr int EW = 3584;
constexpr int OW = 3088, OWP = 3328;
constexpr int QKVW = 3072;
constexpr int DFF = 2816, NEXP = 8, GU = 2 * DFF;
constexpr float NORM_EPS = 1e-6f, GN_EPS = 1e-5f;
constexpr float LOG2E = 1.4426950408889634f;
constexpr float C2 = 0.125f * LOG2E;
constexpr int MOE_MAXT = 136;

constexpr size_t MiB = 1u << 20;
constexpr size_t WS_CTL = 0, CTL_BYTES = 2 * MiB;
constexpr size_t WS_ROPE = 2 * MiB;
constexpr size_t WS_ROUTW = 3 * MiB;
constexpr size_t WS_RSTD4 = 3 * MiB + 65536;
constexpr size_t WS_LIST = 4 * MiB;
constexpr size_t WS_GATE = 6 * MiB;
constexpr size_t WS_PART = 8 * MiB;
constexpr size_t WS_LOGF = 14 * MiB;
constexpr size_t WS_CUM = 16 * MiB;
constexpr size_t WS_W = 18 * MiB;
constexpr size_t WS_W_IN_E = WS_W;
constexpr size_t WS_W_OUT_E = WS_W_IN_E + (size_t)EW * DM * 2;
constexpr size_t WS_W_GU_E = WS_W_OUT_E + (size_t)DM * DM * 2;
constexpr size_t WS_W_DN_E = WS_W_GU_E + (size_t)GU * DM * 2;
constexpr size_t WS_W_IN_O = WS_W_DN_E + (size_t)DM * DFF * 2;
constexpr size_t WS_W_OUT_O = WS_W_IN_O + (size_t)OWP * DM * 2;
constexpr size_t WS_W_GU_M = WS_W_OUT_O + (size_t)DM * DM * 2;
constexpr size_t WS_W_DN_M = WS_W_GU_M + (size_t)NEXP * GU * DM * 2;
constexpr size_t WS_W_END = WS_W_DN_M + (size_t)NEXP * DM * DFF * 2;
constexpr size_t WS_X0 = 184 * MiB;
constexpr size_t WS_BIG = 248 * MiB;
constexpr size_t WS_HID = WS_BIG + 64 * MiB;
constexpr size_t WS_END = WS_BIG + 251 * MiB;
static_assert(WS_W_END <= WS_X0 && WS_END <= 512 * MiB, "ws map");
static_assert(WS_HID + (size_t)MOE_MAXT * 256 * DFF * 2 <= WS_END, "hidden fits");
constexpr int CW_CNT = 64;
constexpr int CW_BAR = 4096;

typedef unsigned short bf16;
typedef short bf16x8 __attribute__((ext_vector_type(8)));
typedef float f32x4 __attribute__((ext_vector_type(4)));
typedef float f32x16 __attribute__((ext_vector_type(16)));
typedef unsigned u32x4 __attribute__((ext_vector_type(4)));
typedef unsigned u32x2 __attribute__((ext_vector_type(2)));

struct Params { const float* in[19]; float* out; unsigned char* ws; int ph_lo, ph_hi, li, pad; };

__device__ __forceinline__ unsigned f2bf(float f) { unsigned u = __builtin_bit_cast(unsigned, f); return (u + 0x7fffu + ((u >> 16) & 1u)) >> 16; }
typedef float f32x2_t __attribute__((ext_vector_type(2))); typedef __bf16 bf16x2_t __attribute__((ext_vector_type(2)));
__device__ __forceinline__ unsigned pk2(float lo, float hi) { const f32x2_t v = {lo, hi}; return __builtin_bit_cast(unsigned, __builtin_convertvector(v, bf16x2_t)); }
__device__ __forceinline__ float bf2f(unsigned short b) { return __builtin_bit_cast(float, (unsigned)b << 16); }
__device__ __forceinline__ float wave_sum(float v) {
#pragma unroll
    for (int o = 1; o < 64; o <<= 1) v += __shfl_xor(v, o);
    return v;
}
__device__ __forceinline__ float silu_f(float x) { return x / (1.f + __expf(-x)); }
__device__ __forceinline__ float softplus2(float y) { return fmaxf(y, 0.f) + __log2f(1.f + __builtin_amdgcn_exp2f(-fabsf(y))); }
__device__ __forceinline__ float rstd_from_part(const float* part, int row) {
    const f32x4* p = (const f32x4*)(part + (size_t)row * 16); float s = 0.f;
#pragma unroll
    for (int i = 0; i < 4; ++i) { const f32x4 v = p[i]; s += (v[0] + v[1]) + (v[2] + v[3]); }
    return 1.0f / sqrtf(s * (1.f / DM) + NORM_EPS);
}
__device__ __forceinline__ bool moe_tile(const unsigned* ctl, int c, int tile, int& e, int& row0, int& nrows) {
    int ts = 0;
#pragma unroll
    for (int i = 0; i < 8; ++i) { const int cn = (int)ctl[CW_CNT + 64 * (c * 8 + i)]; const int nt = (cn + 255) >> 8;
        if (tile >= ts && tile < ts + nt) { e = i; row0 = (tile - ts) * 256; nrows = cn - row0 < 256 ? cn - row0 : 256; return true; }
        ts += nt; }
    return false;
}

__constant__ double c_invfreq[32] = {1, 0.74989420933245587, 0.56234132519034907, 0.42169650342858223, 0.31622776601683794, 0.23713737056616552, 0.17782794100389229, 0.1333521432163324,
    0.10000000000000001, 0.074989420933245579, 0.056234132519034911, 0.042169650342858224, 0.031622776601683791, 0.023713737056616554, 0.017782794100389229, 0.013335214321633241,
    0.01, 0.0074989420933245579, 0.005623413251903491, 0.0042169650342858229, 0.0031622776601683794, 0.0023713737056616554, 0.0017782794100389228, 0.0013335214321633241,
    0.001, 0.00074989420933245586, 0.0005623413251903491, 0.00042169650342858224, 0.00031622776601683794, 0.00023713737056616554, 0.00017782794100389227, 0.0001333521432163324};
__device__ __forceinline__ void rope_entry(int pos, int i, float& c, float& s) {
    const double a = (double)pos * c_invfreq[i];
    const double TWO_PI = 6.283185307179586476925286766559, HALF_PI = 1.5707963267948966192313216916398;
    double r = a - TWO_PI * __builtin_rint(a / TWO_PI);
    const double qd = __builtin_rint(r / HALF_PI); const int q = (int)qd; r -= qd * HALF_PI;
    const double r2 = r * r;
    const double sn = r * (1.0 + r2 * (-1.0 / 6 + r2 * (1.0 / 120 + r2 * (-1.0 / 5040 + r2 * (1.0 / 362880 + r2 * (-1.0 / 39916800 + r2 * (1.0 / 6227020800.0)))))));
    const double cs = 1.0 + r2 * (-0.5 + r2 * (1.0 / 24 + r2 * (-1.0 / 720 + r2 * (1.0 / 40320 + r2 * (-1.0 / 3628800 + r2 * (1.0 / 479001600.0))))));
    const int qq = q & 3; double cc, ss;
    if (qq == 0) { cc = cs; ss = sn; } else if (qq == 1) { cc = -sn; ss = cs; } else if (qq == 2) { cc = -cs; ss = -sn; } else { cc = sn; ss = -cs; }
    c = (float)cc; s = (float)ss;
}
enum { MAP_ID = 0, MAP_INE = 1, MAP_GATE = 2, MAP_UP = 3 };
__device__ __forceinline__ int map_row(int mode, int n) {
    if (mode == MAP_INE) return n < 1024 ? (n & ~63) + 2 * (n & 31) + ((n >> 5) & 1) : n;
    if (mode == MAP_GATE) return (n >> 7) * 256 + (n & 127);
    if (mode == MAP_UP) return (n >> 7) * 256 + 128 + (n & 127);
    return n;
}
constexpr int TR_SCR_BYTES = 64 * 65 * 4;
template <class LP>
__device__ __forceinline__ void transpose_item(const float* __restrict__ W, int K, int N, bf16* WT, const float* __restrict__ gain, int mode, LP scr, int item, int lane) {
    const int nblk = (N + 63) / 64, kb = item / nblk, nb = item % nblk, k0 = 64 * kb, n0 = 64 * nb;
    const int lr = lane >> 4, lc = (lane & 15) * 4;
    const bool nok = n0 + lc < N;
    f32x4 v[16];
#pragma unroll
    for (int i = 0; i < 16; ++i) v[i] = nok ? *(const f32x4*)(W + (size_t)(k0 + 4 * i + lr) * N + n0 + lc) : (f32x4){0.f, 0.f, 0.f, 0.f};
#pragma unroll
    for (int i = 0; i < 16; ++i)
#pragma unroll
        for (int e = 0; e < 4; ++e) scr[(4 * i + lr) * 65 + lc + e] = v[i][e];
    asm volatile("s_waitcnt lgkmcnt(0)" ::: "memory");
    const int c = lane & 7;
    f32x4 g0 = {1.f, 1.f, 1.f, 1.f}, g1 = {1.f, 1.f, 1.f, 1.f};
    if (gain) { g0 = *(const f32x4*)(gain + k0 + 8 * c); g1 = *(const f32x4*)(gain + k0 + 8 * c + 4); }
#pragma unroll
    for (int j = 0; j < 8; ++j) { const int n = (lane >> 3) + 8 * j;
        u32x4 o; o.x = pk2(scr[(8 * c + 0) * 65 + n] * g0[0], scr[(8 * c + 1) * 65 + n] * g0[1]); o.y = pk2(scr[(8 * c + 2) * 65 + n] * g0[2], scr[(8 * c + 3) * 65 + n] * g0[3]);
        o.z = pk2(scr[(8 * c + 4) * 65 + n] * g1[0], scr[(8 * c + 5) * 65 + n] * g1[1]); o.w = pk2(scr[(8 * c + 6) * 65 + n] * g1[2], scr[(8 * c + 7) * 65 + n] * g1[3]);
        if (n0 + n < N) *(u32x4*)(WT + (size_t)map_row(mode, n0 + n) * K + k0 + 8 * c) = o; }
    asm volatile("s_waitcnt lgkmcnt(0)" ::: "memory");
}
struct WJob { const float* W; int K, N; bf16* WT; const float* gain; int mode; int items; };
template <class LP>
__device__ __forceinline__ void prologue_weights(const Params& p, LP scr, int gw, int ngw, int lane) {
    unsigned char* ws = p.ws;
    for (int j = 0; j < 7 + 3 * NEXP; ++j) {
        WJob J;
        if (j == 0) J = WJob{p.in[2], DM, EW, (bf16*)(ws + WS_W_IN_E), p.in[1], MAP_INE, 0};
        else if (j == 1) J = WJob{p.in[4], DM, DM, (bf16*)(ws + WS_W_OUT_E), nullptr, MAP_ID, 0};
        else if (j == 2) J = WJob{p.in[6], DM, DFF, (bf16*)(ws + WS_W_GU_E), p.in[5], MAP_GATE, 0};
        else if (j == 3) J = WJob{p.in[7], DM, DFF, (bf16*)(ws + WS_W_GU_E), p.in[5], MAP_UP, 0};
        else if (j == 4) J = WJob{p.in[8], DFF, DM, (bf16*)(ws + WS_W_DN_E), nullptr, MAP_ID, 0};
        else if (j == 5) J = WJob{p.in[10], DM, OW, (bf16*)(ws + WS_W_IN_O), p.in[9], MAP_ID, 0};
        else if (j == 6) J = WJob{p.in[12], DM, DM, (bf16*)(ws + WS_W_OUT_O), nullptr, MAP_ID, 0};
        else { const int k = j - 7, e = k / 3, w = k % 3;
            if (w == 0) J = WJob{p.in[15] + (size_t)e * DM * DFF, DM, DFF, (bf16*)(ws + WS_W_GU_M) + (size_t)e * GU * DM, p.in[13], MAP_GATE, 0};
            else if (w == 1) J = WJob{p.in[16] + (size_t)e * DM * DFF, DM, DFF, (bf16*)(ws + WS_W_GU_M) + (size_t)e * GU * DM, p.in[13], MAP_UP, 0};
            else J = WJob{p.in[17] + (size_t)e * DFF * DM, DFF, DM, (bf16*)(ws + WS_W_DN_M) + (size_t)e * DM * DFF, nullptr, MAP_ID, 0}; }
        J.items = (J.K / 64) * ((J.N + 63) / 64);
        for (int it = gw; it < J.items; it += ngw) transpose_item(J.W, J.K, J.N, J.WT, J.gain, J.mode, scr, it, lane);
    }
}
__device__ __forceinline__ void prologue_small(const Params& p, int gt, int ngt) {
    unsigned char* ws = p.ws;
    { u32x4* z = (u32x4*)((bf16*)(ws + WS_W_IN_O) + (size_t)OW * DM); const int n16 = (OWP - OW) * DM * 2 / 16;
      for (int i = gt; i < n16; i += ngt) z[i] = (u32x4){0u, 0u, 0u, 0u}; }
    { float2* R = (float2*)(ws + WS_ROPE);
      for (int i = gt; i < SEQ * 32; i += ngt) { float c, s; rope_entry(i >> 5, i & 31, c, s); R[i] = make_float2(c, s); } }
    { float* RW = (float*)(ws + WS_ROUTW); const float* wr = p.in[14]; const float* g = p.in[13];
      for (int i = gt; i < NEXP * DM; i += ngt) { const int e = i >> 10, k = i & 1023; RW[i] = wr[k * NEXP + e] * g[k]; } }
}
__device__ __forceinline__ void rms_row_to_bf16(const float* xrow, bf16* orow, int lane) {
    const f32x4* xr = (const f32x4*)xrow + lane;
    f32x4 v[4]; float s = 0.f;
#pragma unroll
    for (int j = 0; j < 4; ++j) { v[j] = xr[64 * j]; s += (v[j][0] * v[j][0] + v[j][1] * v[j][1]) + (v[j][2] * v[j][2] + v[j][3] * v[j][3]); }
    const float rstd = 1.0f / sqrtf(wave_sum(s) * (1.f / DM) + NORM_EPS);
    unsigned long long* o8 = (unsigned long long*)orow + lane;
#pragma unroll
    for (int j = 0; j < 4; ++j) o8[64 * j] = (unsigned long long)pk2(v[j][0] * rstd, v[j][1] * rstd) | ((unsigned long long)pk2(v[j][2] * rstd, v[j][3] * rstd) << 32);
}
__device__ __forceinline__ void final_norm_row(float* row, const float* gain, int lane) {
    f32x4* xr = (f32x4*)row + lane; const f32x4* g = (const f32x4*)gain + lane;
    f32x4 v[4]; float s = 0.f;
#pragma unroll
    for (int j = 0; j < 4; ++j) { v[j] = xr[64 * j]; s += (v[j][0] * v[j][0] + v[j][1] * v[j][1]) + (v[j][2] * v[j][2] + v[j][3] * v[j][3]); }
    const float rstd = 1.0f / sqrtf(wave_sum(s) * (1.f / DM) + NORM_EPS);
#pragma unroll
    for (int j = 0; j < 4; ++j) xr[64 * j] = v[j] * rstd * g[64 * j];
}
__device__ __forceinline__ void router_row(const float* hrow, const float* RW, const float* part4, int row, float* rstd4, int lane, int& e1, int& e2, float& g1, float& g2) {
    const f32x4* xr = (const f32x4*)hrow + lane; f32x4 v[4];
#pragma unroll
    for (int j = 0; j < 4; ++j) v[j] = xr[64 * j];
    float lg[NEXP];
#pragma unroll
    for (int e = 0; e < NEXP; ++e) { const f32x4* w = (const f32x4*)(RW + e * DM) + lane; float s = 0.f;
#pragma unroll
        for (int j = 0; j < 4; ++j) { const f32x4 ww = w[64 * j]; s += (v[j][0] * ww[0] + v[j][1] * ww[1]) + (v[j][2] * ww[2] + v[j][3] * ww[3]); }
        lg[e] = wave_sum(s); }
    const float rstd = rstd_from_part(part4, row);
    if (lane == 0) rstd4[row] = rstd;
    int b1 = 0; float v1 = lg[0];
#pragma unroll
    for (int e = 1; e < NEXP; ++e) if (lg[e] > v1) { v1 = lg[e]; b1 = e; }
    int b2 = -1; float v2 = -INFINITY;
#pragma unroll
    for (int e = 0; e < NEXP; ++e) if (e != b1 && lg[e] > v2) { v2 = lg[e]; b2 = e; }
    e1 = b1; e2 = b2; const float d = (v2 - v1) * rstd;
    g1 = 1.f / (1.f + __expf(d)); g2 = 1.f - g1;
}

__global__ void __launch_bounds__(128) nk_prologue_w(Params p) {
    __shared__ float scr[2][64 * 65];
    const int wave = threadIdx.x >> 6, lane = threadIdx.x & 63;
    prologue_weights(p, &scr[wave][0], blockIdx.x * 2 + wave, gridDim.x * 2, lane);
}
__global__ void __launch_bounds__(256) nk_prologue_s(Params p) {
    prologue_small(p, blockIdx.x * 256 + threadIdx.x, gridDim.x * 256);
    const int gw = blockIdx.x * 4 + (threadIdx.x >> 6), ngw = gridDim.x * 4, lane = threadIdx.x & 63;
    for (int m = gw; m < T; m += ngw) rms_row_to_bf16(p.in[0] + (size_t)m * DM, (bf16*)(p.ws + WS_X0) + (size_t)m * DM, lane);
}
__global__ void __launch_bounds__(256) nk_rowssq(Params p, int which) {
    const int gw = blockIdx.x * 4 + (threadIdx.x >> 6), ngw = gridDim.x * 4, lane = threadIdx.x & 63;
    float* part = (float*)(p.ws + WS_PART) + (size_t)which * T * 16;
    for (int m = gw; m < T; m += ngw) { const f32x4* xr = (const f32x4*)(p.out + (size_t)m * DM) + lane; float s = 0.f;
#pragma unroll
        for (int j = 0; j < 4; ++j) { const f32x4 v = xr[64 * j]; s += (v[0] * v[0] + v[1] * v[1]) + (v[2] * v[2] + v[3] * v[3]); }
        s = wave_sum(s); if (lane < 16) part[(size_t)m * 16 + lane] = lane == 0 ? s : 0.f; }
}
template <int EPI> __global__ void __launch_bounds__(256) nk_gemm(Params p) {
    unsigned char* ws = p.ws; const unsigned* ctl = (const unsigned*)(ws + WS_CTL);
    const int lane = threadIdx.x & 63, w = threadIdx.x >> 6, wm = w >> 1, wn = w & 1, l15 = lane & 15, lq = lane >> 4;
    const int m0 = blockIdx.y * 64 + wm * 32, n0 = blockIdx.x * 64 + wn * 32;
    constexpr bool DUAL = (EPI == 4 || EPI == 10), MOE = (EPI == 10 || EPI == 11);
    constexpr int K = (EPI == 5 || EPI == 11) ? DFF : DM;
    const bf16* A; const bf16* Bt; int e = 0, row0 = 0, nrows = 256; const int c = p.ph_lo;
    if (MOE) { if (!moe_tile(ctl, c, blockIdx.y >> 2, e, row0, nrows)) return; }
    if (EPI == 1) { A = (const bf16*)(ws + WS_X0); Bt = (const bf16*)(ws + WS_W_IN_E); }
    else if (EPI == 3) { A = (const bf16*)(ws + WS_X0); Bt = (const bf16*)(ws + WS_W_OUT_E); }
    else if (EPI == 4) { A = (const bf16*)(ws + WS_BIG); Bt = (const bf16*)(ws + WS_W_GU_E); }
    else if (EPI == 5) { A = (const bf16*)(ws + WS_HID); Bt = (const bf16*)(ws + WS_W_DN_E); }
    else if (EPI == 6) { A = (const bf16*)(ws + WS_X0); Bt = (const bf16*)(ws + WS_W_IN_O); }
    else if (EPI == 8) { A = (const bf16*)(ws + WS_X0); Bt = (const bf16*)(ws + WS_W_OUT_O); }
    else if (EPI == 10) { A = (const bf16*)(ws + WS_BIG); Bt = (const bf16*)(ws + WS_W_GU_M) + (size_t)e * GU * DM; }
    else { A = (const bf16*)(ws + WS_HID); Bt = (const bf16*)(ws + WS_W_DN_M) + (size_t)e * DM * DFF; }
    const int* list = (const int*)(ws + WS_LIST) + (size_t)(c * 8 + e) * T; const float* glist = (const float*)(ws + WS_GATE) + (size_t)(c * 8 + e) * T;
    const bf16* arow[2];
#pragma unroll
    for (int i = 0; i < 2; ++i) { const int m = m0 + 16 * i + l15;
        if (EPI == 10) { const int r = (m & 255); const int tok = list[row0 + (r < nrows ? r : 0)]; arow[i] = A + (size_t)tok * K; }
        else arow[i] = A + (size_t)m * K; }
    const bf16* brow[2];
#pragma unroll
    for (int j = 0; j < 2; ++j) { const int n = n0 + 16 * j + l15; const int br = DUAL ? ((n >> 7) * 256 + (n & 127)) : n; brow[j] = Bt + (size_t)br * K; }
    f32x4 acc[2][2], acc2[2][2];
#pragma unroll
    for (int i = 0; i < 2; ++i)
#pragma unroll
        for (int j = 0; j < 2; ++j) { acc[i][j] = (f32x4){0.f, 0.f, 0.f, 0.f}; acc2[i][j] = (f32x4){0.f, 0.f, 0.f, 0.f}; }
    for (int k0 = 0; k0 < K; k0 += 32) {
        bf16x8 a[2], b[2], b2[2];
#pragma unroll
        for (int i = 0; i < 2; ++i) a[i] = *(const bf16x8*)(arow[i] + k0 + 8 * lq);
#pragma unroll
        for (int j = 0; j < 2; ++j) { b[j] = *(const bf16x8*)(brow[j] + k0 + 8 * lq); if (DUAL) b2[j] = *(const bf16x8*)(brow[j] + (size_t)128 * K + k0 + 8 * lq); }
#pragma unroll
        for (int i = 0; i < 2; ++i)
#pragma unroll
            for (int j = 0; j < 2; ++j) { acc[i][j] = __builtin_amdgcn_mfma_f32_16x16x32_bf16(a[i], b[j], acc[i][j], 0, 0, 0);
                if (DUAL) acc2[i][j] = __builtin_amdgcn_mfma_f32_16x16x32_bf16(a[i], b2[j], acc2[i][j], 0, 0, 0); }
    }
    const float2* rope = (const float2*)(ws + WS_ROPE);
#pragma unroll
    for (int i = 0; i < 2; ++i)
#pragma unroll
        for (int j = 0; j < 2; ++j)
#pragma unroll
            for (int r = 0; r < 4; ++r) {
                const int m = m0 + 16 * i + 4 * lq + r, n = n0 + 16 * j + l15; float v = acc[i][j][r];
                if (EPI == 1) {
                    bf16* O = (bf16*)(ws + WS_BIG);
                    const float vp = __shfl_xor(v, 1);
                    if (n < 1024) { const float2 cs = rope[(m & (SEQ - 1)) * 32 + ((n & 63) >> 1)];
                        v = (n & 1) ? (vp * cs.y + v * cs.x) : (v * cs.x - vp * cs.y);
                        if (n >= 512) v *= 0.125f; }
                    else if (n >= 2048 && n < 2560) v *= C2;
                    O[(size_t)m * EW + n] = (bf16)f2bf(v);
                } else if (EPI == 3 || EPI == 5 || EPI == 8) {
                    const float* resid = (EPI == 3) ? p.in[0] : p.out; const float o = resid[(size_t)m * DM + n] + v;
                    p.out[(size_t)m * DM + n] = o;
                    bf16* hb = (bf16*)(ws + (EPI == 5 ? WS_X0 : WS_BIG)); hb[(size_t)m * DM + n] = (bf16)f2bf(o);
                } else if (EPI == 4) {
                    const float rs = rstd_from_part((const float*)(ws + WS_PART), m);
                    const float g = v * rs, u = acc2[i][j][r] * rs; ((bf16*)(ws + WS_HID))[(size_t)m * DFF + n] = (bf16)f2bf(silu_f(g) * u);
                } else if (EPI == 6) {
                    const float rs = rstd_from_part((const float*)(ws + WS_PART) + (size_t)T * 16, m); v *= rs;
                    if (n < QKVW) { if (n < 1024) v *= C2; ((bf16*)(ws + WS_BIG))[(size_t)m * QKVW + n] = (bf16)f2bf(v); }
                    else if (n < OW) { const int h = n - QKVW; const float z = v + p.in[11][h]; const float lf = fminf(z, 0.f) - log1pf(__expf(-fabsf(z)));
                        ((float*)(ws + WS_LOGF))[((size_t)(m >> 12) * 16 + h) * SEQ + (m & (SEQ - 1))] = lf; }
                } else if (EPI == 10) {
                    const int rr = m & 255; const int tok = list[row0 + (rr < nrows ? rr : 0)]; const float rs = ((const float*)(ws + WS_RSTD4))[tok];
                    const float g = v * rs, u = acc2[i][j][r] * rs; ((bf16*)(ws + WS_HID))[(size_t)m * DFF + n] = (bf16)f2bf(silu_f(g) * u);
                } else if (EPI == 11) {
                    const int rr = m & 255; if (rr < nrows) { const int tok = list[row0 + rr]; const float gt = glist[row0 + rr]; p.out[(size_t)tok * DM + n] += gt * v; }
                }
            }
}
__global__ void __launch_bounds__(256) nk_retention(Params p) {
    const bf16* P = (const bf16*)(p.ws + WS_BIG); bf16* Y = (bf16*)(p.ws + WS_X0);
    const int gw = blockIdx.x * 4 + (threadIdx.x >> 6), lane = threadIdx.x & 63;
    const int t = gw & (SEQ - 1), h = (gw >> 12) & 7, b = gw >> 15; if (b >= BATCH) return;
    const float lg2 = log2f(1.0f - exp2f(-5.0f - (float)h));
    const size_t rb = (size_t)b * SEQ;
    const float q = bf2f(P[(rb + t) * EW + h * 64 + lane]);
    float o = 0.f;
    for (int s = 0; s <= t; ++s) {
        const float k = bf2f(P[(rb + s) * EW + 512 + h * 64 + lane]), v = bf2f(P[(rb + s) * EW + 1024 + h * 64 + lane]);
        const float d = wave_sum(q * k);
        o += exp2f(lg2 * (float)(t - s)) * d * v;
    }
    const float mu = wave_sum(o) * (1.f / 64.f); const float dv = o - mu; const float var = wave_sum(dv * dv) * (1.f / 64.f);
    const float g = bf2f(P[(rb + t) * EW + 1536 + h * 64 + lane]);
    const float y = dv * (1.0f / sqrtf(var + GN_EPS)) * p.in[3][h * 64 + lane] * silu_f(g);
    Y[(rb + t) * DM + h * 64 + lane] = (bf16)f2bf(y);
}
__global__ void __launch_bounds__(256) nk_stickbreak(Params p) {
    const bf16* P = (const bf16*)(p.ws + WS_BIG); bf16* Y = (bf16*)(p.ws + WS_X0);
    const int gw = blockIdx.x * 4 + (threadIdx.x >> 6), lane = threadIdx.x & 63;
    const int t = gw & (SEQ - 1), h = (gw >> 12) & 7, b = gw >> 15; if (b >= BATCH) return;
    const size_t rb = (size_t)b * SEQ;
    const float q = bf2f(P[(rb + t) * EW + 2048 + h * 64 + lane]);
    float o = 0.f, carry = 0.f;
    for (int s = t - 1; s >= 0; --s) {
        const float k = bf2f(P[(rb + s) * EW + 2560 + h * 64 + lane]), v = bf2f(P[(rb + s) * EW + 3072 + h * 64 + lane]);
        const float y = wave_sum(q * k);
        const float lf2 = -softplus2(y);
        o += __builtin_amdgcn_exp2f(y + lf2 + carry) * v;
        carry += lf2;
    }
    Y[(rb + t) * DM + 512 + h * 64 + lane] = (bf16)f2bf(o);
}
__global__ void __launch_bounds__(128) nk_cumsum(Params p) {
    const int i = threadIdx.x; const float* lf = (const float*)(p.ws + WS_LOGF) + (size_t)i * SEQ; float* cu = (float*)(p.ws + WS_CUM) + (size_t)i * SEQ;
    float s = 0.f; for (int t = 0; t < SEQ; ++t) { s += lf[t]; cu[t] = s; }
}
__global__ void __launch_bounds__(256) nk_fox(Params p) {
    const bf16* P = (const bf16*)(p.ws + WS_BIG); bf16* Y = (bf16*)(p.ws + WS_X0);
    const int gw = blockIdx.x * 4 + (threadIdx.x >> 6), lane = threadIdx.x & 63;
    const int t = gw & (SEQ - 1), h = (gw >> 12) & 15, b = gw >> 16; if (b >= BATCH) return;
    const size_t rb = (size_t)b * SEQ; const float* cu = (const float*)(p.ws + WS_CUM) + ((size_t)b * 16 + h) * SEQ;
    const float q = bf2f(P[(rb + t) * QKVW + h * 64 + lane]);
    const float ct = cu[t]; float m = -INFINITY, l = 0.f, o = 0.f;
    for (int s = 0; s <= t; ++s) {
        const float k = bf2f(P[(rb + s) * QKVW + 1024 + h * 64 + lane]), v = bf2f(P[(rb + s) * QKVW + 2048 + h * 64 + lane]);
        const float x = wave_sum(q * k) + (ct - cu[s]) * LOG2E;
        if (x > m) { const float f = __builtin_amdgcn_exp2f(m - x); l *= f; o *= f; m = x; }
        const float pr = __builtin_amdgcn_exp2f(x - m); l += pr; o += pr * v;
    }
    Y[(rb + t) * DM + h * 64 + lane] = (bf16)f2bf(o / l);
}
__global__ void __launch_bounds__(256) nk_router(Params p) {
    __shared__ unsigned lcnt[16], lbase[16]; __shared__ int tinfo[128][2]; __shared__ float tg[128][2]; __shared__ unsigned tpos[128][2];
    unsigned char* ws = p.ws; unsigned* ctl = (unsigned*)(ws + WS_CTL);
    const int lane = threadIdx.x & 63, w = threadIdx.x >> 6;
    if (threadIdx.x < 16) lcnt[threadIdx.x] = 0u;
    __syncthreads();
    const float* part4 = (const float*)(ws + WS_PART) + (size_t)2 * T * 16;
    for (int i = 0; i < 32; ++i) { const int lt = w * 32 + i, row = blockIdx.x * 128 + lt; int e1, e2; float g1, g2;
        router_row(p.out + (size_t)row * DM, (const float*)(ws + WS_ROUTW), part4, row, (float*)(ws + WS_RSTD4), lane, e1, e2, g1, g2);
        if (lane == 0) { tinfo[lt][0] = e1; tinfo[lt][1] = e2; tg[lt][0] = g1; tg[lt][1] = g2; tpos[lt][0] = atomicAdd(&lcnt[e1], 1u); tpos[lt][1] = atomicAdd(&lcnt[8 + e2], 1u); } }
    __syncthreads();
    if (threadIdx.x < 16) lbase[threadIdx.x] = atomicAdd(&ctl[CW_CNT + 64 * threadIdx.x], lcnt[threadIdx.x]);
    __syncthreads();
    if (threadIdx.x < 256) { const int lt = threadIdx.x >> 1, c = threadIdx.x & 1, e = tinfo[lt][c]; const unsigned pos = lbase[c * 8 + e] + tpos[lt][c];
        ((int*)(ws + WS_LIST))[(size_t)(c * 8 + e) * T + pos] = blockIdx.x * 128 + lt; ((float*)(ws + WS_GATE))[(size_t)(c * 8 + e) * T + pos] = tg[lt][c]; }
}
__global__ void __launch_bounds__(256) nk_final(Params p) {
    const int gw = blockIdx.x * 4 + (threadIdx.x >> 6), ngw = gridDim.x * 4, lane = threadIdx.x & 63;
    for (int m = gw; m < T; m += ngw) final_norm_row(p.out + (size_t)m * DM, p.in[18], lane);
}

namespace pg8 {
#define PG8_LAS __attribute__((address_space(3)))
constexpr int BM = 256, BK = 64, HALF = 128, HTB = HALF * BK * 2, STAGE_BYTES = 8 * HTB, NXCD = 8, WGM = 8;
__host__ __device__ __forceinline__ int lds_byte(int r, int c) { const int st = (r >> 4) * 2 + (c >> 5), rr = r & 15, cc = c & 31, ob = rr * 64 + cc * 2; return st * 1024 + (ob ^ (((ob >> 9) & 1) << 5)); }
__host__ __device__ __forceinline__ void stage_rc(int b, int& R, int& C) { const int st = b / 1024, sb = b % 1024, swz = sb ^ (((sb >> 9) & 1) << 5); R = (st >> 1) * 16 + swz / 64; C = (st & 1) * 32 + (swz % 64) / 2; }
__host__ __device__ __forceinline__ int perm32(int rho) { const int n = rho >> 4, i = rho & 15; return 8 * (i >> 2) + 4 * n + (i & 3); }
struct Unit { int pm, pn; };
struct StaticOrder {
    int nM, nN, nwg, G, c;
    __device__ void init(int nM_, int nN_, int G_, int c_) { nM = nM_; nN = nN_; nwg = nM * nN; G = G_; c = c_; }
    __device__ bool next(int i, Unit& u) const {
        const long L = (long)i * G + c; if (L >= nwg) return false;
        int wgid = (int)L; { const int q = nwg / NXCD, r = nwg % NXCD, xcd = wgid % NXCD, off = wgid / NXCD; wgid = (xcd < r ? xcd * (q + 1) : r * (q + 1) + (xcd - r) * q) + off; }
        const int nig = WGM * nN, gid = wgid / nig, fm = gid * WGM, gsz = (nM - fm) < WGM ? (nM - fm) : WGM;
        u.pm = fm + ((wgid % nig) % gsz); u.pn = (wgid % nig) / gsz; return true;
    }
};
struct ProbDense { const bf16* A; const bf16* Bt; int K; static constexpr bool GATHER = false;
    __device__ __forceinline__ const char* a_tile(const Unit& u) const { return (const char*)A + (size_t)u.pm * BM * K * 2; }
    __device__ __forceinline__ const char* b_tile(const Unit& u) const { return (const char*)Bt + (size_t)u.pn * BM * K * 2; }
    __device__ __forceinline__ void a_offsets(const Unit&, const int (&)[2], const int (&)[2], unsigned (&)[2][2]) const {}
};
struct ProbMoeDown { const bf16* A; const bf16* Bt; int K; size_t estride; const unsigned* ctl; int c; static constexpr bool GATHER = false;
    __device__ __forceinline__ const char* a_tile(const Unit& u) const { return (const char*)A + (size_t)u.pm * BM * K * 2; }
    __device__ __forceinline__ const char* b_tile(const Unit& u) const { int e = 0, r0, nr; moe_tile(ctl, c, u.pm, e, r0, nr); return (const char*)Bt + (size_t)e * estride + (size_t)u.pn * BM * K * 2; }
    __device__ __forceinline__ void a_offsets(const Unit&, const int (&)[2], const int (&)[2], unsigned (&)[2][2]) const {}
};
struct ProbMoeGU { const bf16* A; const bf16* Bt; int K; size_t estride; const unsigned* ctl; int c; const int* lists; static constexpr bool GATHER = true;
    __device__ __forceinline__ const char* a_tile(const Unit&) const { return (const char*)A; }
    __device__ __forceinline__ const char* b_tile(const Unit& u) const { int e = 0, r0, nr; moe_tile(ctl, c, u.pm, e, r0, nr); return (const char*)Bt + (size_t)e * estride + (size_t)u.pn * BM * K * 2; }
    __device__ __forceinline__ void a_offsets(const Unit& u, const int (&RA)[2], const int (&CA)[2], unsigned (&off)[2][2]) const {
        int e = 0, r0 = 0, nr = 1; moe_tile(ctl, c, u.pm, e, r0, nr); const int* l = lists + (size_t)(c * 8 + e) * T + r0;
#pragma unroll
        for (int h = 0; h < 2; ++h)
#pragma unroll
            for (int i = 0; i < 2; ++i) { const int r = h * HALF + RA[i]; const int tok = l[r < nr ? r : 0]; off[h][i] = (unsigned)tok * (unsigned)(K * 2) + (unsigned)(CA[i] * 2); }
    }
};

#define PG8_EARGS const f32x4 (&acc)[2][2][4][2], const Unit& u, int wr, int wc, int fr, int fq
__device__ __forceinline__ u32x4 pack8(const f32x4 a, const f32x4 b) { u32x4 w; w.x = pk2(a[0], a[1]); w.y = pk2(a[2], a[3]); w.z = pk2(b[0], b[1]); w.w = pk2(b[2], b[3]); return w; }
__device__ __forceinline__ float quad_rstd(const float* part, int row, int fq) {
    const f32x4 q = *(const f32x4*)(part + (size_t)row * 16 + 4 * fq); float s = (q[0] + q[1]) + (q[2] + q[3]);
    s += __shfl_xor(s, 16); s += __shfl_xor(s, 32); return 1.0f / sqrtf(s * (1.f / DM) + NORM_EPS);
}
#define PG8_BATCH_FENCE() do { asm volatile("" ::: "memory"); __builtin_amdgcn_sched_barrier(0); } while (0)
struct EpiInEven { static constexpr bool PERM = true; bf16* O; const float2* rope;
    __device__ __forceinline__ void operator()(PG8_EARGS) const {
        const int pn = u.pn, row0 = u.pm * BM + wr * 64 + fr, colb = pn * BM + wc * 32 + 8 * fq;
        if (pn < 4) {
            const float sc = (pn >= 2) ? 0.125f : 1.f;
#pragma unroll
            for (int ai = 0; ai < 2; ++ai) {
                f32x4 cs[4][2];
#pragma unroll
                for (int m = 0; m < 4; ++m) { const int row = row0 + ai * HALF + m * 16; const f32x4* rp = (const f32x4*)(rope + (size_t)(row & (SEQ - 1)) * 32 + 16 * (wc & 1) + 4 * fq); cs[m][0] = rp[0]; cs[m][1] = rp[1]; }
                PG8_BATCH_FENCE();
#pragma unroll
                for (int m = 0; m < 4; ++m) { const int row = row0 + ai * HALF + m * 16; const f32x4 cs0 = cs[m][0], cs1 = cs[m][1];
#pragma unroll
                    for (int bj = 0; bj < 2; ++bj) { const f32x4 v0 = acc[ai][bj][m][0], v1 = acc[ai][bj][m][1]; f32x4 a, b;
                        a[0] = v0[0] * cs0[0] - v0[1] * cs0[1]; a[1] = v0[0] * cs0[1] + v0[1] * cs0[0]; a[2] = v0[2] * cs0[2] - v0[3] * cs0[3]; a[3] = v0[2] * cs0[3] + v0[3] * cs0[2];
                        b[0] = v1[0] * cs1[0] - v1[1] * cs1[1]; b[1] = v1[0] * cs1[1] + v1[1] * cs1[0]; b[2] = v1[2] * cs1[2] - v1[3] * cs1[3]; b[3] = v1[2] * cs1[3] + v1[3] * cs1[2];
                        *(u32x4*)(O + (size_t)row * EW + colb + bj * HALF) = pack8(a * sc, b * sc); } } }
        } else {
            const float sc = (pn == 8 || pn == 9) ? C2 : 1.f;
#pragma unroll
            for (int ai = 0; ai < 2; ++ai)
#pragma unroll
                for (int m = 0; m < 4; ++m) { const int row = row0 + ai * HALF + m * 16;
#pragma unroll
                    for (int bj = 0; bj < 2; ++bj) *(u32x4*)(O + (size_t)row * EW + colb + bj * HALF) = pack8(acc[ai][bj][m][0] * sc, acc[ai][bj][m][1] * sc); }
        }
    }
};
struct EpiResid { static constexpr bool PERM = true; const float* resid; float* out; bf16* hb; float* part;
    __device__ __forceinline__ void operator()(PG8_EARGS) const {
        const int row0 = u.pm * BM + wr * 64 + fr, colb = u.pn * BM + wc * 32 + 8 * fq;
#pragma unroll
        for (int ai = 0; ai < 2; ++ai) {
            f32x4 rr[4][2][2];
#pragma unroll
            for (int m = 0; m < 4; ++m)
#pragma unroll
                for (int bj = 0; bj < 2; ++bj) { const size_t off = (size_t)(row0 + ai * HALF + m * 16) * DM + colb + bj * HALF; rr[m][bj][0] = *(const f32x4*)(resid + off); rr[m][bj][1] = *(const f32x4*)(resid + off + 4); }
            PG8_BATCH_FENCE();
#pragma unroll
            for (int m = 0; m < 4; ++m) { const int row = row0 + ai * HALF + m * 16; float ss = 0.f;
#pragma unroll
                for (int bj = 0; bj < 2; ++bj) { const size_t off = (size_t)row * DM + colb + bj * HALF;
                    const f32x4 o0 = rr[m][bj][0] + acc[ai][bj][m][0], o1 = rr[m][bj][1] + acc[ai][bj][m][1];
                    *(f32x4*)(out + off) = o0; *(f32x4*)(out + off + 4) = o1; *(u32x4*)(hb + off) = pack8(o0, o1);
                    ss += (o0[0] * o0[0] + o0[1] * o0[1]) + (o0[2] * o0[2] + o0[3] * o0[3]) + (o1[0] * o1[0] + o1[1] * o1[1]) + (o1[2] * o1[2] + o1[3] * o1[3]); }
                ss += __shfl_xor(ss, 16); ss += __shfl_xor(ss, 32);
                if (fq == 0) part[(size_t)row * 16 + u.pn * 4 + wc] = ss; }
            PG8_BATCH_FENCE(); }
    }
};
__device__ __forceinline__ float fast_silu(float x) { return x * __builtin_amdgcn_rcpf(1.f + __builtin_amdgcn_exp2f(-LOG2E * x)); }
struct EpiGU { static constexpr bool PERM = true; bf16* hid; const float* part;
    __device__ __forceinline__ void operator()(PG8_EARGS) const {
        const int row0 = u.pm * BM + wr * 64 + fr, colb = u.pn * HALF + wc * 32 + 8 * fq;
        f32x4 q[2][4];
#pragma unroll
        for (int ai = 0; ai < 2; ++ai)
#pragma unroll
            for (int m = 0; m < 4; ++m) q[ai][m] = *(const f32x4*)(part + (size_t)(row0 + ai * HALF + m * 16) * 16 + 4 * fq);
        PG8_BATCH_FENCE();
#pragma unroll
        for (int ai = 0; ai < 2; ++ai)
#pragma unroll
            for (int m = 0; m < 4; ++m) { const int row = row0 + ai * HALF + m * 16; float s = (q[ai][m][0] + q[ai][m][1]) + (q[ai][m][2] + q[ai][m][3]);
                s += __shfl_xor(s, 16); s += __shfl_xor(s, 32); const float rs = 1.0f / sqrtf(s * (1.f / DM) + NORM_EPS);
                f32x4 h0, h1;
#pragma unroll
                for (int e = 0; e < 4; ++e) { h0[e] = fast_silu(acc[ai][0][m][0][e] * rs) * (acc[ai][1][m][0][e] * rs); h1[e] = fast_silu(acc[ai][0][m][1][e] * rs) * (acc[ai][1][m][1][e] * rs); }
                *(u32x4*)(hid + (size_t)row * DFF + colb) = pack8(h0, h1); }
    }
};
struct EpiInOdd { static constexpr bool PERM = true; bf16* O; const float* part; const float* bias; float* logf;
    __device__ __forceinline__ void operator()(PG8_EARGS) const {
        const int pn = u.pn, row0 = u.pm * BM + wr * 64 + fr, colb = pn * BM + wc * 32 + 8 * fq;
        const float sc = pn < 4 ? C2 : 1.f;
        f32x4 q[2][4]; float rs[2][4];
#pragma unroll
        for (int ai = 0; ai < 2; ++ai)
#pragma unroll
            for (int m = 0; m < 4; ++m) q[ai][m] = *(const f32x4*)(part + (size_t)(row0 + ai * HALF + m * 16) * 16 + 4 * fq);
        PG8_BATCH_FENCE();
#pragma unroll
        for (int ai = 0; ai < 2; ++ai)
#pragma unroll
            for (int m = 0; m < 4; ++m) { float s = (q[ai][m][0] + q[ai][m][1]) + (q[ai][m][2] + q[ai][m][3]); s += __shfl_xor(s, 16); s += __shfl_xor(s, 32); rs[ai][m] = 1.0f / sqrtf(s * (1.f / DM) + NORM_EPS); }
        if (pn < 12) {
#pragma unroll
            for (int ai = 0; ai < 2; ++ai)
#pragma unroll
                for (int m = 0; m < 4; ++m) { const int row = row0 + ai * HALF + m * 16;
#pragma unroll
                    for (int bj = 0; bj < 2; ++bj) *(u32x4*)(O + (size_t)row * QKVW + colb + bj * HALF) = pack8(acc[ai][bj][m][0] * (rs[ai][m] * sc), acc[ai][bj][m][1] * (rs[ai][m] * sc)); }
        } else if (wc == 0 && fq < 2) {
            f32x4 b0 = *(const f32x4*)(bias + 8 * fq), b1 = *(const f32x4*)(bias + 8 * fq + 4);
#pragma unroll
            for (int ai = 0; ai < 2; ++ai)
#pragma unroll
                for (int m = 0; m < 4; ++m) { const int row = row0 + ai * HALF + m * 16;
#pragma unroll
                    for (int n = 0; n < 2; ++n)
#pragma unroll
                        for (int e = 0; e < 4; ++e) { const int h = 8 * fq + 4 * n + e; const float z = acc[ai][0][m][n][e] * rs[ai][m] + (n ? b1[e] : b0[e]);
                            logf[((size_t)(row >> 12) * 16 + h) * SEQ + (row & (SEQ - 1))] = fminf(z, 0.f) - __logf(1.f + __expf(-fabsf(z))); } }
        }
    }
};
struct EpiMoeGU { static constexpr bool PERM = true; bf16* hid; const float* rstd4; const unsigned* ctl; int c; const int* lists;
    __device__ __forceinline__ void operator()(PG8_EARGS) const {
        int e = 0, r0 = 0, nr = 1; moe_tile(ctl, c, u.pm, e, r0, nr); const int* l = lists + (size_t)(c * 8 + e) * T + r0;
        const int rl0 = wr * 64 + fr, colb = u.pn * HALF + wc * 32 + 8 * fq;
        int tk[2][4]; float rs[2][4];
#pragma unroll
        for (int ai = 0; ai < 2; ++ai)
#pragma unroll
            for (int m = 0; m < 4; ++m) { const int rl = rl0 + ai * HALF + m * 16; tk[ai][m] = l[rl < nr ? rl : 0]; }
        PG8_BATCH_FENCE();
#pragma unroll
        for (int ai = 0; ai < 2; ++ai)
#pragma unroll
            for (int m = 0; m < 4; ++m) rs[ai][m] = rstd4[tk[ai][m]];
        PG8_BATCH_FENCE();
#pragma unroll
        for (int ai = 0; ai < 2; ++ai)
#pragma unroll
            for (int m = 0; m < 4; ++m) { const int rl = rl0 + ai * HALF + m * 16; const float r = rs[ai][m];
                f32x4 h0, h1;
#pragma unroll
                for (int x = 0; x < 4; ++x) { h0[x] = fast_silu(acc[ai][0][m][0][x] * r) * (acc[ai][1][m][0][x] * r); h1[x] = fast_silu(acc[ai][0][m][1][x] * r) * (acc[ai][1][m][1][x] * r); }
                *(u32x4*)(hid + (size_t)(u.pm * BM + rl) * DFF + colb) = pack8(h0, h1); }
    }
};
struct EpiMoeDown { static constexpr bool PERM = true; float* out; const unsigned* ctl; int c; const int* lists; const float* gates;
    __device__ __forceinline__ void operator()(PG8_EARGS) const {
        int e = 0, r0 = 0, nr = 0; moe_tile(ctl, c, u.pm, e, r0, nr); const int* l = lists + (size_t)(c * 8 + e) * T + r0; const float* g = gates + (size_t)(c * 8 + e) * T + r0;
        const int rl0 = wr * 64 + fr, colb = u.pn * BM + wc * 32 + 8 * fq;
        int tk[2][4]; float gt[2][4];
#pragma unroll
        for (int ai = 0; ai < 2; ++ai)
#pragma unroll
            for (int m = 0; m < 4; ++m) { const int rl = rl0 + ai * HALF + m * 16; const bool ok = rl < nr; tk[ai][m] = l[ok ? rl : 0]; gt[ai][m] = ok ? g[ok ? rl : 0] : 0.f; }
        PG8_BATCH_FENCE();
#pragma unroll
        for (int ai = 0; ai < 2; ++ai) {
            f32x4 rr[4][2][2];
#pragma unroll
            for (int m = 0; m < 4; ++m)
#pragma unroll
                for (int bj = 0; bj < 2; ++bj) { const float* o = out + (size_t)tk[ai][m] * DM + colb + bj * HALF; rr[m][bj][0] = *(const f32x4*)o; rr[m][bj][1] = *(const f32x4*)(o + 4); }
            PG8_BATCH_FENCE();
#pragma unroll
            for (int m = 0; m < 4; ++m) { const int rl = rl0 + ai * HALF + m * 16;
                if (rl < nr) {
#pragma unroll
                    for (int bj = 0; bj < 2; ++bj) { float* o = out + (size_t)tk[ai][m] * DM + colb + bj * HALF;
                        *(f32x4*)o = rr[m][bj][0] + acc[ai][bj][m][0] * gt[ai][m]; *(f32x4*)(o + 4) = rr[m][bj][1] + acc[ai][bj][m][1] * gt[ai][m]; } } }
            PG8_BATCH_FENCE(); }
    }
};

template <class Prob, class Epi, class Sched>
__device__ __forceinline__ void gemm_phase(PG8_LAS unsigned char* lds, const Prob& P, const Sched& S, const Epi& E) {
    const int tid = threadIdx.x, wid = __builtin_amdgcn_readfirstlane(tid >> 6), lane = tid & 63, wr = wid >> 2, wc = wid & 3, fr = lane & 15, fq = lane >> 4;
    const int K = P.K, nt = K / BK;
    unsigned voffA[2], voffB[2]; int RA[2], CA[2];
#pragma unroll
    for (int i = 0; i < 2; ++i) { int R, C; stage_rc(tid * 16 + i * 8192, R, C); const int Rb = Epi::PERM ? ((R & ~31) + perm32(R & 31)) : R;
        voffA[i] = (unsigned)(R * K + C) * 2u; voffB[i] = (unsigned)(Rb * K + C) * 2u; RA[i] = R; CA[i] = C; }
    const size_t kstep = (size_t)(BK * 2);
    const size_t hstep = (size_t)HALF * K * 2;
    const unsigned ldsw = (unsigned)wid * 1024u;
    const int aoff = lds_byte(wr * 64 + fr, fq * 8), boff = lds_byte(wc * 32 + fr, fq * 8);
    unsigned offC[2][2] = {{0u, 0u}, {0u, 0u}}, offN[2][2] = {{0u, 0u}, {0u, 0u}};
#define PG8_SA(b, h) (((b) * 2 + (h)) * HTB)
#define PG8_SB(b, h) ((4 + (b) * 2 + (h)) * HTB)
#define PG8_STAGE(bufoff, gbase, voff) do { _Pragma("unroll") for (int _i = 0; _i < 2; ++_i) \
        __builtin_amdgcn_global_load_lds((const unsigned*)((const char*)(gbase) + (voff)[_i]), (PG8_LAS unsigned*)(lds + (bufoff) + ldsw + _i * 8192), 16, 0, 0); } while (0)
#define PG8_STAGE_A(bufoff, gbase, h, nx) do { _Pragma("unroll") for (int _i = 0; _i < 2; ++_i) { \
        const size_t _o = Prob::GATHER ? (size_t)((nx) ? offN[h][_i] : offC[h][_i]) : (size_t)voffA[_i] + (size_t)(h) * hstep; \
        __builtin_amdgcn_global_load_lds((const unsigned*)((const char*)(gbase) + _o), (PG8_LAS unsigned*)(lds + (bufoff) + ldsw + _i * 8192), 16, 0, 0); } } while (0)
#define PG8_LDA(dst, b, h) do { _Pragma("unroll") for (int m = 0; m < 4; ++m) _Pragma("unroll") for (int k = 0; k < 2; ++k) dst[m][k] = *(const PG8_LAS bf16x8*)(lds + PG8_SA(b, h) + aoff + m * 2048 + k * 1024); } while (0)
#define PG8_LDB(dst, b, h) do { _Pragma("unroll") for (int n = 0; n < 2; ++n) _Pragma("unroll") for (int k = 0; k < 2; ++k) dst[n][k] = *(const PG8_LAS bf16x8*)(lds + PG8_SB(b, h) + boff + n * 2048 + k * 1024); } while (0)
#define PG8_MMA(ai, bj, At, Bt) do { __builtin_amdgcn_s_setprio(1); _Pragma("unroll") for (int m = 0; m < 4; ++m) _Pragma("unroll") for (int n = 0; n < 2; ++n) _Pragma("unroll") for (int k = 0; k < 2; ++k) \
        acc[ai][bj][m][n] = __builtin_amdgcn_mfma_f32_16x16x32_bf16(Bt[n][k], At[m][k], acc[ai][bj][m][n], 0, 0, 0); __builtin_amdgcn_s_setprio(0); } while (0)
#define PG8_WAIT_V(n) asm volatile("s_waitcnt vmcnt(" #n ")" ::: "memory")
#define PG8_WAIT_L(n) asm volatile("s_waitcnt lgkmcnt(" #n ")" ::: "memory")
#define PG8_BAR __builtin_amdgcn_s_barrier()
#define PG8_SCHED __builtin_amdgcn_sched_barrier(0)
    Unit cur, nxt; int ui = 0;
    if (!S.next(0, cur)) return;
    f32x4 acc[2][2][4][2];
#pragma unroll
    for (int a = 0; a < 2; ++a)
#pragma unroll
        for (int b = 0; b < 2; ++b)
#pragma unroll
            for (int m = 0; m < 4; ++m)
#pragma unroll
                for (int n = 0; n < 2; ++n) acc[a][b][m][n] = (f32x4){0.f, 0.f, 0.f, 0.f};
    bf16x8 At[4][2], B0[2][2], B1[2][2];
    const char* cA = P.a_tile(cur); const char* cB = P.b_tile(cur);
    if constexpr (Prob::GATHER) P.a_offsets(cur, RA, CA, offC);
    PG8_STAGE(PG8_SB(0, 0), cB, voffB); PG8_STAGE(PG8_SB(0, 1), cB + hstep, voffB); PG8_STAGE_A(PG8_SA(0, 0), cA, 0, false); PG8_STAGE_A(PG8_SA(0, 1), cA, 1, false);
    if (wr == 1) PG8_BAR;
    PG8_WAIT_V(2); PG8_BAR;
    PG8_STAGE(PG8_SB(1, 0), cB + kstep, voffB); PG8_STAGE_A(PG8_SA(1, 0), cA + kstep, 0, false); PG8_STAGE(PG8_SB(1, 1), cB + hstep + kstep, voffB);
    PG8_WAIT_V(6); PG8_BAR;
    for (;;) {
        const bool has_next = S.next(ui + 1, nxt);
        const char* nA = has_next ? P.a_tile(nxt) : cA; const char* nB = has_next ? P.b_tile(nxt) : cB;
        if constexpr (Prob::GATHER) { if (has_next) P.a_offsets(nxt, RA, CA, offN); else {
#pragma unroll
            for (int h = 0; h < 2; ++h)
#pragma unroll
                for (int i = 0; i < 2; ++i) offN[h][i] = offC[h][i]; } }
        for (int t = 0; t < nt; t += 2) {
            const bool last = (t == nt - 2);
            const char* a1 = cA + (size_t)(t + 1) * kstep;
            const char* a2 = last ? nA : cA + (size_t)(t + 2) * kstep; const char* b2 = last ? nB : cB + (size_t)(t + 2) * kstep;
            const char* a3 = a2 + kstep; const char* b3 = b2 + kstep;
            PG8_LDB(B0, 0, 0); PG8_LDB(B1, 0, 1); PG8_SCHED; PG8_LDA(At, 0, 0); PG8_STAGE_A(PG8_SA(1, 1), a1, 1, false);
            PG8_WAIT_V(8); PG8_WAIT_L(0); PG8_BAR; PG8_MMA(0, 0, At, B0); PG8_MMA(0, 1, At, B1); PG8_BAR; PG8_SCHED;
            PG8_LDA(At, 0, 1); PG8_STAGE(PG8_SB(0, 0), b2, voffB); PG8_STAGE(PG8_SB(0, 1), b2 + hstep, voffB); PG8_STAGE_A(PG8_SA(0, 0), a2, 0, last);
            PG8_WAIT_V(8); PG8_WAIT_L(0); PG8_BAR; PG8_MMA(1, 0, At, B0); PG8_MMA(1, 1, At, B1); PG8_BAR; PG8_SCHED;
            PG8_LDB(B0, 1, 0); PG8_LDB(B1, 1, 1); PG8_SCHED; PG8_LDA(At, 1, 0); PG8_STAGE_A(PG8_SA(0, 1), a2, 1, last);
            PG8_WAIT_V(8); PG8_WAIT_L(0); PG8_BAR; PG8_MMA(0, 0, At, B0); PG8_MMA(0, 1, At, B1); PG8_BAR; PG8_SCHED;
            PG8_LDA(At, 1, 1); PG8_STAGE(PG8_SB(1, 0), b3, voffB); PG8_STAGE(PG8_SB(1, 1), b3 + hstep, voffB); PG8_STAGE_A(PG8_SA(1, 0), a3, 0, last);
            PG8_WAIT_V(8); PG8_WAIT_L(0); PG8_BAR; PG8_MMA(1, 0, At, B0); PG8_MMA(1, 1, At, B1); PG8_BAR; PG8_SCHED;
        }
        if (wr == 0) PG8_BAR;
        E(acc, cur, wr, wc, fr, fq);
        if (!has_next) break;
#pragma unroll
        for (int a = 0; a < 2; ++a)
#pragma unroll
            for (int b = 0; b < 2; ++b)
#pragma unroll
                for (int m = 0; m < 4; ++m)
#pragma unroll
                    for (int n = 0; n < 2; ++n) acc[a][b][m][n] = (f32x4){0.f, 0.f, 0.f, 0.f};
        cur = nxt; cA = nA; cB = nB; ++ui;
        if constexpr (Prob::GATHER) {
#pragma unroll
            for (int h = 0; h < 2; ++h)
#pragma unroll
                for (int i = 0; i < 2; ++i) offC[h][i] = offN[h][i]; }
        if (wr == 1) PG8_BAR;
    }
    PG8_WAIT_V(0);
    PG8_BAR;
#undef PG8_SA
#undef PG8_SB
#undef PG8_STAGE
#undef PG8_STAGE_A
#undef PG8_LDA
#undef PG8_LDB
#undef PG8_MMA
#undef PG8_WAIT_V
#undef PG8_WAIT_L
#undef PG8_BAR
#undef PG8_SCHED
}
}
namespace att {
#define ALAS __attribute__((address_space(3)))
typedef _Float16 f16x8 __attribute__((ext_vector_type(8)));
typedef short s16x4 __attribute__((ext_vector_type(4)));
typedef short v4i16_t __attribute__((ext_vector_type(4)));
constexpr int KSTR = 144, VSTR = 192;
constexpr int KT_BYTES = 64 * KSTR, VT_BYTES = 64 * VSTR, STAGE = KT_BYTES + VT_BYTES;
constexpr int FLAG_OFF = 2 * STAGE;
constexpr int CUM_OFF = 49152;
constexpr float EXIT_T = -152.0f;
__device__ __forceinline__ int crow(int r, int hi) { return (r & 3) + 8 * (r >> 2) + 4 * hi; }
__device__ __forceinline__ bf16x8 vtr2(const ALAS unsigned char* p0, const ALAS unsigned char* p1) {
    const s16x4 a = __builtin_bit_cast(s16x4, __builtin_amdgcn_ds_read_tr16_b64_v4i16((ALAS v4i16_t*)p0));
    const s16x4 b = __builtin_bit_cast(s16x4, __builtin_amdgcn_ds_read_tr16_b64_v4i16((ALAS v4i16_t*)p1));
    return (bf16x8){a[0], a[1], a[2], a[3], b[0], b[1], b[2], b[3]};
}
__device__ __forceinline__ bf16x8 packbf8(const f32x16& p, int b) { u32x4 w; w.x = pk2(p[b], p[b + 1]); w.y = pk2(p[b + 2], p[b + 3]); w.z = pk2(p[b + 4], p[b + 5]); w.w = pk2(p[b + 6], p[b + 7]); return __builtin_bit_cast(bf16x8, w); }
__device__ __forceinline__ f16x8 packh8(const f32x16& p, int b) { f16x8 h;
#pragma unroll
    for (int j = 0; j < 8; ++j) h[j] = (_Float16)p[b + j];
    return h; }
__device__ __forceinline__ void pv_tile(f32x16 (&o)[2], const ALAS unsigned char* vb, int vl, const bf16x8 (&pb)[4]) {
#pragma unroll
    for (int dh = 0; dh < 2; ++dh)
#pragma unroll
        for (int s = 0; s < 4; ++s) { const ALAS unsigned char* a = vb + vl + (16 * s) * VSTR + dh * 64;
            o[dh] = __builtin_amdgcn_mfma_f32_32x32x16_bf16(vtr2(a, a + 8 * VSTR), pb[s], o[dh], 0, 0, 0); }
}
template <int MODE>
__device__ __forceinline__ void unit(ALAS unsigned char* lds, const bf16* Q, const bf16* K, const bf16* V, int pitch, bf16* O, size_t rowbase, int q0, const ALAS float* cum2) {
    const int tid = threadIdx.x, lane = tid & 63, r32 = lane & 31, hi = lane >> 5, wid = __builtin_amdgcn_readfirstlane(tid >> 6);
    const int R0 = q0 + 32 * wid, qrow = R0 + r32;
    bf16x8 qr[4];
#pragma unroll
    for (int d0 = 0; d0 < 4; ++d0) qr[d0] = *(const bf16x8*)(Q + (rowbase + qrow) * pitch + 16 * d0 + 8 * hi);
    const int srow = tid >> 3, sch = tid & 7;
    const bf16* kg = K + (rowbase + srow) * pitch + sch * 8; const bf16* vg = V + (rowbase + srow) * pitch + sch * 8;
    const int kdst = srow * KSTR + sch * 16, vdst = KT_BYTES + srow * VSTR + sch * 16;
    const int kl = r32 * KSTR + 16 * hi;
    const int vl = (4 * hi + ((lane & 15) >> 2)) * VSTR + (16 * ((lane >> 4) & 1) + 4 * (lane & 3)) * 2;
    ALAS unsigned* flags = (ALAS unsigned*)(lds + FLAG_OFF);
    const int jtop = (q0 >> 6) + 3;
    u32x4 kreg = *(const u32x4*)(kg + (size_t)jtop * 64 * pitch), vreg = *(const u32x4*)(vg + (size_t)jtop * 64 * pitch);
    *(ALAS u32x4*)(lds + kdst) = kreg; *(ALAS u32x4*)(lds + vdst) = vreg;
    __syncthreads();
    f32x16 o[2];
#pragma unroll
    for (int r = 0; r < 16; ++r) { o[0][r] = 0.f; o[1][r] = 0.f; }
    float carry = 0.f, m = 0.f, l = 0.f; bool started = false;
    const float cq = (MODE == 1) ? -cum2[qrow] : 0.f; float qn = 0.f;
    if (MODE == 1) { float s2 = 0.f;
#pragma unroll
        for (int d0 = 0; d0 < 4; ++d0)
#pragma unroll
            for (int j = 0; j < 8; ++j) { const float v = bf2f((unsigned short)qr[d0][j]); s2 += v * v; }
        s2 += __shfl_xor(s2, 32); qn = sqrtf(s2) * 1.002f; }
    f16x8 M0, M1, ONES;
#pragma unroll
    for (int j = 0; j < 8; ++j) { const int kk = 8 * (j >> 2) + 4 * hi + (j & 3); M0[j] = (kk > r32) ? (_Float16)1.f : (_Float16)0.f; M1[j] = (16 + kk > r32) ? (_Float16)1.f : (_Float16)0.f; ONES[j] = (_Float16)1.f; }
    int cur = 0;
    for (int j = jtop; j >= 0; --j) {
        const bool more = j > 0;
        if (more) { kreg = *(const u32x4*)(kg + (size_t)(j - 1) * 64 * pitch); vreg = *(const u32x4*)(vg + (size_t)(j - 1) * 64 * pitch); }
        const ALAS unsigned char* kb = lds + cur * STAGE; const ALAS unsigned char* vb = kb + KT_BYTES;
        const int key0 = 64 * j;
        if (key0 <= R0 + 31) {
            const bool diag = key0 + 63 >= R0;
            f32x16 p0, p1;
            if (MODE == 1) { const float cqm = cq - m;
#pragma unroll
                for (int g = 0; g < 4; ++g) { const f32x4 cb0 = *(const ALAS f32x4*)(cum2 + key0 + 8 * g + 4 * hi), cb1 = *(const ALAS f32x4*)(cum2 + key0 + 32 + 8 * g + 4 * hi);
#pragma unroll
                    for (int e = 0; e < 4; ++e) { p0[4 * g + e] = cqm + cb0[e]; p1[4 * g + e] = cqm + cb1[e]; } }
            } else {
#pragma unroll
                for (int r = 0; r < 16; ++r) { p0[r] = 0.f; p1[r] = 0.f; } }
#pragma unroll
            for (int d0 = 0; d0 < 4; ++d0) { const bf16x8 ka = *(const ALAS bf16x8*)(kb + kl + 32 * d0), kc = *(const ALAS bf16x8*)(kb + kl + 32 * KSTR + 32 * d0);
                p0 = __builtin_amdgcn_mfma_f32_32x32x16_bf16(ka, qr[d0], p0, 0, 0, 0); p1 = __builtin_amdgcn_mfma_f32_32x32x16_bf16(kc, qr[d0], p1, 0, 0, 0); }
            bf16x8 pb[4];
            if (MODE == 0) {
                f32x16 l0, l1; float rs = 0.f;
#pragma unroll
                for (int r = 0; r < 16; ++r) { const int key = key0 + crow(r, hi);
                    float a = -softplus2(p0[r]), b = -softplus2(p1[r]);
                    if (diag) { if (!(key < qrow)) a = 0.f; if (!(key + 32 < qrow)) b = 0.f; }
                    l0[r] = a; l1[r] = b; rs += a + b; }
                rs += __shfl_xor(rs, 32);
                const f16x8 lb0 = packh8(l0, 0), lb1 = packh8(l0, 8), lb2 = packh8(l1, 0), lb3 = packh8(l1, 8);
                f32x16 c0, c1;
#pragma unroll
                for (int r = 0; r < 16; ++r) { c0[r] = carry; c1[r] = carry; }
                c0 = __builtin_amdgcn_mfma_f32_32x32x16_f16(M0, lb0, c0, 0, 0, 0); c0 = __builtin_amdgcn_mfma_f32_32x32x16_f16(M1, lb1, c0, 0, 0, 0);
                c0 = __builtin_amdgcn_mfma_f32_32x32x16_f16(ONES, lb2, c0, 0, 0, 0); c0 = __builtin_amdgcn_mfma_f32_32x32x16_f16(ONES, lb3, c0, 0, 0, 0);
                c1 = __builtin_amdgcn_mfma_f32_32x32x16_f16(M0, lb2, c1, 0, 0, 0); c1 = __builtin_amdgcn_mfma_f32_32x32x16_f16(M1, lb3, c1, 0, 0, 0);
#pragma unroll
                for (int r = 0; r < 16; ++r) { const int key = key0 + crow(r, hi);
                    float a = __builtin_amdgcn_exp2f(p0[r] + l0[r] + c0[r]), b = __builtin_amdgcn_exp2f(p1[r] + l1[r] + c1[r]);
                    if (diag) { if (!(key < qrow)) a = 0.f; if (!(key + 32 < qrow)) b = 0.f; }
                    p0[r] = a; p1[r] = b; }
                carry += rs;
            } else {
                if (diag) {
#pragma unroll
                    for (int r = 0; r < 16; ++r) { const int key = key0 + crow(r, hi); if (key > qrow) p0[r] = -INFINITY; if (key + 32 > qrow) p1[r] = -INFINITY; } }
                float ma = __builtin_fmaxf(__builtin_fmaxf(p0[0], p0[1]), p1[0]), mb = __builtin_fmaxf(__builtin_fmaxf(p0[2], p0[3]), p1[1]);
                ma = __builtin_fmaxf(__builtin_fmaxf(ma, p1[2]), p1[3]);
#pragma unroll
                for (int r = 4; r < 16; r += 4) { ma = __builtin_fmaxf(__builtin_fmaxf(ma, p0[r]), p0[r + 1]); mb = __builtin_fmaxf(__builtin_fmaxf(mb, p0[r + 2]), p0[r + 3]);
                    ma = __builtin_fmaxf(__builtin_fmaxf(ma, p1[r]), p1[r + 1]); mb = __builtin_fmaxf(__builtin_fmaxf(mb, p1[r + 2]), p1[r + 3]); }
                float mt = __builtin_fmaxf(ma, mb); mt = __builtin_fmaxf(mt, __shfl_xor(mt, 32));
                if (!started) {
                    m = mt;
#pragma unroll
                    for (int r = 0; r < 16; ++r) { p0[r] -= mt; p1[r] -= mt; }
                    started = true;
                } else if (__any(mt > 0.f)) {
                    const float dl = __builtin_fmaxf(mt, 0.f); m += dl; const float f = __builtin_amdgcn_exp2f(-dl); l *= f; o[0] = o[0] * f; o[1] = o[1] * f;
#pragma unroll
                    for (int r = 0; r < 16; ++r) { p0[r] -= dl; p1[r] -= dl; } }
                float ls = 0.f;
#pragma unroll
                for (int r = 0; r < 16; ++r) { p0[r] = __builtin_amdgcn_exp2f(p0[r]); p1[r] = __builtin_amdgcn_exp2f(p1[r]); ls += p0[r] + p1[r]; }
                l += ls;
            }
            pb[0] = packbf8(p0, 0); pb[1] = packbf8(p0, 8); pb[2] = packbf8(p1, 0); pb[3] = packbf8(p1, 8);
            pv_tile(o, vb, vl, pb);
        }
        if (more) { *(ALAS u32x4*)(lds + (cur ^ 1) * STAGE + kdst) = kreg; *(ALAS u32x4*)(lds + (cur ^ 1) * STAGE + vdst) = vreg; }
        { bool done;
          if (MODE == 0) done = __all(carry < EXIT_T);
          else {
              const float ub = more ? qn * cum2[4096 + j - 1] + (cq - m) + cum2[64 * j - 1] : 0.f; done = started && __all(ub < EXIT_T - 2.f); }
          if (lane == 0) flags[cur * 8 + wid] = done ? 1u : 0u; }
        __syncthreads();
        { unsigned a = 1u;
#pragma unroll
            for (int w = 0; w < 8; ++w) a &= flags[cur * 8 + w];
            if (a) break; }
        cur ^= 1;
    }
    float inv = 1.f;
    if (MODE == 1) { l += __shfl_xor(l, 32); inv = 1.0f / l; }
    bf16* orow = O + (rowbase + qrow) * DM;
#pragma unroll
    for (int dh = 0; dh < 2; ++dh)
#pragma unroll
        for (int g = 0; g < 4; ++g) { u32x2 w; w.x = pk2(o[dh][4 * g] * inv, o[dh][4 * g + 1] * inv); w.y = pk2(o[dh][4 * g + 2] * inv, o[dh][4 * g + 3] * inv);
            *(u32x2*)(orow + 32 * dh + 8 * g + 4 * hi) = w; }
    __syncthreads();
}
__device__ __forceinline__ void fox_tables(ALAS float* cum2, const float* lf, const bf16* K, int pitch) {
    const int tid = threadIdx.x, lane = tid & 63, wid = tid >> 6;
    ALAS float* pm = cum2 + 4096; ALAS float* wtot = cum2 + 4096 + 64; ALAS float* kt = cum2 + 4096 + 128;
    const f32x4 a = *(const f32x4*)(lf + tid * 8), b = *(const f32x4*)(lf + tid * 8 + 4);
    float v[8] = {a[0], a[1], a[2], a[3], b[0], b[1], b[2], b[3]};
#pragma unroll
    for (int i = 1; i < 8; ++i) v[i] += v[i - 1];
    float inc = v[7];
#pragma unroll
    for (int o = 1; o < 64; o <<= 1) { const float n = __shfl_up(inc, o); if (lane >= o) inc += n; }
    if (lane == 63) wtot[wid] = inc;
    for (int it = 0; it < 64; ++it) { const int key = it * 64 + wid * 8 + (lane >> 3);
        const u32x4 kk = *(const u32x4*)(K + (size_t)key * pitch + (lane & 7) * 8);
        float s = 0.f;
#pragma unroll
        for (int q = 0; q < 4; ++q) { const float x0 = bf2f(kk[q] & 0xffff), x1 = bf2f(kk[q] >> 16); s += x0 * x0 + x1 * x1; }
        s += __shfl_xor(s, 1); s += __shfl_xor(s, 2); s += __shfl_xor(s, 4);
        s = fmaxf(s, __shfl_xor(s, 8)); s = fmaxf(s, __shfl_xor(s, 16)); s = fmaxf(s, __shfl_xor(s, 32));
        if (lane == 0) kt[it * 8 + wid] = s; }
    __syncthreads();
    float base = inc - v[7];
    for (int w = 0; w < wid; ++w) base += wtot[w];
#pragma unroll
    for (int i = 0; i < 8; ++i) cum2[tid * 8 + i] = -(v[i] + base) * LOG2E;
    if (wid == 0) { float t = 0.f;
#pragma unroll
        for (int w = 0; w < 8; ++w) t = fmaxf(t, kt[lane * 8 + w]);
#pragma unroll
        for (int o = 1; o < 64; o <<= 1) { const float n = __shfl_up(t, o); if (lane >= o) t = fmaxf(t, n); }
        pm[lane] = sqrtf(t) * 1.002f; }
    __syncthreads();
}

constexpr int RSTR = 192;
__device__ __forceinline__ void ret_pass_a(ALAS unsigned char* lds, const bf16* P  , float* loc, float* grp, int bh, int g) {
    const int tid = threadIdx.x, lane = tid & 63, r32 = lane & 31, hi = lane >> 5, wid = __builtin_amdgcn_readfirstlane(tid >> 6);
    const int b = bh >> 3, h = bh & 7; const size_t rowbase = (size_t)b * SEQ;
    const float lg2 = log2f(1.0f - exp2f(-5.0f - (float)h)); const float cd = exp2f(128.f * lg2);
    ALAS unsigned char* kt = lds; ALAS unsigned char* vt = lds + 128 * RSTR;
    const int eh = wid >> 1, dh = wid & 1;
    const int tl = (4 * hi + ((lane & 15) >> 2)) * RSTR + (16 * ((lane >> 4) & 1) + 4 * (lane & 3)) * 2;
    f32x16 R;
#pragma unroll
    for (int r = 0; r < 16; ++r) R[r] = 0.f;
    for (int j = 0; j < 4; ++j) { const int n = 4 * g + j; const size_t tok0 = rowbase + (size_t)n * 128;
#pragma unroll
        for (int i = 0; i < 2; ++i) { const int idx = tid + 512 * i, row = idx >> 3, ch = idx & 7;
            const u32x4 kk = *(const u32x4*)(P + (tok0 + row) * EW + 512 + h * 64 + ch * 8), vv = *(const u32x4*)(P + (tok0 + row) * EW + 1024 + h * 64 + ch * 8);
            const float dk = exp2f((float)(127 - row) * lg2); u32x4 kd;
            kd.x = pk2(bf2f(kk.x & 0xffff) * dk, bf2f(kk.x >> 16) * dk); kd.y = pk2(bf2f(kk.y & 0xffff) * dk, bf2f(kk.y >> 16) * dk);
            kd.z = pk2(bf2f(kk.z & 0xffff) * dk, bf2f(kk.z >> 16) * dk); kd.w = pk2(bf2f(kk.w & 0xffff) * dk, bf2f(kk.w >> 16) * dk);
            *(ALAS u32x4*)(kt + row * RSTR + ch * 16) = kd; *(ALAS u32x4*)(vt + row * RSTR + ch * 16) = vv; }
        __syncthreads();
        if (wid < 4) {
            float* lo = loc + ((size_t)bh * 32 + n) * 4096;
#pragma unroll
            for (int r = 0; r < 16; ++r) lo[(32 * eh + crow(r, hi)) * 64 + 32 * dh + r32] = R[r];
            R = R * cd;
#pragma unroll
            for (int s = 0; s < 8; ++s) { const ALAS unsigned char* va = vt + tl + (16 * s) * RSTR + eh * 64; const ALAS unsigned char* ka = kt + tl + (16 * s) * RSTR + dh * 64;
                R = __builtin_amdgcn_mfma_f32_32x32x16_bf16(vtr2(va, va + 8 * RSTR), vtr2(ka, ka + 8 * RSTR), R, 0, 0, 0); }
        }
        __syncthreads();
    }
    if (wid < 4) { float* go = grp + ((size_t)bh * 8 + g) * 4096;
#pragma unroll
        for (int r = 0; r < 16; ++r) go[(32 * eh + crow(r, hi)) * 64 + 32 * dh + r32] = R[r]; }
}
constexpr int RB_Q = 0, RB_K = 128 * KSTR, RB_G = 2 * 128 * KSTR, RB_V = 3 * 128 * KSTR, RB_S = RB_V + 128 * RSTR, RB_RED = RB_S + 64 * KSTR;
__device__ __forceinline__ void ret_pass_b(ALAS unsigned char* lds, const bf16* P, const float* loc, const float* grp, const float* retnorm, bf16* Y, int bh, int n) {
    const int tid = threadIdx.x, lane = tid & 63, r32 = lane & 31, hi = lane >> 5, wid = __builtin_amdgcn_readfirstlane(tid >> 6);
    const int b = bh >> 3, h = bh & 7; const size_t tok0 = (size_t)b * SEQ + (size_t)n * 128;
    const float lg2 = log2f(1.0f - exp2f(-5.0f - (float)h)); const float cd = exp2f(128.f * lg2), cd4 = exp2f(512.f * lg2);
    const int g = n >> 2, j = n & 3;
    { const int e = tid >> 3, d0 = (tid & 7) * 8; const size_t off = (size_t)e * 64 + d0;
      f32x4 s0 = {0.f, 0.f, 0.f, 0.f}, s1 = {0.f, 0.f, 0.f, 0.f};
      for (int gp = 0; gp < g; ++gp) { const float* gs = grp + ((size_t)bh * 8 + gp) * 4096 + off; s0 = s0 * cd4 + *(const f32x4*)gs; s1 = s1 * cd4 + *(const f32x4*)(gs + 4); }
      const float cj = exp2f(128.f * (float)j * lg2); const float* lo = loc + ((size_t)bh * 32 + n) * 4096 + off;
      s0 = s0 * cj + *(const f32x4*)lo; s1 = s1 * cj + *(const f32x4*)(lo + 4);
      u32x4 w; w.x = pk2(s0[0], s0[1]); w.y = pk2(s0[2], s0[3]); w.z = pk2(s1[0], s1[1]); w.w = pk2(s1[2], s1[3]);
      *(ALAS u32x4*)(lds + RB_S + e * KSTR + d0 * 2) = w; }
#pragma unroll
    for (int i = 0; i < 2; ++i) { const int idx = tid + 512 * i, row = idx >> 3, ch = idx & 7; const bf16* src = P + (tok0 + row) * EW + h * 64 + ch * 8;
        *(ALAS u32x4*)(lds + RB_Q + row * KSTR + ch * 16) = *(const u32x4*)src; *(ALAS u32x4*)(lds + RB_K + row * KSTR + ch * 16) = *(const u32x4*)(src + 512);
        *(ALAS u32x4*)(lds + RB_V + row * RSTR + ch * 16) = *(const u32x4*)(src + 1024); *(ALAS u32x4*)(lds + RB_G + row * KSTR + ch * 16) = *(const u32x4*)(src + 1536); }
    __syncthreads();
    const int qb = wid & 3, eh = wid >> 2, qloc = 32 * qb + r32;
    const int tl = (4 * hi + ((lane & 15) >> 2)) * RSTR + (16 * ((lane >> 4) & 1) + 4 * (lane & 3)) * 2;
    bf16x8 qf[4];
#pragma unroll
    for (int d0 = 0; d0 < 4; ++d0) qf[d0] = *(const ALAS bf16x8*)(lds + RB_Q + qloc * KSTR + 32 * d0 + 16 * hi);
    float dloc[16];
#pragma unroll
    for (int r = 0; r < 16; ++r) dloc[r] = exp2f((float)(r32 - crow(r, hi)) * lg2);
    f32x16 ain, acr;
#pragma unroll
    for (int r = 0; r < 16; ++r) { ain[r] = 0.f; acr[r] = 0.f; }
    for (int kt = 0; kt <= qb; ++kt) {
        f32x16 s;
#pragma unroll
        for (int r = 0; r < 16; ++r) s[r] = 0.f;
#pragma unroll
        for (int d0 = 0; d0 < 4; ++d0) s = __builtin_amdgcn_mfma_f32_32x32x16_bf16(*(const ALAS bf16x8*)(lds + RB_K + (32 * kt + r32) * KSTR + 32 * d0 + 16 * hi), qf[d0], s, 0, 0, 0);
        const float fac = exp2f(32.f * (float)(qb - kt) * lg2);
#pragma unroll
        for (int r = 0; r < 16; ++r) { float v = s[r] * (dloc[r] * fac); if (kt == qb && crow(r, hi) > r32) v = 0.f; s[r] = v; }
        const bf16x8 pb0 = packbf8(s, 0), pb1 = packbf8(s, 8);
        const ALAS unsigned char* va = lds + RB_V + tl + (32 * kt) * RSTR + eh * 64;
        ain = __builtin_amdgcn_mfma_f32_32x32x16_bf16(vtr2(va, va + 8 * RSTR), pb0, ain, 0, 0, 0);
        ain = __builtin_amdgcn_mfma_f32_32x32x16_bf16(vtr2(va + 16 * RSTR, va + 24 * RSTR), pb1, ain, 0, 0, 0);
    }
#pragma unroll
    for (int d0 = 0; d0 < 4; ++d0) acr = __builtin_amdgcn_mfma_f32_32x32x16_bf16(*(const ALAS bf16x8*)(lds + RB_S + (32 * eh + r32) * KSTR + 32 * d0 + 16 * hi), qf[d0], acr, 0, 0, 0);
    const float qd = exp2f((float)(qloc + 1) * lg2);
    float s1 = 0.f, s2 = 0.f;
#pragma unroll
    for (int r = 0; r < 16; ++r) { const float v = ain[r] + qd * acr[r]; ain[r] = v; s1 += v; s2 += v * v; }
    s1 += __shfl_xor(s1, 32); s2 += __shfl_xor(s2, 32);
    ALAS float* red = (ALAS float*)(lds + RB_RED);
    if (hi == 0) { red[(wid * 32 + r32) * 2] = s1; red[(wid * 32 + r32) * 2 + 1] = s2; }
    __syncthreads();
    { const int pw = wid ^ 4; s1 += red[(pw * 32 + r32) * 2]; s2 += red[(pw * 32 + r32) * 2 + 1]; }
    const float mu = s1 * (1.f / 64.f); const float var = fmaxf(s2 * (1.f / 64.f) - mu * mu, 0.f); const float rstd = 1.0f / sqrtf(var + GN_EPS);
    bf16* yrow = Y + (tok0 + qloc) * DM + h * 64 + 32 * eh;
#pragma unroll
    for (int gq = 0; gq < 4; ++gq) { const int e0 = 8 * gq + 4 * hi;
        const u32x2 gv = *(const ALAS u32x2*)(lds + RB_G + qloc * KSTR + (32 * eh + e0) * 2); const f32x4 rn = *(const f32x4*)(retnorm + h * 64 + 32 * eh + e0);
        const float g0 = bf2f(gv.x & 0xffff), g1 = bf2f(gv.x >> 16), g2 = bf2f(gv.y & 0xffff), g3 = bf2f(gv.y >> 16);
        u32x2 w; w.x = pk2((ain[4 * gq] - mu) * rstd * rn[0] * silu_f(g0), (ain[4 * gq + 1] - mu) * rstd * rn[1] * silu_f(g1));
        w.y = pk2((ain[4 * gq + 2] - mu) * rstd * rn[2] * silu_f(g2), (ain[4 * gq + 3] - mu) * rstd * rn[3] * silu_f(g3));
        *(u32x2*)(yrow + e0) = w; }
    __syncthreads();
}
#undef ALAS
}
#define LAS __attribute__((address_space(3)))
#define XB_TMO      128
#define XB_XCNT(j)  (256  + 64 * (j))
#define XB_XSUB(j)  (1280 + 64 * (j))
#define XB_XGEN(j)  (2304 + 64 * (j))
#define XB_TOP      3328
#define XB_TOPGEN   3392
#define XCD_BAR_WORDS 3456
#define XB_SPIN_CAP (1u << 23)
__device__ __forceinline__ unsigned xb_ld(unsigned* p)              { return __hip_atomic_load(p, __ATOMIC_RELAXED, __HIP_MEMORY_SCOPE_AGENT); }
__device__ __forceinline__ unsigned xb_add(unsigned* p, unsigned v) { return __hip_atomic_fetch_add(p, v, __ATOMIC_RELAXED, __HIP_MEMORY_SCOPE_AGENT); }
__device__ __forceinline__ unsigned xb_xcc_id() { return (unsigned)__builtin_amdgcn_s_getreg((3 << 11) | 20) & 0xFu; }
#define XB_SPIN(cond, bar) do { unsigned _sp = 0; while (cond) { __builtin_amdgcn_s_sleep(1); \
    if ((++_sp & 255u) == 0u) { if (xb_ld(&(bar)[XB_TMO])) break; if (_sp > XB_SPIN_CAP) { atomicAdd(&(bar)[XB_TMO], 1u); break; } } } } while (0)
struct XcdBarrier { unsigned* bar; unsigned x; volatile LAS unsigned* st; };
__device__ __forceinline__ XcdBarrier xcd_barrier_post(unsigned* bar, volatile LAS unsigned* st) {
    XcdBarrier b; b.bar = bar; b.x = xb_xcc_id(); b.st = st;
    if (threadIdx.x == 0) (void)xb_add(&bar[XB_XCNT(b.x)], 1u);
    return b;
}
__device__ __forceinline__ void xcd_barrier_complete(unsigned* bar, unsigned x, unsigned& nloc, unsigned& nx) {
    const unsigned G = gridDim.x * gridDim.y * gridDim.z;
    unsigned sum, cnt, mine, sp = 0u;
    for (;;) {
        sum = 0u; cnt = 0u; mine = 0u;
#pragma unroll
        for (unsigned j = 0; j < 16; ++j) { const unsigned c = xb_ld(&bar[XB_XCNT(j)]); sum += c; cnt += (c > 0u) ? 1u : 0u; mine = (j == x) ? c : mine; }
        if (sum == G) break;
        __builtin_amdgcn_s_sleep(1);
        if ((++sp & 255u) == 0u) { if (xb_ld(&bar[XB_TMO])) break; if (sp > XB_SPIN_CAP) { atomicAdd(&bar[XB_TMO], 1u); break; } }
    }
    nloc = mine > 0u ? mine : 1u; nx = cnt > 0u ? cnt : 1u;
}
__device__ __forceinline__ void xcd_barrier(const XcdBarrier& b) {
    asm volatile("s_waitcnt vmcnt(0)" ::: "memory");
    __syncthreads();
    if (threadIdx.x == 0) {
        unsigned* bar = b.bar;
        __builtin_amdgcn_s_waitcnt(0);
        unsigned nloc = b.st[0], nx = b.st[1];
        if (nloc == 0u) { xcd_barrier_complete(bar, b.x, nloc, nx); b.st[0] = nloc; b.st[1] = nx; }
        const unsigned old = xb_add(&bar[XB_XSUB(b.x)], 1u);
        const unsigned gen = old / nloc;
        if (old + 1u == (gen + 1u) * nloc) {
            __builtin_amdgcn_fence(__ATOMIC_RELEASE, "agent");
            asm volatile("s_waitcnt vmcnt(0)" ::: "memory");
            const unsigned og = xb_add(&bar[XB_TOP], 1u);
            const unsigned tg = og / nx;
            if (og + 1u == (tg + 1u) * nx) xb_add(&bar[XB_TOPGEN], 1u);
            else XB_SPIN(xb_ld(&bar[XB_TOPGEN]) == tg, bar);
            __builtin_amdgcn_fence(__ATOMIC_ACQUIRE, "agent");
            xb_add(&bar[XB_XGEN(b.x)], 1u);
            asm volatile("s_waitcnt vmcnt(0)" ::: "memory");
        } else {
            XB_SPIN(xb_ld(&bar[XB_XGEN(b.x)]) == gen, bar);
            __builtin_amdgcn_fence(__ATOMIC_ACQUIRE, "agent");
            asm volatile("s_waitcnt vmcnt(0)" ::: "memory");
        }
    }
    __syncthreads();
}

constexpr int NWAVES = 8, NTHR = NWAVES * 64;
constexpr int RING_BYTES = 131072, LDS_BYTES = 147456, MISC_OFF = LDS_BYTES - 256;
constexpr int NPHASE = 16;

__device__ __forceinline__ void mixer_even_simple(unsigned char* ws, const float* retnorm, int gw, int ngw, int lane) {
    const bf16* P = (const bf16*)(ws + WS_BIG); bf16* Y = (bf16*)(ws + WS_X0);
    for (int idx = gw; idx < BATCH * 8 * SEQ; idx += ngw) {
        const int t = idx & (SEQ - 1), h = (idx >> 12) & 7, b = idx >> 15; const size_t rb = (size_t)b * SEQ;
        { const float lg2 = log2f(1.0f - exp2f(-5.0f - (float)h));
          const float q = bf2f(P[(rb + t) * EW + h * 64 + lane]); float o = 0.f;
          for (int s = 0; s <= t; ++s) { const float k = bf2f(P[(rb + s) * EW + 512 + h * 64 + lane]), v = bf2f(P[(rb + s) * EW + 1024 + h * 64 + lane]);
              o += exp2f(lg2 * (float)(t - s)) * wave_sum(q * k) * v; }
          const float mu = wave_sum(o) * (1.f / 64.f); const float dv = o - mu; const float var = wave_sum(dv * dv) * (1.f / 64.f);
          const float g = bf2f(P[(rb + t) * EW + 1536 + h * 64 + lane]);
          Y[(rb + t) * DM + h * 64 + lane] = (bf16)f2bf(dv * (1.0f / sqrtf(var + GN_EPS)) * retnorm[h * 64 + lane] * silu_f(g)); }
        { const float q = bf2f(P[(rb + t) * EW + 2048 + h * 64 + lane]); float o = 0.f, carry = 0.f;
          for (int s = t - 1; s >= 0; --s) { const float k = bf2f(P[(rb + s) * EW + 2560 + h * 64 + lane]), v = bf2f(P[(rb + s) * EW + 3072 + h * 64 + lane]);
              const float y = wave_sum(q * k); const float lf2 = -softplus2(y); o += __builtin_amdgcn_exp2f(y + lf2 + carry) * v; carry += lf2; }
          Y[(rb + t) * DM + 512 + h * 64 + lane] = (bf16)f2bf(o); }
    }
}
__device__ __forceinline__ void fox_simple(unsigned char* ws, LAS float* cum, int vcu, int wave, int lane) {
    const bf16* P = (const bf16*)(ws + WS_BIG); bf16* Y = (bf16*)(ws + WS_X0);
    const int bh = vcu >> 1, b = bh >> 4, h = bh & 15; const size_t rb = (size_t)b * SEQ;
    const float* lf = (const float*)(ws + WS_LOGF) + (size_t)bh * SEQ;
    if (wave == 0) { float run = 0.f;
        for (int j = 0; j < 64; ++j) run += lf[lane * 64 + j];
        float inc = run;
#pragma unroll
        for (int o = 1; o < 64; o <<= 1) { const float n = __shfl_up(inc, o); if (lane >= o) inc += n; }
        float acc = inc - run;
        for (int j = 0; j < 64; ++j) { acc += lf[lane * 64 + j]; cum[lane * 64 + j] = acc; } }
    __syncthreads();
    for (int t = (vcu & 1) + 2 * wave; t < SEQ; t += 16) {
        const float q = bf2f(P[(rb + t) * QKVW + h * 64 + lane]); const float ct = cum[t]; float m = -INFINITY, l = 0.f, o = 0.f;
        for (int s = 0; s <= t; ++s) { const float k = bf2f(P[(rb + s) * QKVW + 1024 + h * 64 + lane]), v = bf2f(P[(rb + s) * QKVW + 2048 + h * 64 + lane]);
            const float x = wave_sum(q * k) + (ct - cum[s]) * LOG2E;
            if (x > m) { const float f = __builtin_amdgcn_exp2f(m - x); l *= f; o *= f; m = x; }
            const float pr = __builtin_amdgcn_exp2f(x - m); l += pr; o += pr * v; }
        Y[(rb + t) * DM + h * 64 + lane] = (bf16)f2bf(o / l); }
    __syncthreads();
}
__device__ __forceinline__ void router_phase(unsigned char* ws, const float* hres, LAS unsigned* rl, int vcu, int wave, int lane) {
    unsigned* ctl = (unsigned*)(ws + WS_CTL); const int tid = threadIdx.x;
    LAS unsigned* lcnt = rl; LAS unsigned* lbase = rl + 16; LAS int* tinfo = (LAS int*)(rl + 32); LAS float* tg = (LAS float*)(rl + 32 + 256); LAS unsigned* tpos = rl + 32 + 512;
    if (tid < 16) lcnt[tid] = 0u;
    __syncthreads();
    const float* part4 = (const float*)(ws + WS_PART) + (size_t)2 * T * 16;
    for (int i = 0; i < 16; ++i) { const int lt = wave * 16 + i, row = vcu * 128 + lt; int e1, e2; float g1, g2;
        router_row(hres + (size_t)row * DM, (const float*)(ws + WS_ROUTW), part4, row, (float*)(ws + WS_RSTD4), lane, e1, e2, g1, g2);
        if (lane == 0) { tinfo[lt * 2] = e1; tinfo[lt * 2 + 1] = e2; tg[lt * 2] = g1; tg[lt * 2 + 1] = g2;
            tpos[lt * 2] = __hip_atomic_fetch_add(&lcnt[e1], 1u, __ATOMIC_RELAXED, __HIP_MEMORY_SCOPE_WORKGROUP); tpos[lt * 2 + 1] = __hip_atomic_fetch_add(&lcnt[8 + e2], 1u, __ATOMIC_RELAXED, __HIP_MEMORY_SCOPE_WORKGROUP); } }
    __syncthreads();
    if (tid < 16) lbase[tid] = __hip_atomic_fetch_add(&ctl[CW_CNT + 64 * tid], lcnt[tid], __ATOMIC_RELAXED, __HIP_MEMORY_SCOPE_AGENT);
    __syncthreads();
    if (tid < 256) { const int lt = tid >> 1, c = tid & 1, e = tinfo[tid]; const unsigned pos = lbase[c * 8 + e] + tpos[tid];
        ((int*)(ws + WS_LIST))[(size_t)(c * 8 + e) * T + pos] = vcu * 128 + lt; ((float*)(ws + WS_GATE))[(size_t)(c * 8 + e) * T + pos] = tg[tid]; }
    __syncthreads();
}

typedef const __attribute__((address_space(4))) Params* KParams;
__device__ __forceinline__ KParams kargs() { unsigned long long v = (unsigned long long)__builtin_amdgcn_kernarg_segment_ptr(); asm volatile("" : "+s"(v)); return (KParams)v; }
__global__ void __launch_bounds__(NTHR, 2) mega_fwd(Params p_unused) {
    extern __shared__ __attribute__((aligned(16))) unsigned char lds_raw[];
    LAS unsigned char* lds = (LAS unsigned char*)lds_raw;
    const int tid = threadIdx.x, lane = tid & 63, wave = __builtin_amdgcn_readfirstlane(tid >> 6);
    if (tid < 64) ((LAS unsigned*)(lds + MISC_OFF))[tid] = 0u;
    __syncthreads();
    XcdBarrier bar = xcd_barrier_post((unsigned*)(kargs()->ws + WS_CTL) + CW_BAR + kargs()->li * XCD_BAR_WORDS, (volatile LAS unsigned*)(lds + MISC_OFF) + 8);
#ifndef PH_MASK
#define PH_MASK 0xffff
#endif
#define IN(k) (((PH_MASK >> (k)) & 1) && kargs()->ph_lo <= (k) && (k) < kargs()->ph_hi)
#define SEAM(k) do { if (IN(k) && IN((k) + 1)) xcd_barrier(bar); } while (0)
#define GRID_VARS const int G = gridDim.x, bx = blockIdx.x; const int vcu = (G % 8 == 0) ? (bx % 8) * (G / 8) + bx / 8 : bx; const int gw = vcu * NWAVES + wave, ngw = G * NWAVES; (void)gw; (void)ngw; (void)vcu; \
    KParams kp = kargs(); unsigned char* ws = kp->ws; (void)ws

    if (IN(0)) { GRID_VARS; Params p; for (int i = 0; i < 19; ++i) p.in[i] = kp->in[i]; p.out = kp->out; p.ws = ws; p.ph_lo = 0; p.ph_hi = 0; p.li = 0; p.pad = 0;
        prologue_weights(p, (LAS float*)(lds + wave * TR_SCR_BYTES), gw, ngw, lane);
        prologue_small(p, bx * NTHR + tid, G * NTHR);
        const float* x = kp->in[0]; bf16* X0 = (bf16*)(ws + WS_X0);
        for (int m = gw; m < T; m += ngw) rms_row_to_bf16(x + (size_t)m * DM, X0 + (size_t)m * DM, lane);
    }
    SEAM(0);
    if (IN(1)) { GRID_VARS; pg8::ProbDense P{(const bf16*)(ws + WS_X0), (const bf16*)(ws + WS_W_IN_E), DM}; pg8::StaticOrder S; S.init(T / 256, EW / 256, G, bx);
        pg8::EpiInEven E{(bf16*)(ws + WS_BIG), (const float2*)(ws + WS_ROPE)}; pg8::gemm_phase(lds, P, S, E); }
    SEAM(1);
#ifdef MIX_SIMPLE
    if (IN(2)) { GRID_VARS; mixer_even_simple(ws, kp->in[3], gw, ngw, lane); }
    SEAM(2);
    SEAM(3);
#else
    if (IN(2)) { GRID_VARS; const bf16* Pj = (const bf16*)(ws + WS_BIG); float* loc = kp->out; float* grp = kp->out + (size_t)8 * 1024 * 1024;
        for (int k = 0; k < 2; ++k) { const int u = vcu + 256 * k; att::ret_pass_a(lds, Pj, loc, grp, u >> 3, u & 7); }
        for (int k = 0; k < 2; ++k) { const int u = vcu + 256 * k, bh = u >> 4, qb = u & 15, h = bh & 7;
            att::unit<0>(lds, Pj + 2048 + h * 64, Pj + 2560 + h * 64, Pj + 3072 + h * 64, EW, (bf16*)(ws + WS_X0) + 512 + h * 64, (size_t)(bh >> 3) * SEQ, qb * 256, nullptr); } }
    SEAM(2);
    if (IN(3)) { GRID_VARS; const bf16* Pj = (const bf16*)(ws + WS_BIG); const float* loc = kp->out; const float* grp = kp->out + (size_t)8 * 1024 * 1024; const float* rn = kp->in[3];
        for (int k = 0; k < 8; ++k) { const int u = vcu + 256 * k; att::ret_pass_b(lds, Pj, loc, grp, rn, (bf16*)(ws + WS_X0), u >> 5, u & 31); }
        for (int k = 2; k < 4; ++k) { const int u = vcu + 256 * k, bh = u >> 4, qb = u & 15, h = bh & 7;
            att::unit<0>(lds, Pj + 2048 + h * 64, Pj + 2560 + h * 64, Pj + 3072 + h * 64, EW, (bf16*)(ws + WS_X0) + 512 + h * 64, (size_t)(bh >> 3) * SEQ, qb * 256, nullptr); } }
    SEAM(3);
#endif
    if (IN(4)) { GRID_VARS; pg8::ProbDense P{(const bf16*)(ws + WS_X0), (const bf16*)(ws + WS_W_OUT_E), DM}; pg8::StaticOrder S; S.init(T / 256, DM / 256, G, bx);
        pg8::EpiResid E{kp->in[0], kp->out, (bf16*)(ws + WS_BIG), (float*)(ws + WS_PART)}; pg8::gemm_phase(lds, P, S, E); }
    SEAM(4);
    if (IN(5)) { GRID_VARS; pg8::ProbDense P{(const bf16*)(ws + WS_BIG), (const bf16*)(ws + WS_W_GU_E), DM}; pg8::StaticOrder S; S.init(T / 256, GU / 256, G, bx);
        pg8::EpiGU E{(bf16*)(ws + WS_HID), (const float*)(ws + WS_PART)}; pg8::gemm_phase(lds, P, S, E); }
    SEAM(5);
    if (IN(6)) { GRID_VARS; pg8::ProbDense P{(const bf16*)(ws + WS_HID), (const bf16*)(ws + WS_W_DN_E), DFF}; pg8::StaticOrder S; S.init(T / 256, DM / 256, G, bx);
        pg8::EpiResid E{kp->out, kp->out, (bf16*)(ws + WS_X0), (float*)(ws + WS_PART) + (size_t)T * 16}; pg8::gemm_phase(lds, P, S, E); }
    SEAM(6);
    if (IN(7)) { GRID_VARS; pg8::ProbDense P{(const bf16*)(ws + WS_X0), (const bf16*)(ws + WS_W_IN_O), DM}; pg8::StaticOrder S; S.init(T / 256, OWP / 256, G, bx);
        pg8::EpiInOdd E{(bf16*)(ws + WS_BIG), (const float*)(ws + WS_PART) + (size_t)T * 16, kp->in[11], (float*)(ws + WS_LOGF)}; pg8::gemm_phase(lds, P, S, E); }
    SEAM(7);
#ifdef FOX_SIMPLE
    if (IN(8)) { GRID_VARS; fox_simple(ws, (LAS float*)lds, vcu, wave, lane); }
#else
    if (IN(8)) { GRID_VARS; const bf16* Pj = (const bf16*)(ws + WS_BIG); const int bh = vcu >> 1, h = bh & 15;
        LAS float* cum2 = (LAS float*)(lds + att::CUM_OFF);
        att::fox_tables(cum2, (const float*)(ws + WS_LOGF) + (size_t)bh * SEQ, Pj + (size_t)(bh >> 4) * SEQ * QKVW + 1024 + h * 64, QKVW);
        for (int k = 0; k < 8; ++k) { const int s = 4 * (vcu & 1) + (k >> 1), qb = (k & 1) ? 15 - s : s;
            att::unit<1>(lds, Pj + h * 64, Pj + 1024 + h * 64, Pj + 2048 + h * 64, QKVW, (bf16*)(ws + WS_X0) + h * 64, (size_t)(bh >> 4) * SEQ, qb * 256, cum2); } }
#endif
    SEAM(8);
    if (IN(9)) { GRID_VARS; pg8::ProbDense P{(const bf16*)(ws + WS_X0), (const bf16*)(ws + WS_W_OUT_O), DM}; pg8::StaticOrder S; S.init(T / 256, DM / 256, G, bx);
        pg8::EpiResid E{kp->out, kp->out, (bf16*)(ws + WS_BIG), (float*)(ws + WS_PART) + (size_t)2 * T * 16}; pg8::gemm_phase(lds, P, S, E); }
    SEAM(9);
    if (IN(10)) { GRID_VARS; if (G == 256) router_phase(ws, kp->out, (LAS unsigned*)lds, vcu, wave, lane); }
    SEAM(10);
#define MOE_PASS(c) do { \
        if (IN(11 + 2 * c)) { GRID_VARS; const unsigned* ctl = (const unsigned*)(ws + WS_CTL); int ntile = 0; \
        _Pragma("unroll") \
            for (int e = 0; e < 8; ++e) ntile += ((int)ctl[CW_CNT + 64 * (c * 8 + e)] + 255) >> 8; \
            pg8::ProbMoeGU P{(const bf16*)(ws + WS_BIG), (const bf16*)(ws + WS_W_GU_M), DM, (size_t)GU * DM * 2, ctl, c, (const int*)(ws + WS_LIST)}; pg8::StaticOrder S; S.init(ntile, GU / 256, G, bx); \
            pg8::EpiMoeGU E{(bf16*)(ws + WS_HID), (const float*)(ws + WS_RSTD4), ctl, c, (const int*)(ws + WS_LIST)}; pg8::gemm_phase(lds, P, S, E); } \
        SEAM(11 + 2 * c); \
        if (IN(12 + 2 * c)) { GRID_VARS; const unsigned* ctl = (const unsigned*)(ws + WS_CTL); int ntile = 0; \
        _Pragma("unroll") \
            for (int e = 0; e < 8; ++e) ntile += ((int)ctl[CW_CNT + 64 * (c * 8 + e)] + 255) >> 8; \
            pg8::ProbMoeDown P{(const bf16*)(ws + WS_HID), (const bf16*)(ws + WS_W_DN_M), DFF, (size_t)DM * DFF * 2, ctl, c}; pg8::StaticOrder S; S.init(ntile, DM / 256, G, bx); \
            pg8::EpiMoeDown E{kp->out, ctl, c, (const int*)(ws + WS_LIST), (const float*)(ws + WS_GATE)}; pg8::gemm_phase(lds, P, S, E); } \
        SEAM(12 + 2 * c); \
    } while (0)
    MOE_PASS(0);
    MOE_PASS(1);
#undef MOE_PASS
    if (IN(15)) { GRID_VARS; float* out = kp->out; const float* fg = kp->in[18]; for (int m = gw; m < T; m += ngw) final_norm_row(out + (size_t)m * DM, fg, lane); }
#undef IN
#undef SEAM
#undef GRID_VARS
}

#ifndef MK_N_LAUNCHES
#define MK_N_LAUNCHES 1
#endif
extern "C" void kernel_launch(void* const* d_in, const int* in_sizes, int n_in, void* d_out, int out_size, void* d_ws, size_t ws_size, hipStream_t stream) {
    static int grid = 0;
    if (grid == 0) {
        if (n_in != 19 || out_size != T * DM || ws_size < WS_END) { fprintf(stderr, "kernel_launch: unexpected shapes (n_in %d out %d ws %zu)\n", n_in, out_size, ws_size); grid = -1; return; }
        int dev = 0, cus = 0, per_cu = 0;
        if (hipGetDevice(&dev) != hipSuccess || hipDeviceGetAttribute(&cus, hipDeviceAttributeMultiprocessorCount, dev) != hipSuccess) { grid = -1; return; }
        if (hipFuncSetAttribute((const void*)mega_fwd, hipFuncAttributeMaxDynamicSharedMemorySize, LDS_BYTES) != hipSuccess) { fprintf(stderr, "kernel_launch: hipFuncSetAttribute failed\n"); grid = -1; return; }
        if (hipOccupancyMaxActiveBlocksPerMultiprocessor(&per_cu, (const void*)mega_fwd, NTHR, LDS_BYTES) != hipSuccess || per_cu < 1) { fprintf(stderr, "kernel_launch: occupancy query says %d\n", per_cu); }
        (void)hipGetLastError();
        grid = cus;
        if (grid != 256) fprintf(stderr, "kernel_launch: %d CUs; the router phase assumes 256\n", grid);
    }
    if (grid < 0) return;
    (void)in_sizes;
    if (hipMemsetAsync((char*)d_ws + WS_CTL, 0, CTL_BYTES, stream) != hipSuccess) return;
    Params p{};
    for (int i = 0; i < 19; ++i) p.in[i] = (const float*)d_in[i];
    p.out = (float*)d_out; p.ws = (unsigned char*)d_ws;
#if defined(EXP_PHASE)
    p.ph_lo = 0; p.ph_hi = EXP_PHASE + 1; p.li = 0; hipLaunchKernelGGL(mega_fwd, dim3(grid), dim3(NTHR), LDS_BYTES, stream, p);
    p.ph_lo = EXP_PHASE; p.ph_hi = EXP_PHASE + 1; p.li = 1; hipLaunchKernelGGL(mega_fwd, dim3(grid), dim3(NTHR), LDS_BYTES, stream, p);
    p.ph_lo = EXP_PHASE + 1; p.ph_hi = NPHASE; p.li = 2; hipLaunchKernelGGL(mega_fwd, dim3(grid), dim3(NTHR), LDS_BYTES, stream, p);
#elif MK_N_LAUNCHES == 1
    p.ph_lo = 0; p.ph_hi = NPHASE; p.li = 0;
    hipLaunchKernelGGL(mega_fwd, dim3(grid), dim3(NTHR), LDS_BYTES, stream, p);
#else
    for (int k = 0; k < NPHASE; ++k) { p.ph_lo = k; p.ph_hi = k + 1; p.li = 0; hipLaunchKernelGGL(mega_fwd, dim3(grid), dim3(NTHR), LDS_BYTES, stream, p); }
#endif
}
```

```cpp
#include <hip/hip_runtime.h>
#include <cstdio>
#include <cstdint>

constexpr int DM = 1024, BATCH = 8, SEQ = 4096, T = BATCH * SEQ;
constexpr int HD = 64;
constexpr int EW = 3584;
constexpr int OW = 3088, OWP = 3328;
constexpr int QKVW = 3072;
constexpr int DFF = 2816, NEXP = 8, GU = 2 * DFF;
constexpr float NORM_EPS = 1e-6f, GN_EPS = 1e-5f;
constexpr float LOG2E = 1.4426950408889634f;
constexpr float C2 = 0.125f * LOG2E;
constexpr int MOE_MAXT = 136;

constexpr size_t MiB = 1u << 20;
constexpr size_t WS_CTL = 0, CTL_BYTES = 2 * MiB;
constexpr size_t WS_ROPE = 2 * MiB;
constexpr size_t WS_ROUTW = 3 * MiB;
constexpr size_t WS_RSTD4 = 3 * MiB + 65536;
constexpr size_t WS_LIST = 4 * MiB;
constexpr size_t WS_GATE = 6 * MiB;
constexpr size_t WS_PART = 8 * MiB;
constexpr size_t WS_LOGF = 14 * MiB;
constexpr size_t WS_CUM = 16 * MiB;
constexpr size_t WS_W = 18 * MiB;
constexpr size_t WS_W_IN_E = WS_W;
constexpr size_t WS_W_OUT_E = WS_W_IN_E + (size_t)EW * DM * 2;
constexpr size_t WS_W_GU_E = WS_W_OUT_E + (size_t)DM * DM * 2;
constexpr size_t WS_W_DN_E = WS_W_GU_E + (size_t)GU * DM * 2;
constexpr size_t WS_W_IN_O = WS_W_DN_E + (size_t)DM * DFF * 2;
constexpr size_t WS_W_OUT_O = WS_W_IN_O + (size_t)OWP * DM * 2;
constexpr size_t WS_W_GU_M = WS_W_OUT_O + (size_t)DM * DM * 2;
constexpr size_t WS_W_DN_M = WS_W_GU_M + (size_t)NEXP * GU * DM * 2;
constexpr size_t WS_W_END = WS_W_DN_M + (size_t)NEXP * DM * DFF * 2;
constexpr size_t WS_X0 = 184 * MiB;
constexpr size_t WS_BIG = 248 * MiB;
constexpr size_t WS_HID = WS_BIG + 64 * MiB;
constexpr size_t WS_END = WS_BIG + 251 * MiB;
static_assert(WS_W_END <= WS_X0 && WS_END <= 512 * MiB, "ws map");
static_assert(WS_HID + (size_t)MOE_MAXT * 256 * DFF * 2 <= WS_END, "hidden fits");
constexpr int CW_CNT = 64;
constexpr int CW_BAR = 4096;

typedef unsigned short bf16;
typedef short bf16x8 __attribute__((ext_vector_type(8)));
typedef float f32x4 __attribute__((ext_vector_type(4)));
typedef float f32x16 __attribute__((ext_vector_type(16)));
typedef unsigned u32x4 __attribute__((ext_vector_type(4)));
typedef unsigned u32x2 __attribute__((ext_vector_type(2)));

struct Params { const float* in[19]; float* out; unsigned char* ws; int ph_lo, ph_hi, li, pad; };

__device__ __forceinline__ unsigned f2bf(float f) { unsigned u = __builtin_bit_cast(unsigned, f); return (u + 0x7fffu + ((u >> 16) & 1u)) >> 16; }
typedef float f32x2_t __attribute__((ext_vector_type(2))); typedef __bf16 bf16x2_t __attribute__((ext_vector_type(2)));
__device__ __forceinline__ unsigned pk2(float lo, float hi) { const f32x2_t v = {lo, hi}; return __builtin_bit_cast(unsigned, __builtin_convertvector(v, bf16x2_t)); }
__device__ __forceinline__ float bf2f(unsigned short b) { return __builtin_bit_cast(float, (unsigned)b << 16); }
__device__ __forceinline__ float wave_sum(float v) {
#pragma unroll
    for (int o = 1; o < 64; o <<= 1) v += __shfl_xor(v, o);
    return v;
}
__device__ __forceinline__ float silu_f(float x) { return x / (1.f + __expf(-x)); }
__device__ __forceinline__ float softplus2(float y) { return fmaxf(y, 0.f) + __log2f(1.f + __builtin_amdgcn_exp2f(-fabsf(y))); }
__device__ __forceinline__ float rstd_from_part(const float* part, int row) {
    const f32x4* p = (const f32x4*)(part + (size_t)row * 16); float s = 0.f;
#pragma unroll
    for (int i = 0; i < 4; ++i) { const f32x4 v = p[i]; s += (v[0] + v[1]) + (v[2] + v[3]); }
    return 1.0f / sqrtf(s * (1.f / DM) + NORM_EPS);
}
__device__ __forceinline__ bool moe_tile(const unsigned* ctl, int c, int tile, int& e, int& row0, int& nrows) {
    int ts = 0;
#pragma unroll
    for (int i = 0; i < 8; ++i) { const int cn = (int)ctl[CW_CNT + 64 * (c * 8 + i)]; const int nt = (cn + 255) >> 8;
        if (tile >= ts && tile < ts + nt) { e = i; row0 = (tile - ts) * 256; nrows = cn - row0 < 256 ? cn - row0 : 256; return true; }
        ts += nt; }
    return false;
}

__constant__ double c_invfreq[32] = {1, 0.74989420933245587, 0.56234132519034907, 0.42169650342858223, 0.31622776601683794, 0.23713737056616552, 0.17782794100389229, 0.1333521432163324,
    0.10000000000000001, 0.074989420933245579, 0.056234132519034911, 0.042169650342858224, 0.031622776601683791, 0.023713737056616554, 0.017782794100389229, 0.013335214321633241,
    0.01, 0.0074989420933245579, 0.005623413251903491, 0.0042169650342858229, 0.0031622776601683794, 0.0023713737056616554, 0.0017782794100389228, 0.0013335214321633241,
    0.001, 0.00074989420933245586, 0.0005623413251903491, 0.00042169650342858224, 0.00031622776601683794, 0.00023713737056616554, 0.00017782794100389227, 0.0001333521432163324};
__device__ __forceinline__ void rope_entry(int pos, int i, float& c, float& s) {
    const double a = (double)pos * c_invfreq[i];
    const double TWO_PI = 6.283185307179586476925286766559, HALF_PI = 1.5707963267948966192313216916398;
    double r = a - TWO_PI * __builtin_rint(a / TWO_PI);
    const double qd = __builtin_rint(r / HALF_PI); const int q = (int)qd; r -= qd * HALF_PI;
    const double r2 = r * r;
    const double sn = r * (1.0 + r2 * (-1.0 / 6 + r2 * (1.0 / 120 + r2 * (-1.0 / 5040 + r2 * (1.0 / 362880 + r2 * (-1.0 / 39916800 + r2 * (1.0 / 6227020800.0)))))));
    const double cs = 1.0 + r2 * (-0.5 + r2 * (1.0 / 24 + r2 * (-1.0 / 720 + r2 * (1.0 / 40320 + r2 * (-1.0 / 3628800 + r2 * (1.0 / 479001600.0))))));
    const int qq = q & 3; double cc, ss;
    if (qq == 0) { cc = cs; ss = sn; } else if (qq == 1) { cc = -sn; ss = cs; } else if (qq == 2) { cc = -cs; ss = -sn; } else { cc = sn; ss = -cs; }
    c = (float)cc; s = (float)ss;
}
enum { MAP_ID = 0, MAP_INE = 1, MAP_GATE = 2, MAP_UP = 3 };
__device__ __forceinline__ int map_row(int mode, int n) {
    if (mode == MAP_INE) return n < 1024 ? (n & ~63) + 2 * (n & 31) + ((n >> 5) & 1) : n;
    if (mode == MAP_GATE) return (n >> 7) * 256 + (n & 127);
    if (mode == MAP_UP) return (n >> 7) * 256 + 128 + (n & 127);
    return n;
}
constexpr int TR_SCR_BYTES = 64 * 65 * 4;
template <class LP>
__device__ __forceinline__ void transpose_item(const float* __restrict__ W, int K, int N, bf16* WT, const float* __restrict__ gain, int mode, LP scr, int item, int lane) {
    const int nblk = (N + 63) / 64, kb = item / nblk, nb = item % nblk, k0 = 64 * kb, n0 = 64 * nb;
    const int lr = lane >> 4, lc = (lane & 15) * 4;
    const bool nok = n0 + lc < N;
    f32x4 v[16];
#pragma unroll
    for (int i = 0; i < 16; ++i) v[i] = nok ? *(const f32x4*)(W + (size_t)(k0 + 4 * i + lr) * N + n0 + lc) : (f32x4){0.f, 0.f, 0.f, 0.f};
#pragma unroll
    for (int i = 0; i < 16; ++i)
#pragma unroll
        for (int e = 0; e < 4; ++e) scr[(4 * i + lr) * 65 + lc + e] = v[i][e];
    asm volatile("s_waitcnt lgkmcnt(0)" ::: "memory");
    const int c = lane & 7;
    f32x4 g0 = {1.f, 1.f, 1.f, 1.f}, g1 = {1.f, 1.f, 1.f, 1.f};
    if (gain) { g0 = *(const f32x4*)(gain + k0 + 8 * c); g1 = *(const f32x4*)(gain + k0 + 8 * c + 4); }
#pragma unroll
    for (int j = 0; j < 8; ++j) { const int n = (lane >> 3) + 8 * j;
        u32x4 o; o.x = pk2(scr[(8 * c + 0) * 65 + n] * g0[0], scr[(8 * c + 1) * 65 + n] * g0[1]); o.y = pk2(scr[(8 * c + 2) * 65 + n] * g0[2], scr[(8 * c + 3) * 65 + n] * g0[3]);
        o.z = pk2(scr[(8 * c + 4) * 65 + n] * g1[0], scr[(8 * c + 5) * 65 + n] * g1[1]); o.w = pk2(scr[(8 * c + 6) * 65 + n] * g1[2], scr[(8 * c + 7) * 65 + n] * g1[3]);
        if (n0 + n < N) *(u32x4*)(WT + (size_t)map_row(mode, n0 + n) * K + k0 + 8 * c) = o; }
    asm volatile("s_waitcnt lgkmcnt(0)" ::: "memory");
}
struct WJob { const float* W; int K, N; bf16* WT; const float* gain; int mode; };
constexpr int WI_INE = (DM / 64) * (EW / 64), WI_SQ = (DM / 64) * (DM / 64), WI_FF = (DM / 64) * (DFF / 64), WI_INO = (DM / 64) * ((OW + 63) / 64);
constexpr int WB0 = 0, WB1 = WB0 + WI_INE, WB2 = WB1 + WI_SQ, WB3 = WB2 + WI_FF, WB4 = WB3 + WI_FF, WB5 = WB4 + WI_FF, WB6 = WB5 + WI_INO, WB7 = WB6 + WI_SQ, WB_END = WB7 + 3 * NEXP * WI_FF;
template <class LP>
__device__ __forceinline__ void prologue_weights(const Params& p, LP scr, int gw, int ngw, int lane) {
    unsigned char* ws = p.ws;
    for (int g = gw; g < WB_END; g += ngw) {
        WJob J; int it;
        if (g < WB1) { J = WJob{p.in[2], DM, EW, (bf16*)(ws + WS_W_IN_E), p.in[1], MAP_INE}; it = g - WB0; }
        else if (g < WB2) { J = WJob{p.in[4], DM, DM, (bf16*)(ws + WS_W_OUT_E), nullptr, MAP_ID}; it = g - WB1; }
        else if (g < WB3) { J = WJob{p.in[6], DM, DFF, (bf16*)(ws + WS_W_GU_E), p.in[5], MAP_GATE}; it = g - WB2; }
        else if (g < WB4) { J = WJob{p.in[7], DM, DFF, (bf16*)(ws + WS_W_GU_E), p.in[5], MAP_UP}; it = g - WB3; }
        else if (g < WB5) { J = WJob{p.in[8], DFF, DM, (bf16*)(ws + WS_W_DN_E), nullptr, MAP_ID}; it = g - WB4; }
        else if (g < WB6) { J = WJob{p.in[10], DM, OW, (bf16*)(ws + WS_W_IN_O), p.in[9], MAP_ID}; it = g - WB5; }
        else if (g < WB7) { J = WJob{p.in[12], DM, DM, (bf16*)(ws + WS_W_OUT_O), nullptr, MAP_ID}; it = g - WB6; }
        else { const int k = (g - WB7) / WI_FF, e = k / 3, w = k % 3; it = (g - WB7) % WI_FF;
            if (w == 0) J = WJob{p.in[15] + (size_t)e * DM * DFF, DM, DFF, (bf16*)(ws + WS_W_GU_M) + (size_t)e * GU * DM, p.in[13], MAP_GATE};
            else if (w == 1) J = WJob{p.in[16] + (size_t)e * DM * DFF, DM, DFF, (bf16*)(ws + WS_W_GU_M) + (size_t)e * GU * DM, p.in[13], MAP_UP};
            else J = WJob{p.in[17] + (size_t)e * DFF * DM, DFF, DM, (bf16*)(ws + WS_W_DN_M) + (size_t)e * DM * DFF, nullptr, MAP_ID}; }
        transpose_item(J.W, J.K, J.N, J.WT, J.gain, J.mode, scr, it, lane);
    }
}
__device__ __forceinline__ void prologue_small(const Params& p, int gt, int ngt) {
    unsigned char* ws = p.ws;
    { u32x4* z = (u32x4*)((bf16*)(ws + WS_W_IN_O) + (size_t)OW * DM); const int n16 = (OWP - OW) * DM * 2 / 16;
      for (int i = gt; i < n16; i += ngt) z[i] = (u32x4){0u, 0u, 0u, 0u}; }
    { float2* R = (float2*)(ws + WS_ROPE);
      for (int i = gt; i < SEQ * 32; i += ngt) { float c, s; rope_entry(i >> 5, i & 31, c, s); R[i] = make_float2(c, s); } }
    { float* RW = (float*)(ws + WS_ROUTW); const float* wr = p.in[14]; const float* g = p.in[13];
      for (int i = gt; i < NEXP * DM; i += ngt) { const int e = i >> 10, k = i & 1023; RW[i] = wr[k * NEXP + e] * g[k]; } }
}
__device__ __forceinline__ void rms_row_to_bf16(const float* xrow, bf16* orow, int lane) {
    const f32x4* xr = (const f32x4*)xrow + lane;
    f32x4 v[4]; float s = 0.f;
#pragma unroll
    for (int j = 0; j < 4; ++j) { v[j] = xr[64 * j]; s += (v[j][0] * v[j][0] + v[j][1] * v[j][1]) + (v[j][2] * v[j][2] + v[j][3] * v[j][3]); }
    const float rstd = 1.0f / sqrtf(wave_sum(s) * (1.f / DM) + NORM_EPS);
    unsigned long long* o8 = (unsigned long long*)orow + lane;
#pragma unroll
    for (int j = 0; j < 4; ++j) o8[64 * j] = (unsigned long long)pk2(v[j][0] * rstd, v[j][1] * rstd) | ((unsigned long long)pk2(v[j][2] * rstd, v[j][3] * rstd) << 32);
}
__device__ __forceinline__ void final_norm_row(float* row, const float* gain, int lane) {
    f32x4* xr = (f32x4*)row + lane; const f32x4* g = (const f32x4*)gain + lane;
    f32x4 v[4]; float s = 0.f;
#pragma unroll
    for (int j = 0; j < 4; ++j) { v[j] = xr[64 * j]; s += (v[j][0] * v[j][0] + v[j][1] * v[j][1]) + (v[j][2] * v[j][2] + v[j][3] * v[j][3]); }
    const float rstd = 1.0f / sqrtf(wave_sum(s) * (1.f / DM) + NORM_EPS);
#pragma unroll
    for (int j = 0; j < 4; ++j) xr[64 * j] = v[j] * rstd * g[64 * j];
}
__device__ __forceinline__ void router_row(const float* hrow, const float* RW, const float* part4, int row, float* rstd4, int lane, int& e1, int& e2, float& g1, float& g2) {
    const f32x4* xr = (const f32x4*)hrow + lane; f32x4 v[4];
#pragma unroll
    for (int j = 0; j < 4; ++j) v[j] = xr[64 * j];
    float lg[NEXP];
#pragma unroll
    for (int e = 0; e < NEXP; ++e) { const f32x4* w = (const f32x4*)(RW + e * DM) + lane; float s = 0.f;
#pragma unroll
        for (int j = 0; j < 4; ++j) { const f32x4 ww = w[64 * j]; s += (v[j][0] * ww[0] + v[j][1] * ww[1]) + (v[j][2] * ww[2] + v[j][3] * ww[3]); }
        lg[e] = wave_sum(s); }
    const float rstd = rstd_from_part(part4, row);
    if (lane == 0) rstd4[row] = rstd;
    int b1 = 0; float v1 = lg[0];
#pragma unroll
    for (int e = 1; e < NEXP; ++e) if (lg[e] > v1) { v1 = lg[e]; b1 = e; }
    int b2 = -1; float v2 = -INFINITY;
#pragma unroll
    for (int e = 0; e < NEXP; ++e) if (e != b1 && lg[e] > v2) { v2 = lg[e]; b2 = e; }
    e1 = b1; e2 = b2; const float d = (v2 - v1) * rstd;
    g1 = 1.f / (1.f + __expf(d)); g2 = 1.f - g1;
}

__global__ void __launch_bounds__(128) nk_prologue_w(Params p) {
    __shared__ float scr[2][64 * 65];
    const int wave = threadIdx.x >> 6, lane = threadIdx.x & 63;
    prologue_weights(p, &scr[wave][0], blockIdx.x * 2 + wave, gridDim.x * 2, lane);
}
__global__ void __launch_bounds__(256) nk_prologue_s(Params p) {
    prologue_small(p, blockIdx.x * 256 + threadIdx.x, gridDim.x * 256);
    const int gw = blockIdx.x * 4 + (threadIdx.x >> 6), ngw = gridDim.x * 4, lane = threadIdx.x & 63;
    for (int m = gw; m < T; m += ngw) rms_row_to_bf16(p.in[0] + (size_t)m * DM, (bf16*)(p.ws + WS_X0) + (size_t)m * DM, lane);
}
__global__ void __launch_bounds__(256) nk_rowssq(Params p, int which) {
    const int gw = blockIdx.x * 4 + (threadIdx.x >> 6), ngw = gridDim.x * 4, lane = threadIdx.x & 63;
    float* part = (float*)(p.ws + WS_PART) + (size_t)which * T * 16;
    for (int m = gw; m < T; m += ngw) { const f32x4* xr = (const f32x4*)(p.out + (size_t)m * DM) + lane; float s = 0.f;
#pragma unroll
        for (int j = 0; j < 4; ++j) { const f32x4 v = xr[64 * j]; s += (v[0] * v[0] + v[1] * v[1]) + (v[2] * v[2] + v[3] * v[3]); }
        s = wave_sum(s); if (lane < 16) part[(size_t)m * 16 + lane] = lane == 0 ? s : 0.f; }
}
template <int EPI> __global__ void __launch_bounds__(256) nk_gemm(Params p) {
    unsigned char* ws = p.ws; const unsigned* ctl = (const unsigned*)(ws + WS_CTL);
    const int lane = threadIdx.x & 63, w = threadIdx.x >> 6, wm = w >> 1, wn = w & 1, l15 = lane & 15, lq = lane >> 4;
    const int m0 = blockIdx.y * 64 + wm * 32, n0 = blockIdx.x * 64 + wn * 32;
    constexpr bool DUAL = (EPI == 4 || EPI == 10), MOE = (EPI == 10 || EPI == 11);
    constexpr int K = (EPI == 5 || EPI == 11) ? DFF : DM;
    const bf16* A; const bf16* Bt; int e = 0, row0 = 0, nrows = 256; const int c = p.ph_lo;
    if (MOE) { if (!moe_tile(ctl, c, blockIdx.y >> 2, e, row0, nrows)) return; }
    if (EPI == 1) { A = (const bf16*)(ws + WS_X0); Bt = (const bf16*)(ws + WS_W_IN_E); }
    else if (EPI == 3) { A = (const bf16*)(ws + WS_X0); Bt = (const bf16*)(ws + WS_W_OUT_E); }
    else if (EPI == 4) { A = (const bf16*)(ws + WS_BIG); Bt = (const bf16*)(ws + WS_W_GU_E); }
    else if (EPI == 5) { A = (const bf16*)(ws + WS_HID); Bt = (const bf16*)(ws + WS_W_DN_E); }
    else if (EPI == 6) { A = (const bf16*)(ws + WS_X0); Bt = (const bf16*)(ws + WS_W_IN_O); }
    else if (EPI == 8) { A = (const bf16*)(ws + WS_X0); Bt = (const bf16*)(ws + WS_W_OUT_O); }
    else if (EPI == 10) { A = (const bf16*)(ws + WS_BIG); Bt = (const bf16*)(ws + WS_W_GU_M) + (size_t)e * GU * DM; }
    else { A = (const bf16*)(ws + WS_HID); Bt = (const bf16*)(ws + WS_W_DN_M) + (size_t)e * DM * DFF; }
    const int* list = (const int*)(ws + WS_LIST) + (size_t)(c * 8 + e) * T; const float* glist = (const float*)(ws + WS_GATE) + (size_t)(c * 8 + e) * T;
    const bf16* arow[2];
#pragma unroll
    for (int i = 0; i < 2; ++i) { const int m = m0 + 16 * i + l15;
        if (EPI == 10) { const int r = (m & 255); const int tok = list[row0 + (r < nrows ? r : 0)]; arow[i] = A + (size_t)tok * K; }
        else arow[i] = A + (size_t)m * K; }
    const bf16* brow[2];
#pragma unroll
    for (int j = 0; j < 2; ++j) { const int n = n0 + 16 * j + l15; const int br = DUAL ? ((n >> 7) * 256 + (n & 127)) : n; brow[j] = Bt + (size_t)br * K; }
    f32x4 acc[2][2], acc2[2][2];
#pragma unroll
    for (int i = 0; i < 2; ++i)
#pragma unroll
        for (int j = 0; j < 2; ++j) { acc[i][j] = (f32x4){0.f, 0.f, 0.f, 0.f}; acc2[i][j] = (f32x4){0.f, 0.f, 0.f, 0.f}; }
    for (int k0 = 0; k0 < K; k0 += 32) {
        bf16x8 a[2], b[2], b2[2];
#pragma unroll
        for (int i = 0; i < 2; ++i) a[i] = *(const bf16x8*)(arow[i] + k0 + 8 * lq);
#pragma unroll
        for (int j = 0; j < 2; ++j) { b[j] = *(const bf16x8*)(brow[j] + k0 + 8 * lq); if (DUAL) b2[j] = *(const bf16x8*)(brow[j] + (size_t)128 * K + k0 + 8 * lq); }
#pragma unroll
        for (int i = 0; i < 2; ++i)
#pragma unroll
            for (int j = 0; j < 2; ++j) { acc[i][j] = __builtin_amdgcn_mfma_f32_16x16x32_bf16(a[i], b[j], acc[i][j], 0, 0, 0);
                if (DUAL) acc2[i][j] = __builtin_amdgcn_mfma_f32_16x16x32_bf16(a[i], b2[j], acc2[i][j], 0, 0, 0); }
    }
    const float2* rope = (const float2*)(ws + WS_ROPE);
#pragma unroll
    for (int i = 0; i < 2; ++i)
#pragma unroll
        for (int j = 0; j < 2; ++j)
#pragma unroll
            for (int r = 0; r < 4; ++r) {
                const int m = m0 + 16 * i + 4 * lq + r, n = n0 + 16 * j + l15; float v = acc[i][j][r];
                if (EPI == 1) {
                    bf16* O = (bf16*)(ws + WS_BIG);
                    const float vp = __shfl_xor(v, 1);
                    if (n < 1024) { const float2 cs = rope[(m & (SEQ - 1)) * 32 + ((n & 63) >> 1)];
                        v = (n & 1) ? (vp * cs.y + v * cs.x) : (v * cs.x - vp * cs.y);
                        if (n >= 512) v *= 0.125f; }
                    else if (n >= 2048 && n < 2560) v *= C2;
                    O[(size_t)m * EW + n] = (bf16)f2bf(v);
                } else if (EPI == 3 || EPI == 5 || EPI == 8) {
                    const float* resid = (EPI == 3) ? p.in[0] : p.out; const float o = resid[(size_t)m * DM + n] + v;
                    p.out[(size_t)m * DM + n] = o;
                    bf16* hb = (bf16*)(ws + (EPI == 5 ? WS_X0 : WS_BIG)); hb[(size_t)m * DM + n] = (bf16)f2bf(o);
                } else if (EPI == 4) {
                    const float rs = rstd_from_part((const float*)(ws + WS_PART), m);
                    const float g = v * rs, u = acc2[i][j][r] * rs; ((bf16*)(ws + WS_HID))[(size_t)m * DFF + n] = (bf16)f2bf(silu_f(g) * u);
                } else if (EPI == 6) {
                    const float rs = rstd_from_part((const float*)(ws + WS_PART) + (size_t)T * 16, m); v *= rs;
                    if (n < QKVW) { if (n < 1024) v *= C2; ((bf16*)(ws + WS_BIG))[(size_t)m * QKVW + n] = (bf16)f2bf(v); }
                    else if (n < OW) { const int h = n - QKVW; const float z = v + p.in[11][h]; const float lf = fminf(z, 0.f) - log1pf(__expf(-fabsf(z)));
                        ((float*)(ws + WS_LOGF))[((size_t)(m >> 12) * 16 + h) * SEQ + (m & (SEQ - 1))] = lf; }
                } else if (EPI == 10) {
                    const int rr = m & 255; const int tok = list[row0 + (rr < nrows ? rr : 0)]; const float rs = ((const float*)(ws + WS_RSTD4))[tok];
                    const float g = v * rs, u = acc2[i][j][r] * rs; ((bf16*)(ws + WS_HID))[(size_t)m * DFF + n] = (bf16)f2bf(silu_f(g) * u);
                } else if (EPI == 11) {
                    const int rr = m & 255; if (rr < nrows) { const int tok = list[row0 + rr]; const float gt = glist[row0 + rr]; p.out[(size_t)tok * DM + n] += gt * v; }
                }
            }
}
__global__ void __launch_bounds__(256) nk_retention(Params p) {
    const bf16* P = (const bf16*)(p.ws + WS_BIG); bf16* Y = (bf16*)(p.ws + WS_X0);
    const int gw = blockIdx.x * 4 + (threadIdx.x >> 6), lane = threadIdx.x & 63;
    const int t = gw & (SEQ - 1), h = (gw >> 12) & 7, b = gw >> 15; if (b >= BATCH) return;
    const float lg2 = log2f(1.0f - exp2f(-5.0f - (float)h));
    const size_t rb = (size_t)b * SEQ;
    const float q = bf2f(P[(rb + t) * EW + h * 64 + lane]);
    float o = 0.f;
    for (int s = 0; s <= t; ++s) {
        const float k = bf2f(P[(rb + s) * EW + 512 + h * 64 + lane]), v = bf2f(P[(rb + s) * EW + 1024 + h * 64 + lane]);
        const float d = wave_sum(q * k);
        o += exp2f(lg2 * (float)(t - s)) * d * v;
    }
    const float mu = wave_sum(o) * (1.f / 64.f); const float dv = o - mu; const float var = wave_sum(dv * dv) * (1.f / 64.f);
    const float g = bf2f(P[(rb + t) * EW + 1536 + h * 64 + lane]);
    const float y = dv * (1.0f / sqrtf(var + GN_EPS)) * p.in[3][h * 64 + lane] * silu_f(g);
    Y[(rb + t) * DM + h * 64 + lane] = (bf16)f2bf(y);
}
__global__ void __launch_bounds__(256) nk_stickbreak(Params p) {
    const bf16* P = (const bf16*)(p.ws + WS_BIG); bf16* Y = (bf16*)(p.ws + WS_X0);
    const int gw = blockIdx.x * 4 + (threadIdx.x >> 6), lane = threadIdx.x & 63;
    const int t = gw & (SEQ - 1), h = (gw >> 12) & 7, b = gw >> 15; if (b >= BATCH) return;
    const size_t rb = (size_t)b * SEQ;
    const float q = bf2f(P[(rb + t) * EW + 2048 + h * 64 + lane]);
    float o = 0.f, carry = 0.f;
    for (int s = t - 1; s >= 0; --s) {
        const float k = bf2f(P[(rb + s) * EW + 2560 + h * 64 + lane]), v = bf2f(P[(rb + s) * EW + 3072 + h * 64 + lane]);
        const float y = wave_sum(q * k);
        const float lf2 = -softplus2(y);
        o += __builtin_amdgcn_exp2f(y + lf2 + carry) * v;
        carry += lf2;
    }
    Y[(rb + t) * DM + 512 + h * 64 + lane] = (bf16)f2bf(o);
}
__global__ void __launch_bounds__(128) nk_cumsum(Params p) {
    const int i = threadIdx.x; const float* lf = (const float*)(p.ws + WS_LOGF) + (size_t)i * SEQ; float* cu = (float*)(p.ws + WS_CUM) + (size_t)i * SEQ;
    float s = 0.f; for (int t = 0; t < SEQ; ++t) { s += lf[t]; cu[t] = s; }
}
__global__ void __launch_bounds__(256) nk_fox(Params p) {
    const bf16* P = (const bf16*)(p.ws + WS_BIG); bf16* Y = (bf16*)(p.ws + WS_X0);
    const int gw = blockIdx.x * 4 + (threadIdx.x >> 6), lane = threadIdx.x & 63;
    const int t = gw & (SEQ - 1), h = (gw >> 12) & 15, b = gw >> 16; if (b >= BATCH) return;
    const size_t rb = (size_t)b * SEQ; const float* cu = (const float*)(p.ws + WS_CUM) + ((size_t)b * 16 + h) * SEQ;
    const float q = bf2f(P[(rb + t) * QKVW + h * 64 + lane]);
    const float ct = cu[t]; float m = -INFINITY, l = 0.f, o = 0.f;
    for (int s = 0; s <= t; ++s) {
        const float k = bf2f(P[(rb + s) * QKVW + 1024 + h * 64 + lane]), v = bf2f(P[(rb + s) * QKVW + 2048 + h * 64 + lane]);
        const float x = wave_sum(q * k) + (ct - cu[s]) * LOG2E;
        if (x > m) { const float f = __builtin_amdgcn_exp2f(m - x); l *= f; o *= f; m = x; }
        const float pr = __builtin_amdgcn_exp2f(x - m); l += pr; o += pr * v;
    }
    Y[(rb + t) * DM + h * 64 + lane] = (bf16)f2bf(o / l);
}
__global__ void __launch_bounds__(256) nk_router(Params p) {
    __shared__ unsigned lcnt[16], lbase[16]; __shared__ int tinfo[128][2]; __shared__ float tg[128][2]; __shared__ unsigned tpos[128][2];
    unsigned char* ws = p.ws; unsigned* ctl = (unsigned*)(ws + WS_CTL);
    const int lane = threadIdx.x & 63, w = threadIdx.x >> 6;
    if (threadIdx.x < 16) lcnt[threadIdx.x] = 0u;
    __syncthreads();
    const float* part4 = (const float*)(ws + WS_PART) + (size_t)2 * T * 16;
    for (int i = 0; i < 32; ++i) { const int lt = w * 32 + i, row = blockIdx.x * 128 + lt; int e1, e2; float g1, g2;
        router_row(p.out + (size_t)row * DM, (const float*)(ws + WS_ROUTW), part4, row, (float*)(ws + WS_RSTD4), lane, e1, e2, g1, g2);
        if (lane == 0) { tinfo[lt][0] = e1; tinfo[lt][1] = e2; tg[lt][0] = g1; tg[lt][1] = g2; tpos[lt][0] = atomicAdd(&lcnt[e1], 1u); tpos[lt][1] = atomicAdd(&lcnt[8 + e2], 1u); } }
    __syncthreads();
    if (threadIdx.x < 16) lbase[threadIdx.x] = atomicAdd(&ctl[CW_CNT + 64 * threadIdx.x], lcnt[threadIdx.x]);
    __syncthreads();
    if (threadIdx.x < 256) { const int lt = threadIdx.x >> 1, c = threadIdx.x & 1, e = tinfo[lt][c]; const unsigned pos = lbase[c * 8 + e] + tpos[lt][c];
        ((int*)(ws + WS_LIST))[(size_t)(c * 8 + e) * T + pos] = blockIdx.x * 128 + lt; ((float*)(ws + WS_GATE))[(size_t)(c * 8 + e) * T + pos] = tg[lt][c]; }
}
__global__ void __launch_bounds__(256) nk_final(Params p) {
    const int gw = blockIdx.x * 4 + (threadIdx.x >> 6), ngw = gridDim.x * 4, lane = threadIdx.x & 63;
    for (int m = gw; m < T; m += ngw) final_norm_row(p.out + (size_t)m * DM, p.in[18], lane);
}

namespace pg8 {
#define PG8_LAS __attribute__((address_space(3)))
constexpr int BM = 256, BK = 64, HALF = 128, HTB = HALF * BK * 2, STAGE_BYTES = 8 * HTB, NXCD = 8, WGM = 8;
__host__ __device__ __forceinline__ int lds_byte(int r, int c) { const int st = (r >> 4) * 2 + (c >> 5), rr = r & 15, cc = c & 31, ob = rr * 64 + cc * 2; return st * 1024 + (ob ^ (((ob >> 9) & 1) << 5)); }
__host__ __device__ __forceinline__ void stage_rc(int b, int& R, int& C) { const int st = b / 1024, sb = b % 1024, swz = sb ^ (((sb >> 9) & 1) << 5); R = (st >> 1) * 16 + swz / 64; C = (st & 1) * 32 + (swz % 64) / 2; }
__host__ __device__ __forceinline__ int perm32(int rho) { const int n = rho >> 4, i = rho & 15; return 8 * (i >> 2) + 4 * n + (i & 3); }
struct Unit { int pm, pn; };
struct StaticOrder {
    int nM, nN, nwg, G, c;
    __device__ void init(int nM_, int nN_, int G_, int c_) { nM = nM_; nN = nN_; nwg = nM * nN; G = G_; c = c_; }
    __device__ bool next(int i, Unit& u) const {
        const long L = (long)i * G + c; if (L >= nwg) return false;
        int wgid = (int)L; { const int q = nwg / NXCD, r = nwg % NXCD, xcd = wgid % NXCD, off = wgid / NXCD; wgid = (xcd < r ? xcd * (q + 1) : r * (q + 1) + (xcd - r) * q) + off; }
        const int nig = WGM * nN, gid = wgid / nig, fm = gid * WGM, gsz = (nM - fm) < WGM ? (nM - fm) : WGM;
        u.pm = fm + ((wgid % nig) % gsz); u.pn = (wgid % nig) / gsz; return true;
    }
};
struct ProbDense { const bf16* A; const bf16* Bt; int K; static constexpr bool GATHER = false;
    __device__ __forceinline__ const char* a_tile(const Unit& u) const { return (const char*)A + (size_t)u.pm * BM * K * 2; }
    __device__ __forceinline__ const char* b_tile(const Unit& u) const { return (const char*)Bt + (size_t)u.pn * BM * K * 2; }
    __device__ __forceinline__ void a_offsets(const Unit&, const int (&)[2], const int (&)[2], unsigned (&)[2][2]) const {}
};
struct ProbMoeDown { const bf16* A; const bf16* Bt; int K; size_t estride; const unsigned* ctl; int c; static constexpr bool GATHER = false;
    __device__ __forceinline__ const char* a_tile(const Unit& u) const { return (const char*)A + (size_t)u.pm * BM * K * 2; }
    __device__ __forceinline__ const char* b_tile(const Unit& u) const { int e = 0, r0, nr; moe_tile(ctl, c, u.pm, e, r0, nr); return (const char*)Bt + (size_t)e * estride + (size_t)u.pn * BM * K * 2; }
    __device__ __forceinline__ void a_offsets(const Unit&, const int (&)[2], const int (&)[2], unsigned (&)[2][2]) const {}
};
struct ProbMoeGU { const bf16* A; const bf16* Bt; int K; size_t estride; const unsigned* ctl; int c; const int* lists; static constexpr bool GATHER = true;
    __device__ __forceinline__ const char* a_tile(const Unit&) const { return (const char*)A; }
    __device__ __forceinline__ const char* b_tile(const Unit& u) const { int e = 0, r0, nr; moe_tile(ctl, c, u.pm, e, r0, nr); return (const char*)Bt + (size_t)e * estride + (size_t)u.pn * BM * K * 2; }
    __device__ __forceinline__ void a_offsets(const Unit& u, const int (&RA)[2], const int (&CA)[2], unsigned (&off)[2][2]) const {
        int e = 0, r0 = 0, nr = 1; moe_tile(ctl, c, u.pm, e, r0, nr); const int* l = lists + (size_t)(c * 8 + e) * T + r0;
#pragma unroll
        for (int h = 0; h < 2; ++h)
#pragma unroll
            for (int i = 0; i < 2; ++i) { const int r = h * HALF + RA[i]; const int tok = l[r < nr ? r : 0]; off[h][i] = (unsigned)tok * (unsigned)(K * 2) + (unsigned)(CA[i] * 2); }
    }
};

#define PG8_EARGS const f32x4 (&acc)[2][2][4][2], const Unit& u, int wr, int wc, int fr, int fq
__device__ __forceinline__ u32x4 pack8(const f32x4 a, const f32x4 b) { u32x4 w; w.x = pk2(a[0], a[1]); w.y = pk2(a[2], a[3]); w.z = pk2(b[0], b[1]); w.w = pk2(b[2], b[3]); return w; }
__device__ __forceinline__ float quad_rstd(const float* part, int row, int fq) {
    const f32x4 q = *(const f32x4*)(part + (size_t)row * 16 + 4 * fq); float s = (q[0] + q[1]) + (q[2] + q[3]);
    s += __shfl_xor(s, 16); s += __shfl_xor(s, 32); return 1.0f / sqrtf(s * (1.f / DM) + NORM_EPS);
}
#define PG8_BATCH_FENCE() do { asm volatile("" ::: "memory"); __builtin_amdgcn_sched_barrier(0); } while (0)
struct EpiInEven { static constexpr bool PERM = true; bf16* O; const float2* rope;
    __device__ __forceinline__ void operator()(PG8_EARGS) const {
        const int pn = u.pn, row0 = u.pm * BM + wr * 64 + fr, colb = pn * BM + wc * 32 + 8 * fq;
        if (pn < 4) {
            const float sc = (pn >= 2) ? 0.125f : 1.f;
#pragma unroll
            for (int ai = 0; ai < 2; ++ai) {
                f32x4 cs[4][2];
#pragma unroll
                for (int m = 0; m < 4; ++m) { const int row = row0 + ai * HALF + m * 16; const f32x4* rp = (const f32x4*)(rope + (size_t)(row & (SEQ - 1)) * 32 + 16 * (wc & 1) + 4 * fq); cs[m][0] = rp[0]; cs[m][1] = rp[1]; }
                PG8_BATCH_FENCE();
#pragma unroll
                for (int m = 0; m < 4; ++m) { const int row = row0 + ai * HALF + m * 16; const f32x4 cs0 = cs[m][0], cs1 = cs[m][1];
#pragma unroll
                    for (int bj = 0; bj < 2; ++bj) { const f32x4 v0 = acc[ai][bj][m][0], v1 = acc[ai][bj][m][1]; f32x4 a, b;
                        a[0] = v0[0] * cs0[0] - v0[1] * cs0[1]; a[1] = v0[0] * cs0[1] + v0[1] * cs0[0]; a[2] = v0[2] * cs0[2] - v0[3] * cs0[3]; a[3] = v0[2] * cs0[3] + v0[3] * cs0[2];
                        b[0] = v1[0] * cs1[0] - v1[1] * cs1[1]; b[1] = v1[0] * cs1[1] + v1[1] * cs1[0]; b[2] = v1[2] * cs1[2] - v1[3] * cs1[3]; b[3] = v1[2] * cs1[3] + v1[3] * cs1[2];
                        *(u32x4*)(O + (size_t)row * EW + colb + bj * HALF) = pack8(a * sc, b * sc); } } }
        } else {
            const float sc = (pn == 8 || pn == 9) ? C2 : 1.f;
#pragma unroll
            for (int ai = 0; ai < 2; ++ai)
#pragma unroll
                for (int m = 0; m < 4; ++m) { const int row = row0 + ai * HALF + m * 16;
#pragma unroll
                    for (int bj = 0; bj < 2; ++bj) *(u32x4*)(O + (size_t)row * EW + colb + bj * HALF) = pack8(acc[ai][bj][m][0] * sc, acc[ai][bj][m][1] * sc); }
        }
    }
};
struct EpiResid { static constexpr bool PERM = true; const float* resid; float* out; bf16* hb; float* part;
    __device__ __forceinline__ void operator()(PG8_EARGS) const {
        const int row0 = u.pm * BM + wr * 64 + fr, colb = u.pn * BM + wc * 32 + 8 * fq;
#pragma unroll
        for (int ai = 0; ai < 2; ++ai) {
            f32x4 rr[4][2][2];
#pragma unroll
            for (int m = 0; m < 4; ++m)
#pragma unroll
                for (int bj = 0; bj < 2; ++bj) { const size_t off = (size_t)(row0 + ai * HALF + m * 16) * DM + colb + bj * HALF; rr[m][bj][0] = *(const f32x4*)(resid + off); rr[m][bj][1] = *(const f32x4*)(resid + off + 4); }
            PG8_BATCH_FENCE();
#pragma unroll
            for (int m = 0; m < 4; ++m) { const int row = row0 + ai * HALF + m * 16; float ss = 0.f;
#pragma unroll
                for (int bj = 0; bj < 2; ++bj) { const size_t off = (size_t)row * DM + colb + bj * HALF;
                    const f32x4 o0 = rr[m][bj][0] + acc[ai][bj][m][0], o1 = rr[m][bj][1] + acc[ai][bj][m][1];
                    *(f32x4*)(out + off) = o0; *(f32x4*)(out + off + 4) = o1; *(u32x4*)(hb + off) = pack8(o0, o1);
                    ss += (o0[0] * o0[0] + o0[1] * o0[1]) + (o0[2] * o0[2] + o0[3] * o0[3]) + (o1[0] * o1[0] + o1[1] * o1[1]) + (o1[2] * o1[2] + o1[3] * o1[3]); }
                ss += __shfl_xor(ss, 16); ss += __shfl_xor(ss, 32);
                if (fq == 0) part[(size_t)row * 16 + u.pn * 4 + wc] = ss; }
            PG8_BATCH_FENCE(); }
    }
};
__device__ __forceinline__ float fast_silu(float x) { return x * __builtin_amdgcn_rcpf(1.f + __builtin_amdgcn_exp2f(-LOG2E * x)); }
struct EpiGU { static constexpr bool PERM = true; bf16* hid; const float* part;
    __device__ __forceinline__ void operator()(PG8_EARGS) const {
        const int row0 = u.pm * BM + wr * 64 + fr, colb = u.pn * HALF + wc * 32 + 8 * fq;
        f32x4 q[2][4];
#pragma unroll
        for (int ai = 0; ai < 2; ++ai)
#pragma unroll
            for (int m = 0; m < 4; ++m) q[ai][m] = *(const f32x4*)(part + (size_t)(row0 + ai * HALF + m * 16) * 16 + 4 * fq);
        PG8_BATCH_FENCE();
#pragma unroll
        for (int ai = 0; ai < 2; ++ai)
#pragma unroll
            for (int m = 0; m < 4; ++m) { const int row = row0 + ai * HALF + m * 16; float s = (q[ai][m][0] + q[ai][m][1]) + (q[ai][m][2] + q[ai][m][3]);
                s += __shfl_xor(s, 16); s += __shfl_xor(s, 32); const float rs = 1.0f / sqrtf(s * (1.f / DM) + NORM_EPS);
                f32x4 h0, h1;
#pragma unroll
                for (int e = 0; e < 4; ++e) { h0[e] = fast_silu(acc[ai][0][m][0][e] * rs) * (acc[ai][1][m][0][e] * rs); h1[e] = fast_silu(acc[ai][0][m][1][e] * rs) * (acc[ai][1][m][1][e] * rs); }
                *(u32x4*)(hid + (size_t)row * DFF + colb) = pack8(h0, h1); }
    }
};
struct EpiInOdd { static constexpr bool PERM = true; bf16* O; const float* part; const float* bias; float* logf;
    __device__ __forceinline__ void operator()(PG8_EARGS) const {
        const int pn = u.pn, row0 = u.pm * BM + wr * 64 + fr, colb = pn * BM + wc * 32 + 8 * fq;
        const float sc = pn < 4 ? C2 : 1.f;
        f32x4 q[2][4]; float rs[2][4];
#pragma unroll
        for (int ai = 0; ai < 2; ++ai)
#pragma unroll
            for (int m = 0; m < 4; ++m) q[ai][m] = *(const f32x4*)(part + (size_t)(row0 + ai * HALF + m * 16) * 16 + 4 * fq);
        PG8_BATCH_FENCE();
#pragma unroll
        for (int ai = 0; ai < 2; ++ai)
#pragma unroll
            for (int m = 0; m < 4; ++m) { float s = (q[ai][m][0] + q[ai][m][1]) + (q[ai][m][2] + q[ai][m][3]); s += __shfl_xor(s, 16); s += __shfl_xor(s, 32); rs[ai][m] = 1.0f / sqrtf(s * (1.f / DM) + NORM_EPS); }
        if (pn < 12) {
#pragma unroll
            for (int ai = 0; ai < 2; ++ai)
#pragma unroll
                for (int m = 0; m < 4; ++m) { const int row = row0 + ai * HALF + m * 16;
#pragma unroll
                    for (int bj = 0; bj < 2; ++bj) *(u32x4*)(O + (size_t)row * QKVW + colb + bj * HALF) = pack8(acc[ai][bj][m][0] * (rs[ai][m] * sc), acc[ai][bj][m][1] * (rs[ai][m] * sc)); }
        } else if (wc == 0 && fq < 2) {
            f32x4 b0 = *(const f32x4*)(bias + 8 * fq), b1 = *(const f32x4*)(bias + 8 * fq + 4);
#pragma unroll
            for (int ai = 0; ai < 2; ++ai)
#pragma unroll
                for (int m = 0; m < 4; ++m) { const int row = row0 + ai * HALF + m * 16;
#pragma unroll
                    for (int n = 0; n < 2; ++n)
#pragma unroll
                        for (int e = 0; e < 4; ++e) { const int h = 8 * fq + 4 * n + e; const float z = acc[ai][0][m][n][e] * rs[ai][m] + (n ? b1[e] : b0[e]);
                            logf[((size_t)(row >> 12) * 16 + h) * SEQ + (row & (SEQ - 1))] = fminf(z, 0.f) - __logf(1.f + __expf(-fabsf(z))); } }
        }
    }
};
struct EpiMoeGU { static constexpr bool PERM = true; bf16* hid; const float* rstd4; const unsigned* ctl; int c; const int* lists;
    __device__ __forceinline__ void operator()(PG8_EARGS) const {
        int e = 0, r0 = 0, nr = 1; moe_tile(ctl, c, u.pm, e, r0, nr); const int* l = lists + (size_t)(c * 8 + e) * T + r0;
        const int rl0 = wr * 64 + fr, colb = u.pn * HALF + wc * 32 + 8 * fq;
        int tk[2][4]; float rs[2][4];
#pragma unroll
        for (int ai = 0; ai < 2; ++ai)
#pragma unroll
            for (int m = 0; m < 4; ++m) { const int rl = rl0 + ai * HALF + m * 16; tk[ai][m] = l[rl < nr ? rl : 0]; }
        PG8_BATCH_FENCE();
#pragma unroll
        for (int ai = 0; ai < 2; ++ai)
#pragma unroll
            for (int m = 0; m < 4; ++m) rs[ai][m] = rstd4[tk[ai][m]];
        PG8_BATCH_FENCE();
#pragma unroll
        for (int ai = 0; ai < 2; ++ai)
#pragma unroll
            for (int m = 0; m < 4; ++m) { const int rl = rl0 + ai * HALF + m * 16; const float r = rs[ai][m];
                f32x4 h0, h1;
#pragma unroll
                for (int x = 0; x < 4; ++x) { h0[x] = fast_silu(acc[ai][0][m][0][x] * r) * (acc[ai][1][m][0][x] * r); h1[x] = fast_silu(acc[ai][0][m][1][x] * r) * (acc[ai][1][m][1][x] * r); }
                *(u32x4*)(hid + (size_t)(u.pm * BM + rl) * DFF + colb) = pack8(h0, h1); }
    }
};
struct EpiMoeDown { static constexpr bool PERM = true; float* out; const unsigned* ctl; int c; const int* lists; const float* gates;
    __device__ __forceinline__ void operator()(PG8_EARGS) const {
        int e = 0, r0 = 0, nr = 0; moe_tile(ctl, c, u.pm, e, r0, nr); const int* l = lists + (size_t)(c * 8 + e) * T + r0; const float* g = gates + (size_t)(c * 8 + e) * T + r0;
        const int rl0 = wr * 64 + fr, colb = u.pn * BM + wc * 32 + 8 * fq;
        int tk[2][4]; float gt[2][4];
#pragma unroll
        for (int ai = 0; ai < 2; ++ai)
#pragma unroll
            for (int m = 0; m < 4; ++m) { const int rl = rl0 + ai * HALF + m * 16; const bool ok = rl < nr; tk[ai][m] = l[ok ? rl : 0]; gt[ai][m] = ok ? g[ok ? rl : 0] : 0.f; }
        PG8_BATCH_FENCE();
#pragma unroll
        for (int ai = 0; ai < 2; ++ai) {
            f32x4 rr[4][2][2];
#pragma unroll
            for (int m = 0; m < 4; ++m)
#pragma unroll
                for (int bj = 0; bj < 2; ++bj) { const float* o = out + (size_t)tk[ai][m] * DM + colb + bj * HALF; rr[m][bj][0] = *(const f32x4*)o; rr[m][bj][1] = *(const f32x4*)(o + 4); }
            PG8_BATCH_FENCE();
#pragma unroll
            for (int m = 0; m < 4; ++m) { const int rl = rl0 + ai * HALF + m * 16;
                if (rl < nr) {
#pragma unroll
                    for (int bj = 0; bj < 2; ++bj) { float* o = out + (size_t)tk[ai][m] * DM + colb + bj * HALF;
                        *(f32x4*)o = rr[m][bj][0] + acc[ai][bj][m][0] * gt[ai][m]; *(f32x4*)(o + 4) = rr[m][bj][1] + acc[ai][bj][m][1] * gt[ai][m]; } } }
            PG8_BATCH_FENCE(); }
    }
};

template <class Prob, class Epi, class Sched>
__device__ __forceinline__ void gemm_phase(PG8_LAS unsigned char* lds, const Prob& P, const Sched& S, const Epi& E, int tag = -1) {
#ifdef PROBE_PH
    unsigned long long pr_t0 = 0, pr_k = 0, pr_e = 0; const bool pr_on = (tag == PROBE_PH) && blockIdx.x == 0 && threadIdx.x == 0;
#endif
    const int tid = threadIdx.x, wid = __builtin_amdgcn_readfirstlane(tid >> 6), lane = tid & 63, wr = wid >> 2, wc = wid & 3, fr = lane & 15, fq = lane >> 4;
    const int K = P.K, nt = K / BK;
    unsigned voffA[2], voffB[2]; int RA[2], CA[2];
#pragma unroll
    for (int i = 0; i < 2; ++i) { int R, C; stage_rc(tid * 16 + i * 8192, R, C); const int Rb = Epi::PERM ? ((R & ~31) + perm32(R & 31)) : R;
        voffA[i] = (unsigned)(R * K + C) * 2u; voffB[i] = (unsigned)(Rb * K + C) * 2u; RA[i] = R; CA[i] = C; }
    const size_t kstep = (size_t)(BK * 2);
    const size_t hstep = (size_t)HALF * K * 2;
    const unsigned ldsw = (unsigned)wid * 1024u;
    const int aoff = lds_byte(wr * 64 + fr, fq * 8), boff = lds_byte(wc * 32 + fr, fq * 8);
    unsigned offC[2][2] = {{0u, 0u}, {0u, 0u}}, offN[2][2] = {{0u, 0u}, {0u, 0u}};
#define PG8_SA(b, h) (((b) * 2 + (h)) * HTB)
#define PG8_SB(b, h) ((4 + (b) * 2 + (h)) * HTB)
#define PG8_STAGE(bufoff, gbase, voff) do { _Pragma("unroll") for (int _i = 0; _i < 2; ++_i) \
        __builtin_amdgcn_global_load_lds((const unsigned*)((const char*)(gbase) + (voff)[_i]), (PG8_LAS unsigned*)(lds + (bufoff) + ldsw + _i * 8192), 16, 0, 0); } while (0)
#define PG8_STAGE_A(bufoff, gbase, h, nx) do { _Pragma("unroll") for (int _i = 0; _i < 2; ++_i) { \
        const size_t _o = Prob::GATHER ? (size_t)((nx) ? offN[h][_i] : offC[h][_i]) : (size_t)voffA[_i] + (size_t)(h) * hstep; \
        __builtin_amdgcn_global_load_lds((const unsigned*)((const char*)(gbase) + _o), (PG8_LAS unsigned*)(lds + (bufoff) + ldsw + _i * 8192), 16, 0, 0); } } while (0)
#define PG8_LDA(dst, b, h) do { _Pragma("unroll") for (int m = 0; m < 4; ++m) _Pragma("unroll") for (int k = 0; k < 2; ++k) dst[m][k] = *(const PG8_LAS bf16x8*)(lds + PG8_SA(b, h) + aoff + m * 2048 + k * 1024); } while (0)
#define PG8_LDB(dst, b, h) do { _Pragma("unroll") for (int n = 0; n < 2; ++n) _Pragma("unroll") for (int k = 0; k < 2; ++k) dst[n][k] = *(const PG8_LAS bf16x8*)(lds + PG8_SB(b, h) + boff + n * 2048 + k * 1024); } while (0)
#define PG8_MMA(ai, bj, At, Bt) do { __builtin_amdgcn_s_setprio(1); _Pragma("unroll") for (int m = 0; m < 4; ++m) _Pragma("unroll") for (int n = 0; n < 2; ++n) _Pragma("unroll") for (int k = 0; k < 2; ++k) \
        acc[ai][bj][m][n] = __builtin_amdgcn_mfma_f32_16x16x32_bf16(Bt[n][k], At[m][k], acc[ai][bj][m][n], 0, 0, 0); __builtin_amdgcn_s_setprio(0); } while (0)
#define PG8_WAIT_V(n) asm volatile("s_waitcnt vmcnt(" #n ")" ::: "memory")
#define PG8_WAIT_L(n) asm volatile("s_waitcnt lgkmcnt(" #n ")" ::: "memory")
#define PG8_BAR __builtin_amdgcn_s_barrier()
#define PG8_SCHED __builtin_amdgcn_sched_barrier(0)
    Unit cur, nxt; int ui = 0;
    if (!S.next(0, cur)) return;
    f32x4 acc[2][2][4][2];
#pragma unroll
    for (int a = 0; a < 2; ++a)
#pragma unroll
        for (int b = 0; b < 2; ++b)
#pragma unroll
            for (int m = 0; m < 4; ++m)
#pragma unroll
                for (int n = 0; n < 2; ++n) acc[a][b][m][n] = (f32x4){0.f, 0.f, 0.f, 0.f};
    bf16x8 At[4][2], B0[2][2], B1[2][2];
    const char* cA = P.a_tile(cur); const char* cB = P.b_tile(cur);
    if constexpr (Prob::GATHER) P.a_offsets(cur, RA, CA, offC);
    PG8_STAGE(PG8_SB(0, 0), cB, voffB); PG8_STAGE(PG8_SB(0, 1), cB + hstep, voffB); PG8_STAGE_A(PG8_SA(0, 0), cA, 0, false); PG8_STAGE_A(PG8_SA(0, 1), cA, 1, false);
    if (wr == 1) PG8_BAR;
    PG8_WAIT_V(2); PG8_BAR;
    PG8_STAGE(PG8_SB(1, 0), cB + kstep, voffB); PG8_STAGE_A(PG8_SA(1, 0), cA + kstep, 0, false); PG8_STAGE(PG8_SB(1, 1), cB + hstep + kstep, voffB);
    PG8_WAIT_V(6); PG8_BAR;
    for (;;) {
#ifdef PROBE_PH
        if (pr_on) pr_t0 = __builtin_amdgcn_s_memrealtime();
#endif
        const bool has_next = S.next(ui + 1, nxt);
        const char* nA = has_next ? P.a_tile(nxt) : cA; const char* nB = has_next ? P.b_tile(nxt) : cB;
        if constexpr (Prob::GATHER) { if (ui == 0) { if (has_next) P.a_offsets(nxt, RA, CA, offN); else {
#pragma unroll
            for (int h = 0; h < 2; ++h)
#pragma unroll
                for (int i = 0; i < 2; ++i) offN[h][i] = offC[h][i]; } } }
        for (int t = 0; t < nt; t += 2) {
            const bool last = (t == nt - 2);
            const char* a1 = cA + (size_t)(t + 1) * kstep;
            const char* a2 = last ? nA : cA + (size_t)(t + 2) * kstep; const char* b2 = last ? nB : cB + (size_t)(t + 2) * kstep;
            const char* a3 = a2 + kstep; const char* b3 = b2 + kstep;
            PG8_LDB(B0, 0, 0); PG8_LDB(B1, 0, 1); PG8_SCHED; PG8_LDA(At, 0, 0); PG8_STAGE_A(PG8_SA(1, 1), a1, 1, false);
            PG8_WAIT_V(8); PG8_WAIT_L(0); PG8_BAR; PG8_MMA(0, 0, At, B0); PG8_MMA(0, 1, At, B1); PG8_BAR; PG8_SCHED;
            PG8_LDA(At, 0, 1); PG8_STAGE(PG8_SB(0, 0), b2, voffB); PG8_STAGE(PG8_SB(0, 1), b2 + hstep, voffB); PG8_STAGE_A(PG8_SA(0, 0), a2, 0, last);
            PG8_WAIT_V(8); PG8_WAIT_L(0); PG8_BAR; PG8_MMA(1, 0, At, B0); PG8_MMA(1, 1, At, B1); PG8_BAR; PG8_SCHED;
            PG8_LDB(B0, 1, 0); PG8_LDB(B1, 1, 1); PG8_SCHED; PG8_LDA(At, 1, 0); PG8_STAGE_A(PG8_SA(0, 1), a2, 1, last);
            PG8_WAIT_V(8); PG8_WAIT_L(0); PG8_BAR; PG8_MMA(0, 0, At, B0); PG8_MMA(0, 1, At, B1); PG8_BAR; PG8_SCHED;
            PG8_LDA(At, 1, 1); PG8_STAGE(PG8_SB(1, 0), b3, voffB); PG8_STAGE(PG8_SB(1, 1), b3 + hstep, voffB); PG8_STAGE_A(PG8_SA(1, 0), a3, 0, last);
            PG8_WAIT_V(8); PG8_WAIT_L(0); PG8_BAR; PG8_MMA(1, 0, At, B0); PG8_MMA(1, 1, At, B1); PG8_BAR; PG8_SCHED;
        }
        if (wr == 0) PG8_BAR;
#ifdef PROBE_PH
        unsigned long long pr_t1 = 0; if (pr_on) { pr_t1 = __builtin_amdgcn_s_memrealtime(); pr_k += pr_t1 - pr_t0; }
#endif
        unsigned offNN[2][2] = {{0u, 0u}, {0u, 0u}};
        if constexpr (Prob::GATHER) { Unit n2; if (has_next) { if (S.next(ui + 2, n2)) P.a_offsets(n2, RA, CA, offNN); else {
#pragma unroll
            for (int h = 0; h < 2; ++h)
#pragma unroll
                for (int i = 0; i < 2; ++i) offNN[h][i] = offN[h][i]; } } }
        E(acc, cur, wr, wc, fr, fq);
#ifdef PROBE_PH
        if (pr_on) { pr_e += __builtin_amdgcn_s_memrealtime() - pr_t1; }
#endif
        if (!has_next) break;
#pragma unroll
        for (int a = 0; a < 2; ++a)
#pragma unroll
            for (int b = 0; b < 2; ++b)
#pragma unroll
                for (int m = 0; m < 4; ++m)
#pragma unroll
                    for (int n = 0; n < 2; ++n) acc[a][b][m][n] = (f32x4){0.f, 0.f, 0.f, 0.f};
        cur = nxt; cA = nA; cB = nB; ++ui;
        if constexpr (Prob::GATHER) {
#pragma unroll
            for (int h = 0; h < 2; ++h)
#pragma unroll
                for (int i = 0; i < 2; ++i) { offC[h][i] = offN[h][i]; offN[h][i] = offNN[h][i]; } }
        if (wr == 1) PG8_BAR;
    }
    PG8_WAIT_V(0);
    PG8_BAR;
#ifdef PROBE_PH
    if (pr_on) { ((PG8_LAS unsigned*)(lds + 147456 - 128))[0] = (unsigned)pr_k; ((PG8_LAS unsigned*)(lds + 147456 - 128))[1] = (unsigned)pr_e; }
#endif
#undef PG8_SA
#undef PG8_SB
#undef PG8_STAGE
#undef PG8_STAGE_A
#undef PG8_LDA
#undef PG8_LDB
#undef PG8_MMA
#undef PG8_WAIT_V
#undef PG8_WAIT_L
#undef PG8_BAR
#undef PG8_SCHED
}
}
namespace att {
#define ALAS __attribute__((address_space(3)))
typedef _Float16 f16x8 __attribute__((ext_vector_type(8)));
typedef short s16x4 __attribute__((ext_vector_type(4)));
typedef short v4i16_t __attribute__((ext_vector_type(4)));
constexpr int KSTR = 144, VSTR = 192;
constexpr int KT_BYTES = 64 * KSTR, VT_BYTES = 64 * VSTR, STAGE = KT_BYTES + VT_BYTES;
constexpr int FLAG_OFF = 2 * STAGE;
constexpr int CUM_OFF = 49152;
constexpr float EXIT_T = -152.0f;
__device__ __forceinline__ int crow(int r, int hi) { return (r & 3) + 8 * (r >> 2) + 4 * hi; }
__device__ __forceinline__ bf16x8 vtr2(const ALAS unsigned char* p0, const ALAS unsigned char* p1) {
    const s16x4 a = __builtin_bit_cast(s16x4, __builtin_amdgcn_ds_read_tr16_b64_v4i16((ALAS v4i16_t*)p0));
    const s16x4 b = __builtin_bit_cast(s16x4, __builtin_amdgcn_ds_read_tr16_b64_v4i16((ALAS v4i16_t*)p1));
    return (bf16x8){a[0], a[1], a[2], a[3], b[0], b[1], b[2], b[3]};
}
__device__ __forceinline__ bf16x8 packbf8(const f32x16& p, int b) { u32x4 w; w.x = pk2(p[b], p[b + 1]); w.y = pk2(p[b + 2], p[b + 3]); w.z = pk2(p[b + 4], p[b + 5]); w.w = pk2(p[b + 6], p[b + 7]); return __builtin_bit_cast(bf16x8, w); }
__device__ __forceinline__ f16x8 packh8(const f32x16& p, int b) { f16x8 h;
#pragma unroll
    for (int j = 0; j < 8; ++j) h[j] = (_Float16)p[b + j];
    return h; }
__device__ __forceinline__ void pv_tile(f32x16 (&o)[2], const ALAS unsigned char* vb, int vl, const bf16x8 (&pb)[4]) {
#pragma unroll
    for (int dh = 0; dh < 2; ++dh)
#pragma unroll
        for (int s = 0; s < 4; ++s) { const ALAS unsigned char* a = vb + vl + (16 * s) * VSTR + dh * 64;
            o[dh] = __builtin_amdgcn_mfma_f32_32x32x16_bf16(vtr2(a, a + 8 * VSTR), pb[s], o[dh], 0, 0, 0); }
}
template <int MODE>
__device__ __forceinline__ void unit(ALAS unsigned char* lds, const bf16* Q, const bf16* K, const bf16* V, int pitch, bf16* O, size_t rowbase, int q0, const ALAS float* cum2) {
    const int tid = threadIdx.x, lane = tid & 63, r32 = lane & 31, hi = lane >> 5, wid = __builtin_amdgcn_readfirstlane(tid >> 6);
    const int R0 = q0 + 32 * wid, qrow = R0 + r32;
    bf16x8 qr[4];
#pragma unroll
    for (int d0 = 0; d0 < 4; ++d0) qr[d0] = *(const bf16x8*)(Q + (rowbase + qrow) * pitch + 16 * d0 + 8 * hi);
    const int srow = tid >> 3, sch = tid & 7;
    const bf16* kg = K + (rowbase + srow) * pitch + sch * 8; const bf16* vg = V + (rowbase + srow) * pitch + sch * 8;
    const int kdst = srow * KSTR + sch * 16, vdst = KT_BYTES + srow * VSTR + sch * 16;
    const int kl = r32 * KSTR + 16 * hi;
    const int vl = (4 * hi + ((lane & 15) >> 2)) * VSTR + (16 * ((lane >> 4) & 1) + 4 * (lane & 3)) * 2;
    ALAS unsigned* flags = (ALAS unsigned*)(lds + FLAG_OFF);
    const int jtop = (q0 >> 6) + 3;
    u32x4 kreg = *(const u32x4*)(kg + (size_t)jtop * 64 * pitch), vreg = *(const u32x4*)(vg + (size_t)jtop * 64 * pitch);
    *(ALAS u32x4*)(lds + kdst) = kreg; *(ALAS u32x4*)(lds + vdst) = vreg;
    __syncthreads();
    f32x16 o[2];
#pragma unroll
    for (int r = 0; r < 16; ++r) { o[0][r] = 0.f; o[1][r] = 0.f; }
    float carry = 0.f, m = 0.f, l = 0.f; bool started = false;
    const float cq = (MODE == 1) ? -cum2[qrow] : 0.f; float qn = 0.f;
    if (MODE == 1) { float s2 = 0.f;
#pragma unroll
        for (int d0 = 0; d0 < 4; ++d0)
#pragma unroll
            for (int j = 0; j < 8; ++j) { const float v = bf2f((unsigned short)qr[d0][j]); s2 += v * v; }
        s2 += __shfl_xor(s2, 32); qn = sqrtf(s2) * 1.002f; }
    f16x8 M0, M1, ONES;
#pragma unroll
    for (int j = 0; j < 8; ++j) { const int kk = 8 * (j >> 2) + 4 * hi + (j & 3); M0[j] = (kk > r32) ? (_Float16)1.f : (_Float16)0.f; M1[j] = (16 + kk > r32) ? (_Float16)1.f : (_Float16)0.f; ONES[j] = (_Float16)1.f; }
    int cur = 0;
    for (int j = jtop; j >= 0; --j) {
        const bool more = j > 0;
        if (more) { kreg = *(const u32x4*)(kg + (size_t)(j - 1) * 64 * pitch); vreg = *(const u32x4*)(vg + (size_t)(j - 1) * 64 * pitch); }
        const ALAS unsigned char* kb = lds + cur * STAGE; const ALAS unsigned char* vb = kb + KT_BYTES;
        const int key0 = 64 * j;
        if (key0 <= R0 + 31) {
            const bool diag = key0 + 63 >= R0;
            f32x16 p0, p1;
            if (MODE == 1) { const float cqm = cq - m;
#pragma unroll
                for (int g = 0; g < 4; ++g) { const f32x4 cb0 = *(const ALAS f32x4*)(cum2 + key0 + 8 * g + 4 * hi), cb1 = *(const ALAS f32x4*)(cum2 + key0 + 32 + 8 * g + 4 * hi);
#pragma unroll
                    for (int e = 0; e < 4; ++e) { p0[4 * g + e] = cqm + cb0[e]; p1[4 * g + e] = cqm + cb1[e]; } }
            } else {
#pragma unroll
                for (int r = 0; r < 16; ++r) { p0[r] = 0.f; p1[r] = 0.f; } }
#pragma unroll
            for (int d0 = 0; d0 < 4; ++d0) { const bf16x8 ka = *(const ALAS bf16x8*)(kb + kl + 32 * d0), kc = *(const ALAS bf16x8*)(kb + kl + 32 * KSTR + 32 * d0);
                p0 = __builtin_amdgcn_mfma_f32_32x32x16_bf16(ka, qr[d0], p0, 0, 0, 0); p1 = __builtin_amdgcn_mfma_f32_32x32x16_bf16(kc, qr[d0], p1, 0, 0, 0); }
            bf16x8 pb[4];
            if (MODE == 0) {
                f32x16 l0, l1; float rs = 0.f;
#pragma unroll
                for (int r = 0; r < 16; ++r) { const int key = key0 + crow(r, hi);
                    float a = -softplus2(p0[r]), b = -softplus2(p1[r]);
                    if (diag) { if (!(key < qrow)) a = 0.f; if (!(key + 32 < qrow)) b = 0.f; }
                    l0[r] = a; l1[r] = b; rs += a + b; }
                rs += __shfl_xor(rs, 32);
                const f16x8 lb0 = packh8(l0, 0), lb1 = packh8(l0, 8), lb2 = packh8(l1, 0), lb3 = packh8(l1, 8);
                f32x16 c0, c1;
#pragma unroll
                for (int r = 0; r < 16; ++r) { c0[r] = carry; c1[r] = carry; }
                c0 = __builtin_amdgcn_mfma_f32_32x32x16_f16(M0, lb0, c0, 0, 0, 0); c0 = __builtin_amdgcn_mfma_f32_32x32x16_f16(M1, lb1, c0, 0, 0, 0);
                c0 = __builtin_amdgcn_mfma_f32_32x32x16_f16(ONES, lb2, c0, 0, 0, 0); c0 = __builtin_amdgcn_mfma_f32_32x32x16_f16(ONES, lb3, c0, 0, 0, 0);
                c1 = __builtin_amdgcn_mfma_f32_32x32x16_f16(M0, lb2, c1, 0, 0, 0); c1 = __builtin_amdgcn_mfma_f32_32x32x16_f16(M1, lb3, c1, 0, 0, 0);
#pragma unroll
                for (int r = 0; r < 16; ++r) { const int key = key0 + crow(r, hi);
                    float a = __builtin_amdgcn_exp2f(p0[r] + l0[r] + c0[r]), b = __builtin_amdgcn_exp2f(p1[r] + l1[r] + c1[r]);
                    if (diag) { if (!(key < qrow)) a = 0.f; if (!(key + 32 < qrow)) b = 0.f; }
                    p0[r] = a; p1[r] = b; }
                carry += rs;
            } else {
                if (diag) {
#pragma unroll
                    for (int r = 0; r < 16; ++r) { const int key = key0 + crow(r, hi); if (key > qrow) p0[r] = -INFINITY; if (key + 32 > qrow) p1[r] = -INFINITY; } }
                float ma = __builtin_fmaxf(__builtin_fmaxf(p0[0], p0[1]), p1[0]), mb = __builtin_fmaxf(__builtin_fmaxf(p0[2], p0[3]), p1[1]);
                ma = __builtin_fmaxf(__builtin_fmaxf(ma, p1[2]), p1[3]);
#pragma unroll
                for (int r = 4; r < 16; r += 4) { ma = __builtin_fmaxf(__builtin_fmaxf(ma, p0[r]), p0[r + 1]); mb = __builtin_fmaxf(__builtin_fmaxf(mb, p0[r + 2]), p0[r + 3]);
                    ma = __builtin_fmaxf(__builtin_fmaxf(ma, p1[r]), p1[r + 1]); mb = __builtin_fmaxf(__builtin_fmaxf(mb, p1[r + 2]), p1[r + 3]); }
                float mt = __builtin_fmaxf(ma, mb); mt = __builtin_fmaxf(mt, __shfl_xor(mt, 32));
                if (!started) {
                    m = mt;
#pragma unroll
                    for (int r = 0; r < 16; ++r) { p0[r] -= mt; p1[r] -= mt; }
                    started = true;
                } else if (__any(mt > 0.f)) {
                    const float dl = __builtin_fmaxf(mt, 0.f); m += dl; const float f = __builtin_amdgcn_exp2f(-dl); l *= f; o[0] = o[0] * f; o[1] = o[1] * f;
#pragma unroll
                    for (int r = 0; r < 16; ++r) { p0[r] -= dl; p1[r] -= dl; } }
                float ls = 0.f;
#pragma unroll
                for (int r = 0; r < 16; ++r) { p0[r] = __builtin_amdgcn_exp2f(p0[r]); p1[r] = __builtin_amdgcn_exp2f(p1[r]); ls += p0[r] + p1[r]; }
                l += ls;
            }
            pb[0] = packbf8(p0, 0); pb[1] = packbf8(p0, 8); pb[2] = packbf8(p1, 0); pb[3] = packbf8(p1, 8);
            pv_tile(o, vb, vl, pb);
        }
        if (more) { *(ALAS u32x4*)(lds + (cur ^ 1) * STAGE + kdst) = kreg; *(ALAS u32x4*)(lds + (cur ^ 1) * STAGE + vdst) = vreg; }
        { bool done;
          if (MODE == 0) done = __all(carry < EXIT_T);
          else {
              const float ub = more ? qn * cum2[4096 + j - 1] + (cq - m) + cum2[64 * j - 1] : 0.f; done = started && __all(ub < EXIT_T - 2.f); }
          if (lane == 0) flags[cur * 8 + wid] = done ? 1u : 0u; }
        __syncthreads();
        { unsigned a = 1u;
#pragma unroll
            for (int w = 0; w < 8; ++w) a &= flags[cur * 8 + w];
            if (a) break; }
        cur ^= 1;
    }
    float inv = 1.f;
    if (MODE == 1) { l += __shfl_xor(l, 32); inv = 1.0f / l; }
    bf16* orow = O + (rowbase + qrow) * DM;
#pragma unroll
    for (int dh = 0; dh < 2; ++dh)
#pragma unroll
        for (int g = 0; g < 4; ++g) { u32x2 w; w.x = pk2(o[dh][4 * g] * inv, o[dh][4 * g + 1] * inv); w.y = pk2(o[dh][4 * g + 2] * inv, o[dh][4 * g + 3] * inv);
            *(u32x2*)(orow + 32 * dh + 8 * g + 4 * hi) = w; }
    __syncthreads();
}
__device__ __forceinline__ void fox_tables(ALAS float* cum2, const float* lf, const bf16* K, int pitch) {
    const int tid = threadIdx.x, lane = tid & 63, wid = tid >> 6;
    ALAS float* pm = cum2 + 4096; ALAS float* wtot = cum2 + 4096 + 64; ALAS float* kt = cum2 + 4096 + 128;
    const f32x4 a = *(const f32x4*)(lf + tid * 8), b = *(const f32x4*)(lf + tid * 8 + 4);
    float v[8] = {a[0], a[1], a[2], a[3], b[0], b[1], b[2], b[3]};
#pragma unroll
    for (int i = 1; i < 8; ++i) v[i] += v[i - 1];
    float inc = v[7];
#pragma unroll
    for (int o = 1; o < 64; o <<= 1) { const float n = __shfl_up(inc, o); if (lane >= o) inc += n; }
    if (lane == 63) wtot[wid] = inc;
    for (int it = 0; it < 64; ++it) { const int key = it * 64 + wid * 8 + (lane >> 3);
        const u32x4 kk = *(const u32x4*)(K + (size_t)key * pitch + (lane & 7) * 8);
        float s = 0.f;
#pragma unroll
        for (int q = 0; q < 4; ++q) { const float x0 = bf2f(kk[q] & 0xffff), x1 = bf2f(kk[q] >> 16); s += x0 * x0 + x1 * x1; }
        s += __shfl_xor(s, 1); s += __shfl_xor(s, 2); s += __shfl_xor(s, 4);
        s = fmaxf(s, __shfl_xor(s, 8)); s = fmaxf(s, __shfl_xor(s, 16)); s = fmaxf(s, __shfl_xor(s, 32));
        if (lane == 0) kt[it * 8 + wid] = s; }
    __syncthreads();
    float base = inc - v[7];
    for (int w = 0; w < wid; ++w) base += wtot[w];
#pragma unroll
    for (int i = 0; i < 8; ++i) cum2[tid * 8 + i] = -(v[i] + base) * LOG2E;
    if (wid == 0) { float t = 0.f;
#pragma unroll
        for (int w = 0; w < 8; ++w) t = fmaxf(t, kt[lane * 8 + w]);
#pragma unroll
        for (int o = 1; o < 64; o <<= 1) { const float n = __shfl_up(t, o); if (lane >= o) t = fmaxf(t, n); }
        pm[lane] = sqrtf(t) * 1.002f; }
    __syncthreads();
}

constexpr int RSTR = 192;
__device__ __forceinline__ void ret_pass_a(ALAS unsigned char* lds, const bf16* P  , float* loc, float* grp, int bh, int g) {
    const int tid = threadIdx.x, lane = tid & 63, r32 = lane & 31, hi = lane >> 5, wid = __builtin_amdgcn_readfirstlane(tid >> 6);
    const int b = bh >> 3, h = bh & 7; const size_t rowbase = (size_t)b * SEQ;
    const float lg2 = log2f(1.0f - exp2f(-5.0f - (float)h)); const float cd = exp2f(128.f * lg2);
    ALAS unsigned char* kt = lds; ALAS unsigned char* vt = lds + 128 * RSTR;
    const int eh = wid >> 1, dh = wid & 1;
    const int tl = (4 * hi + ((lane & 15) >> 2)) * RSTR + (16 * ((lane >> 4) & 1) + 4 * (lane & 3)) * 2;
    f32x16 R;
#pragma unroll
    for (int r = 0; r < 16; ++r) R[r] = 0.f;
    for (int j = 0; j < 4; ++j) { const int n = 4 * g + j; const size_t tok0 = rowbase + (size_t)n * 128;
#pragma unroll
        for (int i = 0; i < 2; ++i) { const int idx = tid + 512 * i, row = idx >> 3, ch = idx & 7;
            const u32x4 kk = *(const u32x4*)(P + (tok0 + row) * EW + 512 + h * 64 + ch * 8), vv = *(const u32x4*)(P + (tok0 + row) * EW + 1024 + h * 64 + ch * 8);
            const float dk = exp2f((float)(127 - row) * lg2); u32x4 kd;
            kd.x = pk2(bf2f(kk.x & 0xffff) * dk, bf2f(kk.x >> 16) * dk); kd.y = pk2(bf2f(kk.y & 0xffff) * dk, bf2f(kk.y >> 16) * dk);
            kd.z = pk2(bf2f(kk.z & 0xffff) * dk, bf2f(kk.z >> 16) * dk); kd.w = pk2(bf2f(kk.w & 0xffff) * dk, bf2f(kk.w >> 16) * dk);
            *(ALAS u32x4*)(kt + row * RSTR + ch * 16) = kd; *(ALAS u32x4*)(vt + row * RSTR + ch * 16) = vv; }
        __syncthreads();
        if (wid < 4) {
            float* lo = loc + ((size_t)bh * 32 + n) * 4096;
#pragma unroll
            for (int r = 0; r < 16; ++r) lo[(32 * eh + crow(r, hi)) * 64 + 32 * dh + r32] = R[r];
            R = R * cd;
#pragma unroll
            for (int s = 0; s < 8; ++s) { const ALAS unsigned char* va = vt + tl + (16 * s) * RSTR + eh * 64; const ALAS unsigned char* ka = kt + tl + (16 * s) * RSTR + dh * 64;
                R = __builtin_amdgcn_mfma_f32_32x32x16_bf16(vtr2(va, va + 8 * RSTR), vtr2(ka, ka + 8 * RSTR), R, 0, 0, 0); }
        }
        __syncthreads();
    }
    if (wid < 4) { float* go = grp + ((size_t)bh * 8 + g) * 4096;
#pragma unroll
        for (int r = 0; r < 16; ++r) go[(32 * eh + crow(r, hi)) * 64 + 32 * dh + r32] = R[r]; }
}
constexpr int RB_Q = 0, RB_K = 128 * KSTR, RB_G = 2 * 128 * KSTR, RB_V = 3 * 128 * KSTR, RB_S = RB_V + 128 * RSTR, RB_RED = RB_S + 64 * KSTR;
__device__ __forceinline__ void ret_pass_b(ALAS unsigned char* lds, const bf16* P, const float* loc, const float* grp, const float* retnorm, bf16* Y, int bh, int n) {
    const int tid = threadIdx.x, lane = tid & 63, r32 = lane & 31, hi = lane >> 5, wid = __builtin_amdgcn_readfirstlane(tid >> 6);
    const int b = bh >> 3, h = bh & 7; const size_t tok0 = (size_t)b * SEQ + (size_t)n * 128;
    const float lg2 = log2f(1.0f - exp2f(-5.0f - (float)h)); const float cd = exp2f(128.f * lg2), cd4 = exp2f(512.f * lg2);
    const int g = n >> 2, j = n & 3;
    { const int e = tid >> 3, d0 = (tid & 7) * 8; const size_t off = (size_t)e * 64 + d0;
      f32x4 s0 = {0.f, 0.f, 0.f, 0.f}, s1 = {0.f, 0.f, 0.f, 0.f};
      for (int gp = 0; gp < g; ++gp) { const float* gs = grp + ((size_t)bh * 8 + gp) * 4096 + off; s0 = s0 * cd4 + *(const f32x4*)gs; s1 = s1 * cd4 + *(const f32x4*)(gs + 4); }
      const float cj = exp2f(128.f * (float)j * lg2); const float* lo = loc + ((size_t)bh * 32 + n) * 4096 + off;
      s0 = s0 * cj + *(const f32x4*)lo; s1 = s1 * cj + *(const f32x4*)(lo + 4);
      u32x4 w; w.x = pk2(s0[0], s0[1]); w.y = pk2(s0[2], s0[3]); w.z = pk2(s1[0], s1[1]); w.w = pk2(s1[2], s1[3]);
      *(ALAS u32x4*)(lds + RB_S + e * KSTR + d0 * 2) = w; }
#pragma unroll
    for (int i = 0; i < 2; ++i) { const int idx = tid + 512 * i, row = idx >> 3, ch = idx & 7; const bf16* src = P + (tok0 + row) * EW + h * 64 + ch * 8;
        *(ALAS u32x4*)(lds + RB_Q + row * KSTR + ch * 16) = *(const u32x4*)src; *(ALAS u32x4*)(lds + RB_K + row * KSTR + ch * 16) = *(const u32x4*)(src + 512);
        *(ALAS u32x4*)(lds + RB_V + row * RSTR + ch * 16) = *(const u32x4*)(src + 1024); *(ALAS u32x4*)(lds + RB_G + row * KSTR + ch * 16) = *(const u32x4*)(src + 1536); }
    __syncthreads();
    const int qb = wid & 3, eh = wid >> 2, qloc = 32 * qb + r32;
    const int tl = (4 * hi + ((lane & 15) >> 2)) * RSTR + (16 * ((lane >> 4) & 1) + 4 * (lane & 3)) * 2;
    bf16x8 qf[4];
#pragma unroll
    for (int d0 = 0; d0 < 4; ++d0) qf[d0] = *(const ALAS bf16x8*)(lds + RB_Q + qloc * KSTR + 32 * d0 + 16 * hi);
    float dloc[16];
#pragma unroll
    for (int r = 0; r < 16; ++r) dloc[r] = exp2f((float)(r32 - crow(r, hi)) * lg2);
    f32x16 ain, acr;
#pragma unroll
    for (int r = 0; r < 16; ++r) { ain[r] = 0.f; acr[r] = 0.f; }
    for (int kt = 0; kt <= qb; ++kt) {
        f32x16 s;
#pragma unroll
        for (int r = 0; r < 16; ++r) s[r] = 0.f;
#pragma unroll
        for (int d0 = 0; d0 < 4; ++d0) s = __builtin_amdgcn_mfma_f32_32x32x16_bf16(*(const ALAS bf16x8*)(lds + RB_K + (32 * kt + r32) * KSTR + 32 * d0 + 16 * hi), qf[d0], s, 0, 0, 0);
        const float fac = exp2f(32.f * (float)(qb - kt) * lg2);
#pragma unroll
        for (int r = 0; r < 16; ++r) { float v = s[r] * (dloc[r] * fac); if (kt == qb && crow(r, hi) > r32) v = 0.f; s[r] = v; }
        const bf16x8 pb0 = packbf8(s, 0), pb1 = packbf8(s, 8);
        const ALAS unsigned char* va = lds + RB_V + tl + (32 * kt) * RSTR + eh * 64;
        ain = __builtin_amdgcn_mfma_f32_32x32x16_bf16(vtr2(va, va + 8 * RSTR), pb0, ain, 0, 0, 0);
        ain = __builtin_amdgcn_mfma_f32_32x32x16_bf16(vtr2(va + 16 * RSTR, va + 24 * RSTR), pb1, ain, 0, 0, 0);
    }
#pragma unroll
    for (int d0 = 0; d0 < 4; ++d0) acr = __builtin_amdgcn_mfma_f32_32x32x16_bf16(*(const ALAS bf16x8*)(lds + RB_S + (32 * eh + r32) * KSTR + 32 * d0 + 16 * hi), qf[d0], acr, 0, 0, 0);
    const float qd = exp2f((float)(qloc + 1) * lg2);
    float s1 = 0.f, s2 = 0.f;
#pragma unroll
    for (int r = 0; r < 16; ++r) { const float v = ain[r] + qd * acr[r]; ain[r] = v; s1 += v; s2 += v * v; }
    s1 += __shfl_xor(s1, 32); s2 += __shfl_xor(s2, 32);
    ALAS float* red = (ALAS float*)(lds + RB_RED);
    if (hi == 0) { red[(wid * 32 + r32) * 2] = s1; red[(wid * 32 + r32) * 2 + 1] = s2; }
    __syncthreads();
    { const int pw = wid ^ 4; s1 += red[(pw * 32 + r32) * 2]; s2 += red[(pw * 32 + r32) * 2 + 1]; }
    const float mu = s1 * (1.f / 64.f); const float var = fmaxf(s2 * (1.f / 64.f) - mu * mu, 0.f); const float rstd = 1.0f / sqrtf(var + GN_EPS);
    bf16* yrow = Y + (tok0 + qloc) * DM + h * 64 + 32 * eh;
#pragma unroll
    for (int gq = 0; gq < 4; ++gq) { const int e0 = 8 * gq + 4 * hi;
        const u32x2 gv = *(const ALAS u32x2*)(lds + RB_G + qloc * KSTR + (32 * eh + e0) * 2); const f32x4 rn = *(const f32x4*)(retnorm + h * 64 + 32 * eh + e0);
        const float g0 = bf2f(gv.x & 0xffff), g1 = bf2f(gv.x >> 16), g2 = bf2f(gv.y & 0xffff), g3 = bf2f(gv.y >> 16);
        u32x2 w; w.x = pk2((ain[4 * gq] - mu) * rstd * rn[0] * silu_f(g0), (ain[4 * gq + 1] - mu) * rstd * rn[1] * silu_f(g1));
        w.y = pk2((ain[4 * gq + 2] - mu) * rstd * rn[2] * silu_f(g2), (ain[4 * gq + 3] - mu) * rstd * rn[3] * silu_f(g3));
        *(u32x2*)(yrow + e0) = w; }
    __syncthreads();
}
#undef ALAS
}
#define LAS __attribute__((address_space(3)))
#define XB_TMO      128
#define XB_XCNT(j)  (256  + 64 * (j))
#define XB_XSUB(j)  (1280 + 64 * (j))
#define XB_XGEN(j)  (2304 + 64 * (j))
#define XB_TOP      3328
#define XB_TOPGEN   3392
#define XCD_BAR_WORDS 3456
#define XB_SPIN_CAP (1u << 23)
__device__ __forceinline__ unsigned xb_ld(unsigned* p)              { return __hip_atomic_load(p, __ATOMIC_RELAXED, __HIP_MEMORY_SCOPE_AGENT); }
__device__ __forceinline__ unsigned xb_add(unsigned* p, unsigned v) { return __hip_atomic_fetch_add(p, v, __ATOMIC_RELAXED, __HIP_MEMORY_SCOPE_AGENT); }
__device__ __forceinline__ unsigned xb_xcc_id() { return (unsigned)__builtin_amdgcn_s_getreg((3 << 11) | 20) & 0xFu; }
#define XB_SPIN(cond, bar) do { unsigned _sp = 0; while (cond) { __builtin_amdgcn_s_sleep(1); \
    if ((++_sp & 255u) == 0u) { if (xb_ld(&(bar)[XB_TMO])) break; if (_sp > XB_SPIN_CAP) { atomicAdd(&(bar)[XB_TMO], 1u); break; } } } } while (0)
struct XcdBarrier { unsigned* bar; unsigned x; volatile LAS unsigned* st; };
__device__ __forceinline__ XcdBarrier xcd_barrier_post(unsigned* bar, volatile LAS unsigned* st) {
    XcdBarrier b; b.bar = bar; b.x = xb_xcc_id(); b.st = st;
    if (threadIdx.x == 0) (void)xb_add(&bar[XB_XCNT(b.x)], 1u);
    return b;
}
__device__ __forceinline__ void xcd_barrier_complete(unsigned* bar, unsigned x, unsigned& nloc, unsigned& nx) {
    const unsigned G = gridDim.x * gridDim.y * gridDim.z;
    unsigned sum, cnt, mine, sp = 0u;
    for (;;) {
        sum = 0u; cnt = 0u; mine = 0u;
#pragma unroll
        for (unsigned j = 0; j < 16; ++j) { const unsigned c = xb_ld(&bar[XB_XCNT(j)]); sum += c; cnt += (c > 0u) ? 1u : 0u; mine = (j == x) ? c : mine; }
        if (sum == G) break;
        __builtin_amdgcn_s_sleep(1);
        if ((++sp & 255u) == 0u) { if (xb_ld(&bar[XB_TMO])) break; if (sp > XB_SPIN_CAP) { atomicAdd(&bar[XB_TMO], 1u); break; } }
    }
    nloc = mine > 0u ? mine : 1u; nx = cnt > 0u ? cnt : 1u;
}
__device__ __forceinline__ void xcd_barrier(const XcdBarrier& b) {
    asm volatile("s_waitcnt vmcnt(0)" ::: "memory");
    __syncthreads();
    if (threadIdx.x == 0) {
        unsigned* bar = b.bar;
        __builtin_amdgcn_s_waitcnt(0);
        unsigned nloc = b.st[0], nx = b.st[1];
        if (nloc == 0u) { xcd_barrier_complete(bar, b.x, nloc, nx); b.st[0] = nloc; b.st[1] = nx; }
        const unsigned old = xb_add(&bar[XB_XSUB(b.x)], 1u);
        const unsigned gen = old / nloc;
        if (old + 1u == (gen + 1u) * nloc) {
            __builtin_amdgcn_fence(__ATOMIC_RELEASE, "agent");
            asm volatile("s_waitcnt vmcnt(0)" ::: "memory");
            const unsigned og = xb_add(&bar[XB_TOP], 1u);
            const unsigned tg = og / nx;
            if (og + 1u == (tg + 1u) * nx) xb_add(&bar[XB_TOPGEN], 1u);
            else XB_SPIN(xb_ld(&bar[XB_TOPGEN]) == tg, bar);
            __builtin_amdgcn_fence(__ATOMIC_ACQUIRE, "agent");
            xb_add(&bar[XB_XGEN(b.x)], 1u);
            asm volatile("s_waitcnt vmcnt(0)" ::: "memory");
        } else {
            XB_SPIN(xb_ld(&bar[XB_XGEN(b.x)]) == gen, bar);
            __builtin_amdgcn_fence(__ATOMIC_ACQUIRE, "agent");
            asm volatile("s_waitcnt vmcnt(0)" ::: "memory");
        }
    }
    __syncthreads();
}

constexpr int NWAVES = 8, NTHR = NWAVES * 64;
constexpr int RING_BYTES = 131072, LDS_BYTES = 147456, MISC_OFF = LDS_BYTES - 256;
constexpr int NPHASE = 16;

__device__ __forceinline__ void mixer_even_simple(unsigned char* ws, const float* retnorm, int gw, int ngw, int lane) {
    const bf16* P = (const bf16*)(ws + WS_BIG); bf16* Y = (bf16*)(ws + WS_X0);
    for (int idx = gw; idx < BATCH * 8 * SEQ; idx += ngw) {
        const int t = idx & (SEQ - 1), h = (idx >> 12) & 7, b = idx >> 15; const size_t rb = (size_t)b * SEQ;
        { const float lg2 = log2f(1.0f - exp2f(-5.0f - (float)h));
          const float q = bf2f(P[(rb + t) * EW + h * 64 + lane]); float o = 0.f;
          for (int s = 0; s <= t; ++s) { const float k = bf2f(P[(rb + s) * EW + 512 + h * 64 + lane]), v = bf2f(P[(rb + s) * EW + 1024 + h * 64 + lane]);
              o += exp2f(lg2 * (float)(t - s)) * wave_sum(q * k) * v; }
          const float mu = wave_sum(o) * (1.f / 64.f); const float dv = o - mu; const float var = wave_sum(dv * dv) * (1.f / 64.f);
          const float g = bf2f(P[(rb + t) * EW + 1536 + h * 64 + lane]);
          Y[(rb + t) * DM + h * 64 + lane] = (bf16)f2bf(dv * (1.0f / sqrtf(var + GN_EPS)) * retnorm[h * 64 + lane] * silu_f(g)); }
        { const float q = bf2f(P[(rb + t) * EW + 2048 + h * 64 + lane]); float o = 0.f, carry = 0.f;
          for (int s = t - 1; s >= 0; --s) { const float k = bf2f(P[(rb + s) * EW + 2560 + h * 64 + lane]), v = bf2f(P[(rb + s) * EW + 3072 + h * 64 + lane]);
              const float y = wave_sum(q * k); const float lf2 = -softplus2(y); o += __builtin_amdgcn_exp2f(y + lf2 + carry) * v; carry += lf2; }
          Y[(rb + t) * DM + 512 + h * 64 + lane] = (bf16)f2bf(o); }
    }
}
__device__ __forceinline__ void fox_simple(unsigned char* ws, LAS float* cum, int vcu, int wave, int lane) {
    const bf16* P = (const bf16*)(ws + WS_BIG); bf16* Y = (bf16*)(ws + WS_X0);
    const int bh = vcu >> 1, b = bh >> 4, h = bh & 15; const size_t rb = (size_t)b * SEQ;
    const float* lf = (const float*)(ws + WS_LOGF) + (size_t)bh * SEQ;
    if (wave == 0) { float run = 0.f;
        for (int j = 0; j < 64; ++j) run += lf[lane * 64 + j];
        float inc = run;
#pragma unroll
        for (int o = 1; o < 64; o <<= 1) { const float n = __shfl_up(inc, o); if (lane >= o) inc += n; }
        float acc = inc - run;
        for (int j = 0; j < 64; ++j) { acc += lf[lane * 64 + j]; cum[lane * 64 + j] = acc; } }
    __syncthreads();
    for (int t = (vcu & 1) + 2 * wave; t < SEQ; t += 16) {
        const float q = bf2f(P[(rb + t) * QKVW + h * 64 + lane]); const float ct = cum[t]; float m = -INFINITY, l = 0.f, o = 0.f;
        for (int s = 0; s <= t; ++s) { const float k = bf2f(P[(rb + s) * QKVW + 1024 + h * 64 + lane]), v = bf2f(P[(rb + s) * QKVW + 2048 + h * 64 + lane]);
            const float x = wave_sum(q * k) + (ct - cum[s]) * LOG2E;
            if (x > m) { const float f = __builtin_amdgcn_exp2f(m - x); l *= f; o *= f; m = x; }
            const float pr = __builtin_amdgcn_exp2f(x - m); l += pr; o += pr * v; }
        Y[(rb + t) * DM + h * 64 + lane] = (bf16)f2bf(o / l); }
    __syncthreads();
}
__device__ __forceinline__ void router_phase(unsigned char* ws, const float* hres, LAS unsigned* rl, int vcu, int wave, int lane) {
    unsigned* ctl = (unsigned*)(ws + WS_CTL); const int tid = threadIdx.x;
    LAS unsigned* lcnt = rl; LAS unsigned* lbase = rl + 16; LAS int* tinfo = (LAS int*)(rl + 32); LAS float* tg = (LAS float*)(rl + 32 + 256); LAS unsigned* tpos = rl + 32 + 512;
    if (tid < 16) lcnt[tid] = 0u;
    __syncthreads();
    const float* part4 = (const float*)(ws + WS_PART) + (size_t)2 * T * 16; const float* RW = (const float*)(ws + WS_ROUTW); float* rstd4 = (float*)(ws + WS_RSTD4);
    f32x4 rw[NEXP][4];
#pragma unroll
    for (int e = 0; e < NEXP; ++e)
#pragma unroll
        for (int j = 0; j < 4; ++j) rw[e][j] = *((const f32x4*)(RW + e * DM) + lane + 64 * j);
    for (int i0 = 0; i0 < 16; i0 += 4) {
        f32x4 v[4][4]; float ps[4];
#pragma unroll
        for (int q = 0; q < 4; ++q) { const int row = vcu * 128 + wave * 16 + i0 + q; const f32x4* xr = (const f32x4*)(hres + (size_t)row * DM) + lane;
#pragma unroll
            for (int j = 0; j < 4; ++j) v[q][j] = xr[64 * j];
            ps[q] = (lane < 16) ? part4[(size_t)row * 16 + lane] : 0.f; }
#pragma unroll
        for (int q = 0; q < 4; ++q) { const int lt = wave * 16 + i0 + q, row = vcu * 128 + lt; float lg[NEXP];
#pragma unroll
            for (int e = 0; e < NEXP; ++e) { float s = 0.f;
#pragma unroll
                for (int j = 0; j < 4; ++j) s += (v[q][j][0] * rw[e][j][0] + v[q][j][1] * rw[e][j][1]) + (v[q][j][2] * rw[e][j][2] + v[q][j][3] * rw[e][j][3]);
                lg[e] = wave_sum(s); }
            float ss = 0.f;
#pragma unroll
            for (int k = 0; k < 16; ++k) ss += __shfl(ps[q], k);
            const float rstd = 1.0f / sqrtf(ss * (1.f / DM) + NORM_EPS);
            int b1 = 0; float v1 = lg[0];
#pragma unroll
            for (int e = 1; e < NEXP; ++e) if (lg[e] > v1) { v1 = lg[e]; b1 = e; }
            int b2 = -1; float v2 = -INFINITY;
#pragma unroll
            for (int e = 0; e < NEXP; ++e) if (e != b1 && lg[e] > v2) { v2 = lg[e]; b2 = e; }
            if (b2 < 0) b2 = (b1 + 1) & 7;
            const float g1 = 1.f / (1.f + __expf((v2 - v1) * rstd)), g2 = 1.f - g1;
            if (lane == 0) { rstd4[row] = rstd; tinfo[lt * 2] = b1; tinfo[lt * 2 + 1] = b2; tg[lt * 2] = g1; tg[lt * 2 + 1] = g2;
                tpos[lt * 2] = __hip_atomic_fetch_add(&lcnt[b1], 1u, __ATOMIC_RELAXED, __HIP_MEMORY_SCOPE_WORKGROUP); tpos[lt * 2 + 1] = __hip_atomic_fetch_add(&lcnt[8 + b2], 1u, __ATOMIC_RELAXED, __HIP_MEMORY_SCOPE_WORKGROUP); } }
    }
    __syncthreads();
    if (tid < 16) lbase[tid] = __hip_atomic_fetch_add(&ctl[CW_CNT + 64 * tid], lcnt[tid], __ATOMIC_RELAXED, __HIP_MEMORY_SCOPE_AGENT);
    __syncthreads();
    if (tid < 256) { const int lt = tid >> 1, c = tid & 1, e = tinfo[tid]; const unsigned pos = lbase[c * 8 + e] + tpos[tid];
        ((int*)(ws + WS_LIST))[(size_t)(c * 8 + e) * T + pos] = vcu * 128 + lt; ((float*)(ws + WS_GATE))[(size_t)(c * 8 + e) * T + pos] = tg[tid]; }
    __syncthreads();
}

typedef const __attribute__((address_space(4))) Params* KParams;
__device__ __forceinline__ KParams kargs() { unsigned long long v = (unsigned long long)__builtin_amdgcn_kernarg_segment_ptr(); asm volatile("" : "+s"(v)); return (KParams)v; }
__global__ void __launch_bounds__(NTHR, 2) mega_fwd(Params p_unused) {
    extern __shared__ __attribute__((aligned(16))) unsigned char lds_raw[];
    LAS unsigned char* lds = (LAS unsigned char*)lds_raw;
    const int tid = threadIdx.x, lane = tid & 63, wave = __builtin_amdgcn_readfirstlane(tid >> 6);
    if (tid < 64) ((LAS unsigned*)(lds + MISC_OFF))[tid] = 0u;
    __syncthreads();
    XcdBarrier bar = xcd_barrier_post((unsigned*)(kargs()->ws + WS_CTL) + CW_BAR + kargs()->li * XCD_BAR_WORDS, (volatile LAS unsigned*)(lds + MISC_OFF) + 8);
#ifndef PH_MASK
#define PH_MASK 0xffff
#endif
#define IN(k) (((PH_MASK >> (k)) & 1) && kargs()->ph_lo <= (k) && (k) < kargs()->ph_hi)
#ifdef PROBE_PH
#define SEAM(k) do { if ((k) == PROBE_PH && threadIdx.x == 0) { const unsigned busy_ = (unsigned)(__builtin_amdgcn_s_memrealtime() - pr_last); unsigned* pw_ = (unsigned*)(kargs()->ws + WS_CTL) + 2048; \
        __hip_atomic_fetch_max(pw_, busy_, __ATOMIC_RELAXED, __HIP_MEMORY_SCOPE_AGENT); __hip_atomic_fetch_min(pw_ + 64, ~busy_, __ATOMIC_RELAXED, __HIP_MEMORY_SCOPE_AGENT); __hip_atomic_fetch_max(pw_ + 128, ~busy_, __ATOMIC_RELAXED, __HIP_MEMORY_SCOPE_AGENT); } \
    if (IN(k) && IN((k) + 1)) xcd_barrier(bar); \
    if (threadIdx.x == 0) { const unsigned long long now_ = __builtin_amdgcn_s_memrealtime(); if ((k) == PROBE_PH && blockIdx.x == 0) { LAS unsigned* pl_ = (LAS unsigned*)(lds + LDS_BYTES - 128); unsigned* pw_ = (unsigned*)(kargs()->ws + WS_CTL) + 2048; \
        pl_[2] = (unsigned)(now_ - pr_last); pl_[3] = __hip_atomic_load(pw_, __ATOMIC_RELAXED, __HIP_MEMORY_SCOPE_AGENT); pl_[4] = ~__hip_atomic_load(pw_ + 128, __ATOMIC_RELAXED, __HIP_MEMORY_SCOPE_AGENT); } pr_last = now_; } } while (0)
#else
#define SEAM(k) do { if (IN(k) && IN((k) + 1)) xcd_barrier(bar); } while (0)
#endif
#define GRID_VARS const int G = gridDim.x, bx = blockIdx.x; const int vcu = (G % 8 == 0) ? (bx % 8) * (G / 8) + bx / 8 : bx; const int gw = vcu * NWAVES + wave, ngw = G * NWAVES; (void)gw; (void)ngw; (void)vcu; \
    KParams kp = kargs(); unsigned char* ws = kp->ws; (void)ws

#ifdef PROBE_PH
    unsigned long long pr_last = __builtin_amdgcn_s_memrealtime();
#endif
    if (IN(0)) { GRID_VARS; Params p; for (int i = 0; i < 19; ++i) p.in[i] = kp->in[i]; p.out = kp->out; p.ws = ws; p.ph_lo = 0; p.ph_hi = 0; p.li = 0; p.pad = 0;
        prologue_weights(p, (LAS float*)(lds + wave * TR_SCR_BYTES), gw, ngw, lane);
        prologue_small(p, bx * NTHR + tid, G * NTHR);
        const float* x = kp->in[0]; bf16* X0 = (bf16*)(ws + WS_X0);
        for (int m = gw; m < T; m += ngw) rms_row_to_bf16(x + (size_t)m * DM, X0 + (size_t)m * DM, lane);
    }
    SEAM(0);
    if (IN(1)) { GRID_VARS; pg8::ProbDense P{(const bf16*)(ws + WS_X0), (const bf16*)(ws + WS_W_IN_E), DM}; pg8::StaticOrder S; S.init(T / 256, EW / 256, G, bx);
        pg8::EpiInEven E{(bf16*)(ws + WS_BIG), (const float2*)(ws + WS_ROPE)}; pg8::gemm_phase(lds, P, S, E, 1); }
    SEAM(1);
#ifdef MIX_SIMPLE
    if (IN(2)) { GRID_VARS; mixer_even_simple(ws, kp->in[3], gw, ngw, lane); }
    SEAM(2);
    SEAM(3);
#else
    if (IN(2)) { GRID_VARS; const bf16* Pj = (const bf16*)(ws + WS_BIG); float* loc = kp->out; float* grp = kp->out + (size_t)8 * 1024 * 1024;
        for (int k = 0; k < 2; ++k) { const int u = vcu + 256 * k; att::ret_pass_a(lds, Pj, loc, grp, u >> 3, u & 7); }
        for (int k = 0; k < 2; ++k) { const int u = vcu + 256 * k, bh = u >> 4, qb = u & 15, h = bh & 7;
            att::unit<0>(lds, Pj + 2048 + h * 64, Pj + 2560 + h * 64, Pj + 3072 + h * 64, EW, (bf16*)(ws + WS_X0) + 512 + h * 64, (size_t)(bh >> 3) * SEQ, qb * 256, nullptr); } }
    SEAM(2);
    if (IN(3)) { GRID_VARS; const bf16* Pj = (const bf16*)(ws + WS_BIG); const float* loc = kp->out; const float* grp = kp->out + (size_t)8 * 1024 * 1024; const float* rn = kp->in[3];
        for (int k = 0; k < 8; ++k) { const int u = vcu + 256 * k; att::ret_pass_b(lds, Pj, loc, grp, rn, (bf16*)(ws + WS_X0), u >> 5, u & 31); }
        for (int k = 2; k < 4; ++k) { const int u = vcu + 256 * k, bh = u >> 4, qb = u & 15, h = bh & 7;
            att::unit<0>(lds, Pj + 2048 + h * 64, Pj + 2560 + h * 64, Pj + 3072 + h * 64, EW, (bf16*)(ws + WS_X0) + 512 + h * 64, (size_t)(bh >> 3) * SEQ, qb * 256, nullptr); } }
    SEAM(3);
#endif
    if (IN(4)) { GRID_VARS; pg8::ProbDense P{(const bf16*)(ws + WS_X0), (const bf16*)(ws + WS_W_OUT_E), DM}; pg8::StaticOrder S; S.init(T / 256, DM / 256, G, bx);
        pg8::EpiResid E{kp->in[0], kp->out, (bf16*)(ws + WS_BIG), (float*)(ws + WS_PART)}; pg8::gemm_phase(lds, P, S, E, 4); }
    SEAM(4);
    if (IN(5)) { GRID_VARS; pg8::ProbDense P{(const bf16*)(ws + WS_BIG), (const bf16*)(ws + WS_W_GU_E), DM}; pg8::StaticOrder S; S.init(T / 256, GU / 256, G, bx);
        pg8::EpiGU E{(bf16*)(ws + WS_HID), (const float*)(ws + WS_PART)}; pg8::gemm_phase(lds, P, S, E, 5); }
    SEAM(5);
    if (IN(6)) { GRID_VARS; pg8::ProbDense P{(const bf16*)(ws + WS_HID), (const bf16*)(ws + WS_W_DN_E), DFF}; pg8::StaticOrder S; S.init(T / 256, DM / 256, G, bx);
        pg8::EpiResid E{kp->out, kp->out, (bf16*)(ws + WS_X0), (float*)(ws + WS_PART) + (size_t)T * 16}; pg8::gemm_phase(lds, P, S, E, 6); }
    SEAM(6);
    if (IN(7)) { GRID_VARS; pg8::ProbDense P{(const bf16*)(ws + WS_X0), (const bf16*)(ws + WS_W_IN_O), DM}; pg8::StaticOrder S; S.init(T / 256, OWP / 256, G, bx);
        pg8::EpiInOdd E{(bf16*)(ws + WS_BIG), (const float*)(ws + WS_PART) + (size_t)T * 16, kp->in[11], (float*)(ws + WS_LOGF)}; pg8::gemm_phase(lds, P, S, E, 7); }
    SEAM(7);
#ifdef FOX_SIMPLE
    if (IN(8)) { GRID_VARS; fox_simple(ws, (LAS float*)lds, vcu, wave, lane); }
#else
    if (IN(8)) { GRID_VARS; const bf16* Pj = (const bf16*)(ws + WS_BIG); const int bh = vcu >> 1, h = bh & 15;
        LAS float* cum2 = (LAS float*)(lds + att::CUM_OFF);
        att::fox_tables(cum2, (const float*)(ws + WS_LOGF) + (size_t)bh * SEQ, Pj + (size_t)(bh >> 4) * SEQ * QKVW + 1024 + h * 64, QKVW);
        for (int k = 0; k < 8; ++k) { const int s = 4 * (vcu & 1) + (k >> 1), qb = (k & 1) ? 15 - s : s;
            att::unit<1>(lds, Pj + h * 64, Pj + 1024 + h * 64, Pj + 2048 + h * 64, QKVW, (bf16*)(ws + WS_X0) + h * 64, (size_t)(bh >> 4) * SEQ, qb * 256, cum2); } }
#endif
    SEAM(8);
    if (IN(9)) { GRID_VARS; pg8::ProbDense P{(const bf16*)(ws + WS_X0), (const bf16*)(ws + WS_W_OUT_O), DM}; pg8::StaticOrder S; S.init(T / 256, DM / 256, G, bx);
        pg8::EpiResid E{kp->out, kp->out, (bf16*)(ws + WS_BIG), (float*)(ws + WS_PART) + (size_t)2 * T * 16}; pg8::gemm_phase(lds, P, S, E, 9); }
    SEAM(9);
    if (IN(10)) { GRID_VARS; if (G == 256) router_phase(ws, kp->out, (LAS unsigned*)lds, vcu, wave, lane); }
    SEAM(10);
#define MOE_PASS(c) do { \
        if (IN(11 + 2 * c)) { GRID_VARS; const unsigned* ctl = (const unsigned*)(ws + WS_CTL); int ntile = 0; \
        _Pragma("unroll") \
            for (int e = 0; e < 8; ++e) ntile += ((int)ctl[CW_CNT + 64 * (c * 8 + e)] + 255) >> 8; \
            pg8::ProbMoeGU P{(const bf16*)(ws + WS_BIG), (const bf16*)(ws + WS_W_GU_M), DM, (size_t)GU * DM * 2, ctl, c, (const int*)(ws + WS_LIST)}; pg8::StaticOrder S; S.init(ntile, GU / 256, G, bx); \
            pg8::EpiMoeGU E{(bf16*)(ws + WS_HID), (const float*)(ws + WS_RSTD4), ctl, c, (const int*)(ws + WS_LIST)}; pg8::gemm_phase(lds, P, S, E, 11 + 2 * c); } \
        SEAM(11 + 2 * c); \
        if (IN(12 + 2 * c)) { GRID_VARS; const unsigned* ctl = (const unsigned*)(ws + WS_CTL); int ntile = 0; \
        _Pragma("unroll") \
            for (int e = 0; e < 8; ++e) ntile += ((int)ctl[CW_CNT + 64 * (c * 8 + e)] + 255) >> 8; \
            pg8::ProbMoeDown P{(const bf16*)(ws + WS_HID), (const bf16*)(ws + WS_W_DN_M), DFF, (size_t)DM * DFF * 2, ctl, c}; pg8::StaticOrder S; S.init(ntile, DM / 256, G, bx); \
            pg8::EpiMoeDown E{kp->out, ctl, c, (const int*)(ws + WS_LIST), (const float*)(ws + WS_GATE)}; pg8::gemm_phase(lds, P, S, E, 12 + 2 * c); } \
        SEAM(12 + 2 * c); \
    } while (0)
    MOE_PASS(0);
    MOE_PASS(1);
#undef MOE_PASS
    if (IN(15)) { GRID_VARS; float* out = kp->out; const float* fg = kp->in[18]; for (int m = gw; m < T; m += ngw) final_norm_row(out + (size_t)m * DM, fg, lane); }
#ifdef PROBE_PH
    if (blockIdx.x == 0 && threadIdx.x == 0) { const unsigned v = ((LAS unsigned*)(lds + LDS_BYTES - 128))[PROBE_SEL]; const unsigned long long t0 = __builtin_amdgcn_s_memrealtime();
        while (__builtin_amdgcn_s_memrealtime() - t0 < (unsigned long long)v * 16ull) __builtin_amdgcn_s_sleep(8); }
#endif
#undef IN
#undef SEAM
#undef GRID_VARS
}

#ifndef MK_N_LAUNCHES
#define MK_N_LAUNCHES 1
#endif
extern "C" void kernel_launch(void* const* d_in, const int* in_sizes, int n_in, void* d_out, int out_size, void* d_ws, size_t ws_size, hipStream_t stream) {
    static int grid = 0;
    if (grid == 0) {
        if (n_in != 19 || out_size != T * DM || ws_size < WS_END) { fprintf(stderr, "kernel_launch: unexpected shapes (n_in %d out %d ws %zu)\n", n_in, out_size, ws_size); grid = -1; return; }
        int dev = 0, cus = 0, per_cu = 0;
        if (hipGetDevice(&dev) != hipSuccess || hipDeviceGetAttribute(&cus, hipDeviceAttributeMultiprocessorCount, dev) != hipSuccess) { grid = -1; return; }
        if (hipFuncSetAttribute((const void*)mega_fwd, hipFuncAttributeMaxDynamicSharedMemorySize, LDS_BYTES) != hipSuccess) { fprintf(stderr, "kernel_launch: hipFuncSetAttribute failed\n"); grid = -1; return; }
        if (hipOccupancyMaxActiveBlocksPerMultiprocessor(&per_cu, (const void*)mega_fwd, NTHR, LDS_BYTES) != hipSuccess || per_cu < 1) { fprintf(stderr, "kernel_launch: occupancy query says %d\n", per_cu); }
        (void)hipGetLastError();
        grid = cus;
        if (grid != 256) fprintf(stderr, "kernel_launch: %d CUs; the router phase assumes 256\n", grid);
    }
    if (grid < 0) return;
    (void)in_sizes;
    if (hipMemsetAsync((char*)d_ws + WS_CTL, 0, CTL_BYTES, stream) != hipSuccess) return;
    Params p{};
    for (int i = 0; i < 19; ++i) p.in[i] = (const float*)d_in[i];
    p.out = (float*)d_out; p.ws = (unsigned char*)d_ws;
#if defined(EXP_PHASE)
    p.ph_lo = 0; p.ph_hi = EXP_PHASE + 1; p.li = 0; hipLaunchKernelGGL(mega_fwd, dim3(grid), dim3(NTHR), LDS_BYTES, stream, p);
    p.ph_lo = EXP_PHASE; p.ph_hi = EXP_PHASE + 1; p.li = 1; hipLaunchKernelGGL(mega_fwd, dim3(grid), dim3(NTHR), LDS_BYTES, stream, p);
    p.ph_lo = EXP_PHASE + 1; p.ph_hi = NPHASE; p.li = 2; hipLaunchKernelGGL(mega_fwd, dim3(grid), dim3(NTHR), LDS_BYTES, stream, p);
#elif MK_N_LAUNCHES == 1
    p.ph_lo = 0; p.ph_hi = NPHASE; p.li = 0;
    hipLaunchKernelGGL(mega_fwd, dim3(grid), dim3(NTHR), LDS_BYTES, stream, p);
#else
    for (int k = 0; k < NPHASE; ++k) { p.ph_lo = k; p.ph_hi = k + 1; p.li = 0; hipLaunchKernelGGL(mega_fwd, dim3(grid), dim3(NTHR), LDS_BYTES, stream, p); }
#endif
}
```

```cpp
#include <hip/hip_runtime.h>
#include <cstdio>
#include <cstdint>

constexpr int DM = 1024, BATCH = 8, SEQ = 4096, T = BATCH * SEQ;
constexpr int HD = 64;
constexpr int EW = 3584;
constexpr int OW = 3088, OWP = 3328;
constexpr int QKVW = 3072;
constexpr int DFF = 2816, NEXP = 8, GU = 2 * DFF;
constexpr float NORM_EPS = 1e-6f, GN_EPS = 1e-5f;
constexpr float LOG2E = 1.4426950408889634f;
constexpr float C2 = 0.125f * LOG2E;
constexpr int MOE_MAXT = 136;

constexpr size_t MiB = 1u << 20;
constexpr size_t WS_CTL = 0, CTL_BYTES = 2 * MiB;
constexpr size_t WS_ROPE = 2 * MiB;
constexpr size_t WS_ROUTW = 3 * MiB;
constexpr size_t WS_RSTD4 = 3 * MiB + 65536;
constexpr size_t WS_LIST = 4 * MiB;
constexpr size_t WS_GATE = 6 * MiB;
constexpr size_t WS_PART = 8 * MiB;
constexpr size_t WS_LOGF = 14 * MiB;
constexpr size_t WS_CUM = 16 * MiB;
constexpr size_t WS_W = 18 * MiB;
constexpr size_t WS_W_IN_E = WS_W;
constexpr size_t WS_W_OUT_E = WS_W_IN_E + (size_t)EW * DM * 2;
constexpr size_t WS_W_GU_E = WS_W_OUT_E + (size_t)DM * DM * 2;
constexpr size_t WS_W_DN_E = WS_W_GU_E + (size_t)GU * DM * 2;
constexpr size_t WS_W_IN_O = WS_W_DN_E + (size_t)DM * DFF * 2;
constexpr size_t WS_W_OUT_O = WS_W_IN_O + (size_t)OWP * DM * 2;
constexpr size_t WS_W_GU_M = WS_W_OUT_O + (size_t)DM * DM * 2;
constexpr size_t WS_W_DN_M = WS_W_GU_M + (size_t)NEXP * GU * DM * 2;
constexpr size_t WS_W_END = WS_W_DN_M + (size_t)NEXP * DM * DFF * 2;
constexpr size_t WS_X0 = 184 * MiB;
constexpr size_t WS_BIG = 248 * MiB;
constexpr size_t WS_HID = WS_BIG + 64 * MiB;
constexpr size_t WS_END = WS_BIG + 251 * MiB;
static_assert(WS_W_END <= WS_X0 && WS_END <= 512 * MiB, "ws map");
static_assert(WS_HID + (size_t)MOE_MAXT * 256 * DFF * 2 <= WS_END, "hidden fits");
constexpr int CW_CNT = 64;
constexpr int CW_BAR = 4096;

typedef unsigned short bf16;
typedef short bf16x8 __attribute__((ext_vector_type(8)));
typedef float f32x4 __attribute__((ext_vector_type(4)));
typedef float f32x16 __attribute__((ext_vector_type(16)));
typedef unsigned u32x4 __attribute__((ext_vector_type(4)));
typedef unsigned u32x2 __attribute__((ext_vector_type(2)));

struct Params { const float* in[19]; float* out; unsigned char* ws; int ph_lo, ph_hi, li, pad; };

__device__ __forceinline__ unsigned f2bf(float f) { unsigned u = __builtin_bit_cast(unsigned, f); return (u + 0x7fffu + ((u >> 16) & 1u)) >> 16; }
typedef float f32x2_t __attribute__((ext_vector_type(2))); typedef __bf16 bf16x2_t __attribute__((ext_vector_type(2)));
__device__ __forceinline__ unsigned pk2(float lo, float hi) { const f32x2_t v = {lo, hi}; return __builtin_bit_cast(unsigned, __builtin_convertvector(v, bf16x2_t)); }
__device__ __forceinline__ float bf2f(unsigned short b) { return __builtin_bit_cast(float, (unsigned)b << 16); }
__device__ __forceinline__ float wave_sum(float v) {
#pragma unroll
    for (int o = 1; o < 64; o <<= 1) v += __shfl_xor(v, o);
    return v;
}
__device__ __forceinline__ float silu_f(float x) { return x / (1.f + __expf(-x)); }
__device__ __forceinline__ float softplus2(float y) { return fmaxf(y, 0.f) + __log2f(1.f + __builtin_amdgcn_exp2f(-fabsf(y))); }
__device__ __forceinline__ float rstd_from_part(const float* part, int row) {
    const f32x4* p = (const f32x4*)(part + (size_t)row * 16); float s = 0.f;
#pragma unroll
    for (int i = 0; i < 4; ++i) { const f32x4 v = p[i]; s += (v[0] + v[1]) + (v[2] + v[3]); }
    return 1.0f / sqrtf(s * (1.f / DM) + NORM_EPS);
}
__device__ __forceinline__ bool moe_tile(const unsigned* ctl, int c, int tile, int& e, int& row0, int& nrows) {
    int ts = 0;
#pragma unroll
    for (int i = 0; i < 8; ++i) { const int cn = (int)ctl[CW_CNT + 64 * (c * 8 + i)]; const int nt = (cn + 255) >> 8;
        if (tile >= ts && tile < ts + nt) { e = i; row0 = (tile - ts) * 256; nrows = cn - row0 < 256 ? cn - row0 : 256; return true; }
        ts += nt; }
    return false;
}

__constant__ double c_invfreq[32] = {1, 0.74989420933245587, 0.56234132519034907, 0.42169650342858223, 0.31622776601683794, 0.23713737056616552, 0.17782794100389229, 0.1333521432163324,
    0.10000000000000001, 0.074989420933245579, 0.056234132519034911, 0.042169650342858224, 0.031622776601683791, 0.023713737056616554, 0.017782794100389229, 0.013335214321633241,
    0.01, 0.0074989420933245579, 0.005623413251903491, 0.0042169650342858229, 0.0031622776601683794, 0.0023713737056616554, 0.0017782794100389228, 0.0013335214321633241,
    0.001, 0.00074989420933245586, 0.0005623413251903491, 0.00042169650342858224, 0.00031622776601683794, 0.00023713737056616554, 0.00017782794100389227, 0.0001333521432163324};
__device__ __forceinline__ void rope_entry(int pos, int i, float& c, float& s) {
    const double a = (double)pos * c_invfreq[i];
    const double TWO_PI = 6.283185307179586476925286766559, HALF_PI = 1.5707963267948966192313216916398;
    double r = a - TWO_PI * __builtin_rint(a / TWO_PI);
    const double qd = __builtin_rint(r / HALF_PI); const int q = (int)qd; r -= qd * HALF_PI;
    const double r2 = r * r;
    const double sn = r * (1.0 + r2 * (-1.0 / 6 + r2 * (1.0 / 120 + r2 * (-1.0 / 5040 + r2 * (1.0 / 362880 + r2 * (-1.0 / 39916800 + r2 * (1.0 / 6227020800.0)))))));
    const double cs = 1.0 + r2 * (-0.5 + r2 * (1.0 / 24 + r2 * (-1.0 / 720 + r2 * (1.0 / 40320 + r2 * (-1.0 / 3628800 + r2 * (1.0 / 479001600.0))))));
    const int qq = q & 3; double cc, ss;
    if (qq == 0) { cc = cs; ss = sn; } else if (qq == 1) { cc = -sn; ss = cs; } else if (qq == 2) { cc = -cs; ss = -sn; } else { cc = sn; ss = -cs; }
    c = (float)cc; s = (float)ss;
}
enum { MAP_ID = 0, MAP_INE = 1, MAP_GATE = 2, MAP_UP = 3 };
__device__ __forceinline__ int map_row(int mode, int n) {
    if (mode == MAP_INE) return n < 1024 ? (n & ~63) + 2 * (n & 31) + ((n >> 5) & 1) : n;
    if (mode == MAP_GATE) return (n >> 7) * 256 + (n & 127);
    if (mode == MAP_UP) return (n >> 7) * 256 + 128 + (n & 127);
    return n;
}
constexpr int TR_SCR_BYTES = 64 * 65 * 4;
template <class LP>
__device__ __forceinline__ void transpose_item(const float* __restrict__ W, int K, int N, bf16* WT, const float* __restrict__ gain, int mode, LP scr, int item, int lane) {
    const int nblk = (N + 63) / 64, kb = item / nblk, nb = item % nblk, k0 = 64 * kb, n0 = 64 * nb;
    const int lr = lane >> 4, lc = (lane & 15) * 4;
    const bool nok = n0 + lc < N;
    f32x4 v[16];
#pragma unroll
    for (int i = 0; i < 16; ++i) v[i] = nok ? *(const f32x4*)(W + (size_t)(k0 + 4 * i + lr) * N + n0 + lc) : (f32x4){0.f, 0.f, 0.f, 0.f};
#pragma unroll
    for (int i = 0; i < 16; ++i)
#pragma unroll
        for (int e = 0; e < 4; ++e) scr[(4 * i + lr) * 65 + lc + e] = v[i][e];
    asm volatile("s_waitcnt lgkmcnt(0)" ::: "memory");
    const int c = lane & 7;
    f32x4 g0 = {1.f, 1.f, 1.f, 1.f}, g1 = {1.f, 1.f, 1.f, 1.f};
    if (gain) { g0 = *(const f32x4*)(gain + k0 + 8 * c); g1 = *(const f32x4*)(gain + k0 + 8 * c + 4); }
#pragma unroll
    for (int j = 0; j < 8; ++j) { const int n = (lane >> 3) + 8 * j;
        u32x4 o; o.x = pk2(scr[(8 * c + 0) * 65 + n] * g0[0], scr[(8 * c + 1) * 65 + n] * g0[1]); o.y = pk2(scr[(8 * c + 2) * 65 + n] * g0[2], scr[(8 * c + 3) * 65 + n] * g0[3]);
        o.z = pk2(scr[(8 * c + 4) * 65 + n] * g1[0], scr[(8 * c + 5) * 65 + n] * g1[1]); o.w = pk2(scr[(8 * c + 6) * 65 + n] * g1[2], scr[(8 * c + 7) * 65 + n] * g1[3]);
        if (n0 + n < N) *(u32x4*)(WT + (size_t)map_row(mode, n0 + n) * K + k0 + 8 * c) = o; }
    asm volatile("s_waitcnt lgkmcnt(0)" ::: "memory");
}
struct WJob { const float* W; int K, N; bf16* WT; const float* gain; int mode; };
constexpr int WI_INE = (DM / 64) * (EW / 64), WI_SQ = (DM / 64) * (DM / 64), WI_FF = (DM / 64) * (DFF / 64), WI_INO = (DM / 64) * ((OW + 63) / 64);
constexpr int WB0 = 0, WB1 = WB0 + WI_INE, WB2 = WB1 + WI_SQ, WB3 = WB2 + WI_FF, WB4 = WB3 + WI_FF, WB5 = WB4 + WI_FF, WB6 = WB5 + WI_INO, WB7 = WB6 + WI_SQ, WB_END = WB7 + 3 * NEXP * WI_FF;
template <class LP>
__device__ __forceinline__ void prologue_weights(const Params& p, LP scr, int gw, int ngw, int lane) {
    unsigned char* ws = p.ws;
    for (int g = gw; g < WB_END; g += ngw) {
        WJob J; int it;
        if (g < WB1) { J = WJob{p.in[2], DM, EW, (bf16*)(ws + WS_W_IN_E), p.in[1], MAP_INE}; it = g - WB0; }
        else if (g < WB2) { J = WJob{p.in[4], DM, DM, (bf16*)(ws + WS_W_OUT_E), nullptr, MAP_ID}; it = g - WB1; }
        else if (g < WB3) { J = WJob{p.in[6], DM, DFF, (bf16*)(ws + WS_W_GU_E), p.in[5], MAP_GATE}; it = g - WB2; }
        else if (g < WB4) { J = WJob{p.in[7], DM, DFF, (bf16*)(ws + WS_W_GU_E), p.in[5], MAP_UP}; it = g - WB3; }
        else if (g < WB5) { J = WJob{p.in[8], DFF, DM, (bf16*)(ws + WS_W_DN_E), nullptr, MAP_ID}; it = g - WB4; }
        else if (g < WB6) { J = WJob{p.in[10], DM, OW, (bf16*)(ws + WS_W_IN_O), p.in[9], MAP_ID}; it = g - WB5; }
        else if (g < WB7) { J = WJob{p.in[12], DM, DM, (bf16*)(ws + WS_W_OUT_O), nullptr, MAP_ID}; it = g - WB6; }
        else { const int k = (g - WB7) / WI_FF, e = k / 3, w = k % 3; it = (g - WB7) % WI_FF;
            if (w == 0) J = WJob{p.in[15] + (size_t)e * DM * DFF, DM, DFF, (bf16*)(ws + WS_W_GU_M) + (size_t)e * GU * DM, p.in[13], MAP_GATE};
            else if (w == 1) J = WJob{p.in[16] + (size_t)e * DM * DFF, DM, DFF, (bf16*)(ws + WS_W_GU_M) + (size_t)e * GU * DM, p.in[13], MAP_UP};
            else J = WJob{p.in[17] + (size_t)e * DFF * DM, DFF, DM, (bf16*)(ws + WS_W_DN_M) + (size_t)e * DM * DFF, nullptr, MAP_ID}; }
        transpose_item(J.W, J.K, J.N, J.WT, J.gain, J.mode, scr, it, lane);
    }
}
__device__ __forceinline__ void prologue_small(const Params& p, int gt, int ngt) {
    unsigned char* ws = p.ws;
    { u32x4* z = (u32x4*)((bf16*)(ws + WS_W_IN_O) + (size_t)OW * DM); const int n16 = (OWP - OW) * DM * 2 / 16;
      for (int i = gt; i < n16; i += ngt) z[i] = (u32x4){0u, 0u, 0u, 0u}; }
    { float2* R = (float2*)(ws + WS_ROPE);
      for (int i = gt; i < SEQ * 32; i += ngt) { float c, s; rope_entry(i >> 5, i & 31, c, s); R[i] = make_float2(c, s); } }
    { float* RW = (float*)(ws + WS_ROUTW); const float* wr = p.in[14]; const float* g = p.in[13];
      for (int i = gt; i < NEXP * DM; i += ngt) { const int e = i >> 10, k = i & 1023; RW[i] = wr[k * NEXP + e] * g[k]; } }
}
__device__ __forceinline__ void rms_row_to_bf16(const float* xrow, bf16* orow, int lane) {
    const f32x4* xr = (const f32x4*)xrow + lane;
    f32x4 v[4]; float s = 0.f;
#pragma unroll
    for (int j = 0; j < 4; ++j) { v[j] = xr[64 * j]; s += (v[j][0] * v[j][0] + v[j][1] * v[j][1]) + (v[j][2] * v[j][2] + v[j][3] * v[j][3]); }
    const float rstd = 1.0f / sqrtf(wave_sum(s) * (1.f / DM) + NORM_EPS);
    unsigned long long* o8 = (unsigned long long*)orow + lane;
#pragma unroll
    for (int j = 0; j < 4; ++j) o8[64 * j] = (unsigned long long)pk2(v[j][0] * rstd, v[j][1] * rstd) | ((unsigned long long)pk2(v[j][2] * rstd, v[j][3] * rstd) << 32);
}
__device__ __forceinline__ void final_norm_row(float* row, const float* gain, int lane) {
    f32x4* xr = (f32x4*)row + lane; const f32x4* g = (const f32x4*)gain + lane;
    f32x4 v[4]; float s = 0.f;
#pragma unroll
    for (int j = 0; j < 4; ++j) { v[j] = xr[64 * j]; s += (v[j][0] * v[j][0] + v[j][1] * v[j][1]) + (v[j][2] * v[j][2] + v[j][3] * v[j][3]); }
    const float rstd = 1.0f / sqrtf(wave_sum(s) * (1.f / DM) + NORM_EPS);
#pragma unroll
    for (int j = 0; j < 4; ++j) xr[64 * j] = v[j] * rstd * g[64 * j];
}
__device__ __forceinline__ void router_row(const float* hrow, const float* RW, const float* part4, int row, float* rstd4, int lane, int& e1, int& e2, float& g1, float& g2) {
    const f32x4* xr = (const f32x4*)hrow + lane; f32x4 v[4];
#pragma unroll
    for (int j = 0; j < 4; ++j) v[j] = xr[64 * j];
    float lg[NEXP];
#pragma unroll
    for (int e = 0; e < NEXP; ++e) { const f32x4* w = (const f32x4*)(RW + e * DM) + lane; float s = 0.f;
#pragma unroll
        for (int j = 0; j < 4; ++j) { const f32x4 ww = w[64 * j]; s += (v[j][0] * ww[0] + v[j][1] * ww[1]) + (v[j][2] * ww[2] + v[j][3] * ww[3]); }
        lg[e] = wave_sum(s); }
    const float rstd = rstd_from_part(part4, row);
    if (lane == 0) rstd4[row] = rstd;
    int b1 = 0; float v1 = lg[0];
#pragma unroll
    for (int e = 1; e < NEXP; ++e) if (lg[e] > v1) { v1 = lg[e]; b1 = e; }
    int b2 = -1; float v2 = -INFINITY;
#pragma unroll
    for (int e = 0; e < NEXP; ++e) if (e != b1 && lg[e] > v2) { v2 = lg[e]; b2 = e; }
    e1 = b1; e2 = b2; const float d = (v2 - v1) * rstd;
    g1 = 1.f / (1.f + __expf(d)); g2 = 1.f - g1;
}

__global__ void __launch_bounds__(128) nk_prologue_w(Params p) {
    __shared__ float scr[2][64 * 65];
    const int wave = threadIdx.x >> 6, lane = threadIdx.x & 63;
    prologue_weights(p, &scr[wave][0], blockIdx.x * 2 + wave, gridDim.x * 2, lane);
}
__global__ void __launch_bounds__(256) nk_prologue_s(Params p) {
    prologue_small(p, blockIdx.x * 256 + threadIdx.x, gridDim.x * 256);
    const int gw = blockIdx.x * 4 + (threadIdx.x >> 6), ngw = gridDim.x * 4, lane = threadIdx.x & 63;
    for (int m = gw; m < T; m += ngw) rms_row_to_bf16(p.in[0] + (size_t)m * DM, (bf16*)(p.ws + WS_X0) + (size_t)m * DM, lane);
}
__global__ void __launch_bounds__(256) nk_rowssq(Params p, int which) {
    const int gw = blockIdx.x * 4 + (threadIdx.x >> 6), ngw = gridDim.x * 4, lane = threadIdx.x & 63;
    float* part = (float*)(p.ws + WS_PART) + (size_t)which * T * 16;
    for (int m = gw; m < T; m += ngw) { const f32x4* xr = (const f32x4*)(p.out + (size_t)m * DM) + lane; float s = 0.f;
#pragma unroll
        for (int j = 0; j < 4; ++j) { const f32x4 v = xr[64 * j]; s += (v[0] * v[0] + v[1] * v[1]) + (v[2] * v[2] + v[3] * v[3]); }
        s = wave_sum(s); if (lane < 16) part[(size_t)m * 16 + lane] = lane == 0 ? s : 0.f; }
}
template <int EPI> __global__ void __launch_bounds__(256) nk_gemm(Params p) {
    unsigned char* ws = p.ws; const unsigned* ctl = (const unsigned*)(ws + WS_CTL);
    const int lane = threadIdx.x & 63, w = threadIdx.x >> 6, wm = w >> 1, wn = w & 1, l15 = lane & 15, lq = lane >> 4;
    const int m0 = blockIdx.y * 64 + wm * 32, n0 = blockIdx.x * 64 + wn * 32;
    constexpr bool DUAL = (EPI == 4 || EPI == 10), MOE = (EPI == 10 || EPI == 11);
    constexpr int K = (EPI == 5 || EPI == 11) ? DFF : DM;
    const bf16* A; const bf16* Bt; int e = 0, row0 = 0, nrows = 256; const int c = p.ph_lo;
    if (MOE) { if (!moe_tile(ctl, c, blockIdx.y >> 2, e, row0, nrows)) return; }
    if (EPI == 1) { A = (const bf16*)(ws + WS_X0); Bt = (const bf16*)(ws + WS_W_IN_E); }
    else if (EPI == 3) { A = (const bf16*)(ws + WS_X0); Bt = (const bf16*)(ws + WS_W_OUT_E); }
    else if (EPI == 4) { A = (const bf16*)(ws + WS_BIG); Bt = (const bf16*)(ws + WS_W_GU_E); }
    else if (EPI == 5) { A = (const bf16*)(ws + WS_HID); Bt = (const bf16*)(ws + WS_W_DN_E); }
    else if (EPI == 6) { A = (const bf16*)(ws + WS_X0); Bt = (const bf16*)(ws + WS_W_IN_O); }
    else if (EPI == 8) { A = (const bf16*)(ws + WS_X0); Bt = (const bf16*)(ws + WS_W_OUT_O); }
    else if (EPI == 10) { A = (const bf16*)(ws + WS_BIG); Bt = (const bf16*)(ws + WS_W_GU_M) + (size_t)e * GU * DM; }
    else { A = (const bf16*)(ws + WS_HID); Bt = (const bf16*)(ws + WS_W_DN_M) + (size_t)e * DM * DFF; }
    const int* list = (const int*)(ws + WS_LIST) + (size_t)(c * 8 + e) * T; const float* glist = (const float*)(ws + WS_GATE) + (size_t)(c * 8 + e) * T;
    const bf16* arow[2];
#pragma unroll
    for (int i = 0; i < 2; ++i) { const int m = m0 + 16 * i + l15;
        if (EPI == 10) { const int r = (m & 255); const int tok = list[row0 + (r < nrows ? r : 0)]; arow[i] = A + (size_t)tok * K; }
        else arow[i] = A + (size_t)m * K; }
    const bf16* brow[2];
#pragma unroll
    for (int j = 0; j < 2; ++j) { const int n = n0 + 16 * j + l15; const int br = DUAL ? ((n >> 7) * 256 + (n & 127)) : n; brow[j] = Bt + (size_t)br * K; }
    f32x4 acc[2][2], acc2[2][2];
#pragma unroll
    for (int i = 0; i < 2; ++i)
#pragma unroll
        for (int j = 0; j < 2; ++j) { acc[i][j] = (f32x4){0.f, 0.f, 0.f, 0.f}; acc2[i][j] = (f32x4){0.f, 0.f, 0.f, 0.f}; }
    for (int k0 = 0; k0 < K; k0 += 32) {
        bf16x8 a[2], b[2], b2[2];
#pragma unroll
        for (int i = 0; i < 2; ++i) a[i] = *(const bf16x8*)(arow[i] + k0 + 8 * lq);
#pragma unroll
        for (int j = 0; j < 2; ++j) { b[j] = *(const bf16x8*)(brow[j] + k0 + 8 * lq); if (DUAL) b2[j] = *(const bf16x8*)(brow[j] + (size_t)128 * K + k0 + 8 * lq); }
#pragma unroll
        for (int i = 0; i < 2; ++i)
#pragma unroll
            for (int j = 0; j < 2; ++j) { acc[i][j] = __builtin_amdgcn_mfma_f32_16x16x32_bf16(a[i], b[j], acc[i][j], 0, 0, 0);
                if (DUAL) acc2[i][j] = __builtin_amdgcn_mfma_f32_16x16x32_bf16(a[i], b2[j], acc2[i][j], 0, 0, 0); }
    }
    const float2* rope = (const float2*)(ws + WS_ROPE);
#pragma unroll
    for (int i = 0; i < 2; ++i)
#pragma unroll
        for (int j = 0; j < 2; ++j)
#pragma unroll
            for (int r = 0; r < 4; ++r) {
                const int m = m0 + 16 * i + 4 * lq + r, n = n0 + 16 * j + l15; float v = acc[i][j][r];
                if (EPI == 1) {
                    bf16* O = (bf16*)(ws + WS_BIG);
                    const float vp = __shfl_xor(v, 1);
                    if (n < 1024) { const float2 cs = rope[(m & (SEQ - 1)) * 32 + ((n & 63) >> 1)];
                        v = (n & 1) ? (vp * cs.y + v * cs.x) : (v * cs.x - vp * cs.y);
                        if (n >= 512) v *= 0.125f; }
                    else if (n >= 2048 && n < 2560) v *= C2;
                    O[(size_t)m * EW + n] = (bf16)f2bf(v);
                } else if (EPI == 3 || EPI == 5 || EPI == 8) {
                    const float* resid = (EPI == 3) ? p.in[0] : p.out; const float o = resid[(size_t)m * DM + n] + v;
                    p.out[(size_t)m * DM + n] = o;
                    bf16* hb = (bf16*)(ws + (EPI == 5 ? WS_X0 : WS_BIG)); hb[(size_t)m * DM + n] = (bf16)f2bf(o);
                } else if (EPI == 4) {
                    const float rs = rstd_from_part((const float*)(ws + WS_PART), m);
                    const float g = v * rs, u = acc2[i][j][r] * rs; ((bf16*)(ws + WS_HID))[(size_t)m * DFF + n] = (bf16)f2bf(silu_f(g) * u);
                } else if (EPI == 6) {
                    const float rs = rstd_from_part((const float*)(ws + WS_PART) + (size_t)T * 16, m); v *= rs;
                    if (n < QKVW) { if (n < 1024) v *= C2; ((bf16*)(ws + WS_BIG))[(size_t)m * QKVW + n] = (bf16)f2bf(v); }
                    else if (n < OW) { const int h = n - QKVW; const float z = v + p.in[11][h]; const float lf = fminf(z, 0.f) - log1pf(__expf(-fabsf(z)));
                        ((float*)(ws + WS_LOGF))[((size_t)(m >> 12) * 16 + h) * SEQ + (m & (SEQ - 1))] = lf; }
                } else if (EPI == 10) {
                    const int rr = m & 255; const int tok = list[row0 + (rr < nrows ? rr : 0)]; const float rs = ((const float*)(ws + WS_RSTD4))[tok];
                    const float g = v * rs, u = acc2[i][j][r] * rs; ((bf16*)(ws + WS_HID))[(size_t)m * DFF + n] = (bf16)f2bf(silu_f(g) * u);
                } else if (EPI == 11) {
                    const int rr = m & 255; if (rr < nrows) { const int tok = list[row0 + rr]; const float gt = glist[row0 + rr]; p.out[(size_t)tok * DM + n] += gt * v; }
                }
            }
}
__global__ void __launch_bounds__(256) nk_retention(Params p) {
    const bf16* P = (const bf16*)(p.ws + WS_BIG); bf16* Y = (bf16*)(p.ws + WS_X0);
    const int gw = blockIdx.x * 4 + (threadIdx.x >> 6), lane = threadIdx.x & 63;
    const int t = gw & (SEQ - 1), h = (gw >> 12) & 7, b = gw >> 15; if (b >= BATCH) return;
    const float lg2 = log2f(1.0f - exp2f(-5.0f - (float)h));
    const size_t rb = (size_t)b * SEQ;
    const float q = bf2f(P[(rb + t) * EW + h * 64 + lane]);
    float o = 0.f;
    for (int s = 0; s <= t; ++s) {
        const float k = bf2f(P[(rb + s) * EW + 512 + h * 64 + lane]), v = bf2f(P[(rb + s) * EW + 1024 + h * 64 + lane]);
        const float d = wave_sum(q * k);
        o += exp2f(lg2 * (float)(t - s)) * d * v;
    }
    const float mu = wave_sum(o) * (1.f / 64.f); const float dv = o - mu; const float var = wave_sum(dv * dv) * (1.f / 64.f);
    const float g = bf2f(P[(rb + t) * EW + 1536 + h * 64 + lane]);
    const float y = dv * (1.0f / sqrtf(var + GN_EPS)) * p.in[3][h * 64 + lane] * silu_f(g);
    Y[(rb + t) * DM + h * 64 + lane] = (bf16)f2bf(y);
}
__global__ void __launch_bounds__(256) nk_stickbreak(Params p) {
    const bf16* P = (const bf16*)(p.ws + WS_BIG); bf16* Y = (bf16*)(p.ws + WS_X0);
    const int gw = blockIdx.x * 4 + (threadIdx.x >> 6), lane = threadIdx.x & 63;
    const int t = gw & (SEQ - 1), h = (gw >> 12) & 7, b = gw >> 15; if (b >= BATCH) return;
    const size_t rb = (size_t)b * SEQ;
    const float q = bf2f(P[(rb + t) * EW + 2048 + h * 64 + lane]);
    float o = 0.f, carry = 0.f;
    for (int s = t - 1; s >= 0; --s) {
        const float k = bf2f(P[(rb + s) * EW + 2560 + h * 64 + lane]), v = bf2f(P[(rb + s) * EW + 3072 + h * 64 + lane]);
        const float y = wave_sum(q * k);
        const float lf2 = -softplus2(y);
        o += __builtin_amdgcn_exp2f(y + lf2 + carry) * v;
        carry += lf2;
    }
    Y[(rb + t) * DM + 512 + h * 64 + lane] = (bf16)f2bf(o);
}
__global__ void __launch_bounds__(128) nk_cumsum(Params p) {
    const int i = threadIdx.x; const float* lf = (const float*)(p.ws + WS_LOGF) + (size_t)i * SEQ; float* cu = (float*)(p.ws + WS_CUM) + (size_t)i * SEQ;
    float s = 0.f; for (int t = 0; t < SEQ; ++t) { s += lf[t]; cu[t] = s; }
}
__global__ void __launch_bounds__(256) nk_fox(Params p) {
    const bf16* P = (const bf16*)(p.ws + WS_BIG); bf16* Y = (bf16*)(p.ws + WS_X0);
    const int gw = blockIdx.x * 4 + (threadIdx.x >> 6), lane = threadIdx.x & 63;
    const int t = gw & (SEQ - 1), h = (gw >> 12) & 15, b = gw >> 16; if (b >= BATCH) return;
    const size_t rb = (size_t)b * SEQ; const float* cu = (const float*)(p.ws + WS_CUM) + ((size_t)b * 16 + h) * SEQ;
    const float q = bf2f(P[(rb + t) * QKVW + h * 64 + lane]);
    const float ct = cu[t]; float m = -INFINITY, l = 0.f, o = 0.f;
    for (int s = 0; s <= t; ++s) {
        const float k = bf2f(P[(rb + s) * QKVW + 1024 + h * 64 + lane]), v = bf2f(P[(rb + s) * QKVW + 2048 + h * 64 + lane]);
        const float x = wave_sum(q * k) + (ct - cu[s]) * LOG2E;
        if (x > m) { const float f = __builtin_amdgcn_exp2f(m - x); l *= f; o *= f; m = x; }
        const float pr = __builtin_amdgcn_exp2f(x - m); l += pr; o += pr * v;
    }
    Y[(rb + t) * DM + h * 64 + lane] = (bf16)f2bf(o / l);
}
__global__ void __launch_bounds__(256) nk_router(Params p) {
    __shared__ unsigned lcnt[16], lbase[16]; __shared__ int tinfo[128][2]; __shared__ float tg[128][2]; __shared__ unsigned tpos[128][2];
    unsigned char* ws = p.ws; unsigned* ctl = (unsigned*)(ws + WS_CTL);
    const int lane = threadIdx.x & 63, w = threadIdx.x >> 6;
    if (threadIdx.x < 16) lcnt[threadIdx.x] = 0u;
    __syncthreads();
    const float* part4 = (const float*)(ws + WS_PART) + (size_t)2 * T * 16;
    for (int i = 0; i < 32; ++i) { const int lt = w * 32 + i, row = blockIdx.x * 128 + lt; int e1, e2; float g1, g2;
        router_row(p.out + (size_t)row * DM, (const float*)(ws + WS_ROUTW), part4, row, (float*)(ws + WS_RSTD4), lane, e1, e2, g1, g2);
        if (lane == 0) { tinfo[lt][0] = e1; tinfo[lt][1] = e2; tg[lt][0] = g1; tg[lt][1] = g2; tpos[lt][0] = atomicAdd(&lcnt[e1], 1u); tpos[lt][1] = atomicAdd(&lcnt[8 + e2], 1u); } }
    __syncthreads();
    if (threadIdx.x < 16) lbase[threadIdx.x] = atomicAdd(&ctl[CW_CNT + 64 * threadIdx.x], lcnt[threadIdx.x]);
    __syncthreads();
    if (threadIdx.x < 256) { const int lt = threadIdx.x >> 1, c = threadIdx.x & 1, e = tinfo[lt][c]; const unsigned pos = lbase[c * 8 + e] + tpos[lt][c];
        ((int*)(ws + WS_LIST))[(size_t)(c * 8 + e) * T + pos] = blockIdx.x * 128 + lt; ((float*)(ws + WS_GATE))[(size_t)(c * 8 + e) * T + pos] = tg[lt][c]; }
}
__global__ void __launch_bounds__(256) nk_final(Params p) {
    const int gw = blockIdx.x * 4 + (threadIdx.x >> 6), ngw = gridDim.x * 4, lane = threadIdx.x & 63;
    for (int m = gw; m < T; m += ngw) final_norm_row(p.out + (size_t)m * DM, p.in[18], lane);
}

namespace pg8 {
#define PG8_LAS __attribute__((address_space(3)))
constexpr int BM = 256, BK = 64, HALF = 128, HTB = HALF * BK * 2, STAGE_BYTES = 8 * HTB, NXCD = 8, WGM = 8;
__host__ __device__ __forceinline__ int lds_byte(int r, int c) { const int st = (r >> 4) * 2 + (c >> 5), rr = r & 15, cc = c & 31, ob = rr * 64 + cc * 2; return st * 1024 + (ob ^ (((ob >> 9) & 1) << 5)); }
__host__ __device__ __forceinline__ void stage_rc(int b, int& R, int& C) { const int st = b / 1024, sb = b % 1024, swz = sb ^ (((sb >> 9) & 1) << 5); R = (st >> 1) * 16 + swz / 64; C = (st & 1) * 32 + (swz % 64) / 2; }
__host__ __device__ __forceinline__ int perm32(int rho) { const int n = rho >> 4, i = rho & 15; return 8 * (i >> 2) + 4 * n + (i & 3); }
struct Unit { int pm, pn; };
struct StaticOrder {
    int nM, nN, nwg, G, c;
    __device__ void init(int nM_, int nN_, int G_, int c_) { nM = nM_; nN = nN_; nwg = nM * nN; G = G_; c = c_; }
    __device__ bool next(int i, Unit& u) const {
        const long L = (long)i * G + c; if (L >= nwg) return false;
        int wgid = (int)L; { const int q = nwg / NXCD, r = nwg % NXCD, xcd = wgid % NXCD, off = wgid / NXCD; wgid = (xcd < r ? xcd * (q + 1) : r * (q + 1) + (xcd - r) * q) + off; }
        const int nig = WGM * nN, gid = wgid / nig, fm = gid * WGM, gsz = (nM - fm) < WGM ? (nM - fm) : WGM;
        u.pm = fm + ((wgid % nig) % gsz); u.pn = (wgid % nig) / gsz; return true;
    }
};
struct ProbDense { const bf16* A; const bf16* Bt; int K; static constexpr bool GATHER = false;
    __device__ __forceinline__ const char* a_tile(const Unit& u) const { return (const char*)A + (size_t)u.pm * BM * K * 2; }
    __device__ __forceinline__ const char* b_tile(const Unit& u) const { return (const char*)Bt + (size_t)u.pn * BM * K * 2; }
    __device__ __forceinline__ void a_offsets(const Unit&, const int (&)[2], const int (&)[2], unsigned (&)[2][2]) const {}
};
struct ProbMoeDown { const bf16* A; const bf16* Bt; int K; size_t estride; const unsigned* ctl; int c; static constexpr bool GATHER = false;
    __device__ __forceinline__ const char* a_tile(const Unit& u) const { return (const char*)A + (size_t)u.pm * BM * K * 2; }
    __device__ __forceinline__ const char* b_tile(const Unit& u) const { int e = 0, r0, nr; moe_tile(ctl, c, u.pm, e, r0, nr); return (const char*)Bt + (size_t)e * estride + (size_t)u.pn * BM * K * 2; }
    __device__ __forceinline__ void a_offsets(const Unit&, const int (&)[2], const int (&)[2], unsigned (&)[2][2]) const {}
};
struct ProbMoeGU { const bf16* A; const bf16* Bt; int K; size_t estride; const unsigned* ctl; int c; const int* lists; static constexpr bool GATHER = true;
    __device__ __forceinline__ const char* a_tile(const Unit&) const { return (const char*)A; }
    __device__ __forceinline__ const char* b_tile(const Unit& u) const { int e = 0, r0, nr; moe_tile(ctl, c, u.pm, e, r0, nr); return (const char*)Bt + (size_t)e * estride + (size_t)u.pn * BM * K * 2; }
    __device__ __forceinline__ void a_offsets(const Unit& u, const int (&RA)[2], const int (&CA)[2], unsigned (&off)[2][2]) const {
        int e = 0, r0 = 0, nr = 1; moe_tile(ctl, c, u.pm, e, r0, nr); const int* l = lists + (size_t)(c * 8 + e) * T + r0;
#pragma unroll
        for (int h = 0; h < 2; ++h)
#pragma unroll
            for (int i = 0; i < 2; ++i) { const int r = h * HALF + RA[i]; const int tok = l[r < nr ? r : 0]; off[h][i] = (unsigned)tok * (unsigned)(K * 2) + (unsigned)(CA[i] * 2); }
    }
};

#define PG8_EARGS const f32x4 (&acc)[2][2][4][2], const Unit& u, int wr, int wc, int fr, int fq
__device__ __forceinline__ u32x4 pack8(const f32x4 a, const f32x4 b) { u32x4 w; w.x = pk2(a[0], a[1]); w.y = pk2(a[2], a[3]); w.z = pk2(b[0], b[1]); w.w = pk2(b[2], b[3]); return w; }
__device__ __forceinline__ float quad_rstd(const float* part, int row, int fq) {
    const f32x4 q = *(const f32x4*)(part + (size_t)row * 16 + 4 * fq); float s = (q[0] + q[1]) + (q[2] + q[3]);
    s += __shfl_xor(s, 16); s += __shfl_xor(s, 32); return 1.0f / sqrtf(s * (1.f / DM) + NORM_EPS);
}
#define PG8_BATCH_FENCE() do { asm volatile("" ::: "memory"); __builtin_amdgcn_sched_barrier(0); } while (0)
struct EpiInEven { static constexpr bool PERM = true; bf16* O; const float2* rope;
    __device__ __forceinline__ void operator()(PG8_EARGS) const {
        const int pn = u.pn, row0 = u.pm * BM + wr * 64 + fr, colb = pn * BM + wc * 32 + 8 * fq;
        if (pn < 4) {
            const float sc = (pn >= 2) ? 0.125f : 1.f;
#pragma unroll
            for (int ai = 0; ai < 2; ++ai) {
                f32x4 cs[4][2];
#pragma unroll
                for (int m = 0; m < 4; ++m) { const int row = row0 + ai * HALF + m * 16; const f32x4* rp = (const f32x4*)(rope + (size_t)(row & (SEQ - 1)) * 32 + 16 * (wc & 1) + 4 * fq); cs[m][0] = rp[0]; cs[m][1] = rp[1]; }
                PG8_BATCH_FENCE();
#pragma unroll
                for (int m = 0; m < 4; ++m) { const int row = row0 + ai * HALF + m * 16; const f32x4 cs0 = cs[m][0], cs1 = cs[m][1];
#pragma unroll
                    for (int bj = 0; bj < 2; ++bj) { const f32x4 v0 = acc[ai][bj][m][0], v1 = acc[ai][bj][m][1]; f32x4 a, b;
                        a[0] = v0[0] * cs0[0] - v0[1] * cs0[1]; a[1] = v0[0] * cs0[1] + v0[1] * cs0[0]; a[2] = v0[2] * cs0[2] - v0[3] * cs0[3]; a[3] = v0[2] * cs0[3] + v0[3] * cs0[2];
                        b[0] = v1[0] * cs1[0] - v1[1] * cs1[1]; b[1] = v1[0] * cs1[1] + v1[1] * cs1[0]; b[2] = v1[2] * cs1[2] - v1[3] * cs1[3]; b[3] = v1[2] * cs1[3] + v1[3] * cs1[2];
                        *(u32x4*)(O + (size_t)row * EW + colb + bj * HALF) = pack8(a * sc, b * sc); } } }
        } else {
            const float sc = (pn == 8 || pn == 9) ? C2 : 1.f;
#pragma unroll
            for (int ai = 0; ai < 2; ++ai)
#pragma unroll
                for (int m = 0; m < 4; ++m) { const int row = row0 + ai * HALF + m * 16;
#pragma unroll
                    for (int bj = 0; bj < 2; ++bj) *(u32x4*)(O + (size_t)row * EW + colb + bj * HALF) = pack8(acc[ai][bj][m][0] * sc, acc[ai][bj][m][1] * sc); }
        }
    }
};
__device__ __forceinline__ f32x4 bf4lo(const u32x4 w) { return (f32x4){bf2f(w.x & 0xffff), bf2f(w.x >> 16), bf2f(w.y & 0xffff), bf2f(w.y >> 16)}; }
__device__ __forceinline__ f32x4 bf4hi(const u32x4 w) { return (f32x4){bf2f(w.z & 0xffff), bf2f(w.z >> 16), bf2f(w.w & 0xffff), bf2f(w.w >> 16)}; }
template <bool RF32> struct EpiResid { static constexpr bool PERM = true; const void* resid; bf16* hb; float* part;
    __device__ __forceinline__ void operator()(PG8_EARGS) const {
        const int row0 = u.pm * BM + wr * 64 + fr, colb = u.pn * BM + wc * 32 + 8 * fq;
        if constexpr (RF32) {
#pragma unroll
            for (int ai = 0; ai < 2; ++ai) {
                f32x4 rr[4][2][2];
#pragma unroll
                for (int m = 0; m < 4; ++m)
#pragma unroll
                    for (int bj = 0; bj < 2; ++bj) { const size_t off = (size_t)(row0 + ai * HALF + m * 16) * DM + colb + bj * HALF; rr[m][bj][0] = *(const f32x4*)((const float*)resid + off); rr[m][bj][1] = *(const f32x4*)((const float*)resid + off + 4); }
                PG8_BATCH_FENCE();
#pragma unroll
                for (int m = 0; m < 4; ++m) { const int row = row0 + ai * HALF + m * 16; float ss = 0.f;
#pragma unroll
                    for (int bj = 0; bj < 2; ++bj) { const size_t off = (size_t)row * DM + colb + bj * HALF;
                        const f32x4 o0 = rr[m][bj][0] + acc[ai][bj][m][0], o1 = rr[m][bj][1] + acc[ai][bj][m][1];
                        *(u32x4*)(hb + off) = pack8(o0, o1);
                        ss += (o0[0] * o0[0] + o0[1] * o0[1]) + (o0[2] * o0[2] + o0[3] * o0[3]) + (o1[0] * o1[0] + o1[1] * o1[1]) + (o1[2] * o1[2] + o1[3] * o1[3]); }
                    ss += __shfl_xor(ss, 16); ss += __shfl_xor(ss, 32);
                    if (fq == 0) part[(size_t)row * 16 + u.pn * 4 + wc] = ss; }
                PG8_BATCH_FENCE(); }
        } else {
#pragma unroll
            for (int ai = 0; ai < 2; ++ai) {
                u32x4 rr[4][2];
#pragma unroll
                for (int m = 0; m < 4; ++m)
#pragma unroll
                    for (int bj = 0; bj < 2; ++bj) rr[m][bj] = *(const u32x4*)((const bf16*)resid + (size_t)(row0 + ai * HALF + m * 16) * DM + colb + bj * HALF);
                PG8_BATCH_FENCE();
#pragma unroll
                for (int m = 0; m < 4; ++m) { const int row = row0 + ai * HALF + m * 16; float ss = 0.f;
#pragma unroll
                    for (int bj = 0; bj < 2; ++bj) { const size_t off = (size_t)row * DM + colb + bj * HALF;
                        const f32x4 o0 = bf4lo(rr[m][bj]) + acc[ai][bj][m][0], o1 = bf4hi(rr[m][bj]) + acc[ai][bj][m][1];
                        *(u32x4*)(hb + off) = pack8(o0, o1);
                        ss += (o0[0] * o0[0] + o0[1] * o0[1]) + (o0[2] * o0[2] + o0[3] * o0[3]) + (o1[0] * o1[0] + o1[1] * o1[1]) + (o1[2] * o1[2] + o1[3] * o1[3]); }
                    ss += __shfl_xor(ss, 16); ss += __shfl_xor(ss, 32);
                    if (fq == 0) part[(size_t)row * 16 + u.pn * 4 + wc] = ss; }
                PG8_BATCH_FENCE(); }
        }
    }
};
__device__ __forceinline__ float fast_silu(float x) { return x * __builtin_amdgcn_rcpf(1.f + __builtin_amdgcn_exp2f(-LOG2E * x)); }
struct EpiGU { static constexpr bool PERM = true; bf16* hid; const float* part;
    __device__ __forceinline__ void operator()(PG8_EARGS) const {
        const int row0 = u.pm * BM + wr * 64 + fr, colb = u.pn * HALF + wc * 32 + 8 * fq;
        f32x4 q[2][4];
#pragma unroll
        for (int ai = 0; ai < 2; ++ai)
#pragma unroll
            for (int m = 0; m < 4; ++m) q[ai][m] = *(const f32x4*)(part + (size_t)(row0 + ai * HALF + m * 16) * 16 + 4 * fq);
        PG8_BATCH_FENCE();
#pragma unroll
        for (int ai = 0; ai < 2; ++ai)
#pragma unroll
            for (int m = 0; m < 4; ++m) { const int row = row0 + ai * HALF + m * 16; float s = (q[ai][m][0] + q[ai][m][1]) + (q[ai][m][2] + q[ai][m][3]);
                s += __shfl_xor(s, 16); s += __shfl_xor(s, 32); const float rs = 1.0f / sqrtf(s * (1.f / DM) + NORM_EPS);
                f32x4 h0, h1;
#pragma unroll
                for (int e = 0; e < 4; ++e) { h0[e] = fast_silu(acc[ai][0][m][0][e] * rs) * (acc[ai][1][m][0][e] * rs); h1[e] = fast_silu(acc[ai][0][m][1][e] * rs) * (acc[ai][1][m][1][e] * rs); }
                *(u32x4*)(hid + (size_t)row * DFF + colb) = pack8(h0, h1); }
    }
};
struct EpiInOdd { static constexpr bool PERM = true; bf16* O; const float* part; const float* bias; float* logf;
    __device__ __forceinline__ void operator()(PG8_EARGS) const {
        const int pn = u.pn, row0 = u.pm * BM + wr * 64 + fr, colb = pn * BM + wc * 32 + 8 * fq;
        const float sc = pn < 4 ? C2 : 1.f;
        f32x4 q[2][4]; float rs[2][4];
#pragma unroll
        for (int ai = 0; ai < 2; ++ai)
#pragma unroll
            for (int m = 0; m < 4; ++m) q[ai][m] = *(const f32x4*)(part + (size_t)(row0 + ai * HALF + m * 16) * 16 + 4 * fq);
        PG8_BATCH_FENCE();
#pragma unroll
        for (int ai = 0; ai < 2; ++ai)
#pragma unroll
            for (int m = 0; m < 4; ++m) { float s = (q[ai][m][0] + q[ai][m][1]) + (q[ai][m][2] + q[ai][m][3]); s += __shfl_xor(s, 16); s += __shfl_xor(s, 32); rs[ai][m] = 1.0f / sqrtf(s * (1.f / DM) + NORM_EPS); }
        if (pn < 12) {
#pragma unroll
            for (int ai = 0; ai < 2; ++ai)
#pragma unroll
                for (int m = 0; m < 4; ++m) { const int row = row0 + ai * HALF + m * 16;
#pragma unroll
                    for (int bj = 0; bj < 2; ++bj) *(u32x4*)(O + (size_t)row * QKVW + colb + bj * HALF) = pack8(acc[ai][bj][m][0] * (rs[ai][m] * sc), acc[ai][bj][m][1] * (rs[ai][m] * sc)); }
        } else if (wc == 0 && fq < 2) {
            f32x4 b0 = *(const f32x4*)(bias + 8 * fq), b1 = *(const f32x4*)(bias + 8 * fq + 4);
#pragma unroll
            for (int ai = 0; ai < 2; ++ai)
#pragma unroll
                for (int m = 0; m < 4; ++m) { const int row = row0 + ai * HALF + m * 16;
#pragma unroll
                    for (int n = 0; n < 2; ++n)
#pragma unroll
                        for (int e = 0; e < 4; ++e) { const int h = 8 * fq + 4 * n + e; const float z = acc[ai][0][m][n][e] * rs[ai][m] + (n ? b1[e] : b0[e]);
                            logf[((size_t)(row >> 12) * 16 + h) * SEQ + (row & (SEQ - 1))] = fminf(z, 0.f) - __logf(1.f + __expf(-fabsf(z))); } }
        }
    }
};
struct EpiMoeGU { static constexpr bool PERM = true; bf16* hid; const float* rstd4; const unsigned* ctl; int c; const int* lists;
    __device__ __forceinline__ void operator()(PG8_EARGS) const {
        int e = 0, r0 = 0, nr = 1; moe_tile(ctl, c, u.pm, e, r0, nr); const int* l = lists + (size_t)(c * 8 + e) * T + r0;
        const int rl0 = wr * 64 + fr, colb = u.pn * HALF + wc * 32 + 8 * fq;
        int tk[2][4]; float rs[2][4];
#pragma unroll
        for (int ai = 0; ai < 2; ++ai)
#pragma unroll
            for (int m = 0; m < 4; ++m) { const int rl = rl0 + ai * HALF + m * 16; tk[ai][m] = l[rl < nr ? rl : 0]; }
        PG8_BATCH_FENCE();
#pragma unroll
        for (int ai = 0; ai < 2; ++ai)
#pragma unroll
            for (int m = 0; m < 4; ++m) rs[ai][m] = rstd4[tk[ai][m]];
        PG8_BATCH_FENCE();
#pragma unroll
        for (int ai = 0; ai < 2; ++ai)
#pragma unroll
            for (int m = 0; m < 4; ++m) { const int rl = rl0 + ai * HALF + m * 16; const float r = rs[ai][m];
                f32x4 h0, h1;
#pragma unroll
                for (int x = 0; x < 4; ++x) { h0[x] = fast_silu(acc[ai][0][m][0][x] * r) * (acc[ai][1][m][0][x] * r); h1[x] = fast_silu(acc[ai][0][m][1][x] * r) * (acc[ai][1][m][1][x] * r); }
                *(u32x4*)(hid + (size_t)(u.pm * BM + rl) * DFF + colb) = pack8(h0, h1); }
    }
};
template <bool FIRST> struct EpiMoeDown { static constexpr bool PERM = true; float* out; const bf16* hres; const unsigned* ctl; int c; const int* lists; const float* gates;
    __device__ __forceinline__ void operator()(PG8_EARGS) const {
        int e = 0, r0 = 0, nr = 0; moe_tile(ctl, c, u.pm, e, r0, nr); const int* l = lists + (size_t)(c * 8 + e) * T + r0; const float* g = gates + (size_t)(c * 8 + e) * T + r0;
        const int rl0 = wr * 64 + fr, colb = u.pn * BM + wc * 32 + 8 * fq;
        int tk[2][4]; float gt[2][4];
#pragma unroll
        for (int ai = 0; ai < 2; ++ai)
#pragma unroll
            for (int m = 0; m < 4; ++m) { const int rl = rl0 + ai * HALF + m * 16; const bool ok = rl < nr; tk[ai][m] = l[ok ? rl : 0]; gt[ai][m] = ok ? g[ok ? rl : 0] : 0.f; }
        PG8_BATCH_FENCE();
        if constexpr (FIRST) {
            u32x4 rr[2][4][2];
#pragma unroll
            for (int ai = 0; ai < 2; ++ai)
#pragma unroll
                for (int m = 0; m < 4; ++m)
#pragma unroll
                    for (int bj = 0; bj < 2; ++bj) rr[ai][m][bj] = *(const u32x4*)(hres + (size_t)tk[ai][m] * DM + colb + bj * HALF);
            PG8_BATCH_FENCE();
#pragma unroll
            for (int ai = 0; ai < 2; ++ai)
#pragma unroll
                for (int m = 0; m < 4; ++m) { const int rl = rl0 + ai * HALF + m * 16;
                    if (rl < nr) {
#pragma unroll
                        for (int bj = 0; bj < 2; ++bj) { float* o = out + (size_t)tk[ai][m] * DM + colb + bj * HALF;
                            *(f32x4*)o = bf4lo(rr[ai][m][bj]) + acc[ai][bj][m][0] * gt[ai][m]; *(f32x4*)(o + 4) = bf4hi(rr[ai][m][bj]) + acc[ai][bj][m][1] * gt[ai][m]; } } }
        } else {
#pragma unroll
            for (int ai = 0; ai < 2; ++ai) {
                f32x4 rr[4][2][2];
#pragma unroll
                for (int m = 0; m < 4; ++m)
#pragma unroll
                    for (int bj = 0; bj < 2; ++bj) { const float* o = out + (size_t)tk[ai][m] * DM + colb + bj * HALF; rr[m][bj][0] = *(const f32x4*)o; rr[m][bj][1] = *(const f32x4*)(o + 4); }
                PG8_BATCH_FENCE();
#pragma unroll
                for (int m = 0; m < 4; ++m) { const int rl = rl0 + ai * HALF + m * 16;
                    if (rl < nr) {
#pragma unroll
                        for (int bj = 0; bj < 2; ++bj) { float* o = out + (size_t)tk[ai][m] * DM + colb + bj * HALF;
                            *(f32x4*)o = rr[m][bj][0] + acc[ai][bj][m][0] * gt[ai][m]; *(f32x4*)(o + 4) = rr[m][bj][1] + acc[ai][bj][m][1] * gt[ai][m]; } } }
                PG8_BATCH_FENCE(); }
        }
    }
};

template <class Prob, class Epi, class Sched>
__device__ __forceinline__ void gemm_phase(PG8_LAS unsigned char* lds, const Prob& P, const Sched& S, const Epi& E, int tag = -1) {
#ifdef PROBE_PH
    unsigned long long pr_t0 = 0, pr_k = 0, pr_e = 0; const bool pr_on = (tag == PROBE_PH) && blockIdx.x == 0 && threadIdx.x == 0;
#endif
    const int tid = threadIdx.x, wid = __builtin_amdgcn_readfirstlane(tid >> 6), lane = tid & 63, wr = wid >> 2, wc = wid & 3, fr = lane & 15, fq = lane >> 4;
    const int K = P.K, nt = K / BK;
    unsigned voffA[2], voffB[2]; int RA[2], CA[2];
#pragma unroll
    for (int i = 0; i < 2; ++i) { int R, C; stage_rc(tid * 16 + i * 8192, R, C); const int Rb = Epi::PERM ? ((R & ~31) + perm32(R & 31)) : R;
        voffA[i] = (unsigned)(R * K + C) * 2u; voffB[i] = (unsigned)(Rb * K + C) * 2u; RA[i] = R; CA[i] = C; }
    const size_t kstep = (size_t)(BK * 2);
    const size_t hstep = (size_t)HALF * K * 2;
    const unsigned ldsw = (unsigned)wid * 1024u;
    const int aoff = lds_byte(wr * 64 + fr, fq * 8), boff = lds_byte(wc * 32 + fr, fq * 8);
    unsigned offC[2][2] = {{0u, 0u}, {0u, 0u}}, offN[2][2] = {{0u, 0u}, {0u, 0u}};
#define PG8_SA(b, h) (((b) * 2 + (h)) * HTB)
#define PG8_SB(b, h) ((4 + (b) * 2 + (h)) * HTB)
#define PG8_STAGE(bufoff, gbase, voff) do { _Pragma("unroll") for (int _i = 0; _i < 2; ++_i) \
        __builtin_amdgcn_global_load_lds((const unsigned*)((const char*)(gbase) + (voff)[_i]), (PG8_LAS unsigned*)(lds + (bufoff) + ldsw + _i * 8192), 16, 0, 0); } while (0)
#define PG8_STAGE_A(bufoff, gbase, h, nx) do { _Pragma("unroll") for (int _i = 0; _i < 2; ++_i) { \
        const size_t _o = Prob::GATHER ? (size_t)((nx) ? offN[h][_i] : offC[h][_i]) : (size_t)voffA[_i] + (size_t)(h) * hstep; \
        __builtin_amdgcn_global_load_lds((const unsigned*)((const char*)(gbase) + _o), (PG8_LAS unsigned*)(lds + (bufoff) + ldsw + _i * 8192), 16, 0, 0); } } while (0)
#define PG8_LDA(dst, b, h) do { _Pragma("unroll") for (int m = 0; m < 4; ++m) _Pragma("unroll") for (int k = 0; k < 2; ++k) dst[m][k] = *(const PG8_LAS bf16x8*)(lds + PG8_SA(b, h) + aoff + m * 2048 + k * 1024); } while (0)
#define PG8_LDB(dst, b, h) do { _Pragma("unroll") for (int n = 0; n < 2; ++n) _Pragma("unroll") for (int k = 0; k < 2; ++k) dst[n][k] = *(const PG8_LAS bf16x8*)(lds + PG8_SB(b, h) + boff + n * 2048 + k * 1024); } while (0)
#define PG8_MMA(ai, bj, At, Bt) do { __builtin_amdgcn_s_setprio(1); _Pragma("unroll") for (int m = 0; m < 4; ++m) _Pragma("unroll") for (int n = 0; n < 2; ++n) _Pragma("unroll") for (int k = 0; k < 2; ++k) \
        acc[ai][bj][m][n] = __builtin_amdgcn_mfma_f32_16x16x32_bf16(Bt[n][k], At[m][k], acc[ai][bj][m][n], 0, 0, 0); __builtin_amdgcn_s_setprio(0); } while (0)
#define PG8_WAIT_V(n) asm volatile("s_waitcnt vmcnt(" #n ")" ::: "memory")
#define PG8_WAIT_L(n) asm volatile("s_waitcnt lgkmcnt(" #n ")" ::: "memory")
#define PG8_BAR __builtin_amdgcn_s_barrier()
#define PG8_SCHED __builtin_amdgcn_sched_barrier(0)
    Unit cur, nxt; int ui = 0;
    if (!S.next(0, cur)) return;
    f32x4 acc[2][2][4][2];
#pragma unroll
    for (int a = 0; a < 2; ++a)
#pragma unroll
        for (int b = 0; b < 2; ++b)
#pragma unroll
            for (int m = 0; m < 4; ++m)
#pragma unroll
                for (int n = 0; n < 2; ++n) acc[a][b][m][n] = (f32x4){0.f, 0.f, 0.f, 0.f};
    bf16x8 At[4][2], B0[2][2], B1[2][2];
    const char* cA = P.a_tile(cur); const char* cB = P.b_tile(cur);
    if constexpr (Prob::GATHER) P.a_offsets(cur, RA, CA, offC);
    PG8_STAGE(PG8_SB(0, 0), cB, voffB); PG8_STAGE(PG8_SB(0, 1), cB + hstep, voffB); PG8_STAGE_A(PG8_SA(0, 0), cA, 0, false); PG8_STAGE_A(PG8_SA(0, 1), cA, 1, false);
    if (wr == 1) PG8_BAR;
    PG8_WAIT_V(2); PG8_BAR;
    PG8_STAGE(PG8_SB(1, 0), cB + kstep, voffB); PG8_STAGE_A(PG8_SA(1, 0), cA + kstep, 0, false); PG8_STAGE(PG8_SB(1, 1), cB + hstep + kstep, voffB);
    PG8_WAIT_V(6); PG8_BAR;
    for (;;) {
#ifdef PROBE_PH
        if (pr_on) pr_t0 = __builtin_amdgcn_s_memrealtime();
#endif
        const bool has_next = S.next(ui + 1, nxt);
        const char* nA = has_next ? P.a_tile(nxt) : cA; const char* nB = has_next ? P.b_tile(nxt) : cB;
        if constexpr (Prob::GATHER) { if (ui == 0) { if (has_next) P.a_offsets(nxt, RA, CA, offN); else {
#pragma unroll
            for (int h = 0; h < 2; ++h)
#pragma unroll
                for (int i = 0; i < 2; ++i) offN[h][i] = offC[h][i]; } } }
        for (int t = 0; t < nt; t += 2) {
            const bool last = (t == nt - 2);
            const char* a1 = cA + (size_t)(t + 1) * kstep;
            const char* a2 = last ? nA : cA + (size_t)(t + 2) * kstep; const char* b2 = last ? nB : cB + (size_t)(t + 2) * kstep;
            const char* a3 = a2 + kstep; const char* b3 = b2 + kstep;
            PG8_LDB(B0, 0, 0); PG8_LDB(B1, 0, 1); PG8_SCHED; PG8_LDA(At, 0, 0); PG8_STAGE_A(PG8_SA(1, 1), a1, 1, false);
            PG8_WAIT_V(8); PG8_WAIT_L(0); PG8_BAR; PG8_MMA(0, 0, At, B0); PG8_MMA(0, 1, At, B1); PG8_BAR; PG8_SCHED;
            PG8_LDA(At, 0, 1); PG8_STAGE(PG8_SB(0, 0), b2, voffB); PG8_STAGE(PG8_SB(0, 1), b2 + hstep, voffB); PG8_STAGE_A(PG8_SA(0, 0), a2, 0, last);
            PG8_WAIT_V(8); PG8_WAIT_L(0); PG8_BAR; PG8_MMA(1, 0, At, B0); PG8_MMA(1, 1, At, B1); PG8_BAR; PG8_SCHED;
            PG8_LDB(B0, 1, 0); PG8_LDB(B1, 1, 1); PG8_SCHED; PG8_LDA(At, 1, 0); PG8_STAGE_A(PG8_SA(0, 1), a2, 1, last);
            PG8_WAIT_V(8); PG8_WAIT_L(0); PG8_BAR; PG8_MMA(0, 0, At, B0); PG8_MMA(0, 1, At, B1); PG8_BAR; PG8_SCHED;
            PG8_LDA(At, 1, 1); PG8_STAGE(PG8_SB(1, 0), b3, voffB); PG8_STAGE(PG8_SB(1, 1), b3 + hstep, voffB); PG8_STAGE_A(PG8_SA(1, 0), a3, 0, last);
            PG8_WAIT_V(8); PG8_WAIT_L(0); PG8_BAR; PG8_MMA(1, 0, At, B0); PG8_MMA(1, 1, At, B1); PG8_BAR; PG8_SCHED;
        }
        if (wr == 0) PG8_BAR;
#ifdef PROBE_PH
        unsigned long long pr_t1 = 0; if (pr_on) { pr_t1 = __builtin_amdgcn_s_memrealtime(); pr_k += pr_t1 - pr_t0; }
#endif
        unsigned offNN[2][2] = {{0u, 0u}, {0u, 0u}};
        if constexpr (Prob::GATHER) { Unit n2; if (has_next) { if (S.next(ui + 2, n2)) P.a_offsets(n2, RA, CA, offNN); else {
#pragma unroll
            for (int h = 0; h < 2; ++h)
#pragma unroll
                for (int i = 0; i < 2; ++i) offNN[h][i] = offN[h][i]; } } }
        E(acc, cur, wr, wc, fr, fq);
#ifdef PROBE_PH
        if (pr_on) { pr_e += __builtin_amdgcn_s_memrealtime() - pr_t1; }
#endif
        if (!has_next) break;
#pragma unroll
        for (int a = 0; a < 2; ++a)
#pragma unroll
            for (int b = 0; b < 2; ++b)
#pragma unroll
                for (int m = 0; m < 4; ++m)
#pragma unroll
                    for (int n = 0; n < 2; ++n) acc[a][b][m][n] = (f32x4){0.f, 0.f, 0.f, 0.f};
        cur = nxt; cA = nA; cB = nB; ++ui;
        if constexpr (Prob::GATHER) {
#pragma unroll
            for (int h = 0; h < 2; ++h)
#pragma unroll
                for (int i = 0; i < 2; ++i) { offC[h][i] = offN[h][i]; offN[h][i] = offNN[h][i]; } }
        if (wr == 1) PG8_BAR;
    }
    PG8_WAIT_V(0);
    PG8_BAR;
#ifdef PROBE_PH
    if (pr_on) { ((PG8_LAS unsigned*)(lds + 147456 - 128))[0] = (unsigned)pr_k; ((PG8_LAS unsigned*)(lds + 147456 - 128))[1] = (unsigned)pr_e; }
#endif
#undef PG8_SA
#undef PG8_SB
#undef PG8_STAGE
#undef PG8_STAGE_A
#undef PG8_LDA
#undef PG8_LDB
#undef PG8_MMA
#undef PG8_WAIT_V
#undef PG8_WAIT_L
#undef PG8_BAR
#undef PG8_SCHED
}
}
namespace att {
#define ALAS __attribute__((address_space(3)))
typedef _Float16 f16x8 __attribute__((ext_vector_type(8)));
typedef short s16x4 __attribute__((ext_vector_type(4)));
typedef short v4i16_t __attribute__((ext_vector_type(4)));
constexpr int KSTR = 144, VSTR = 192;
constexpr int KT_BYTES = 64 * KSTR, VT_BYTES = 64 * VSTR, STAGE = KT_BYTES + VT_BYTES;
constexpr int FLAG_OFF = 2 * STAGE;
constexpr int CUM_OFF = 49152;
constexpr float EXIT_T = -152.0f;
__device__ __forceinline__ int crow(int r, int hi) { return (r & 3) + 8 * (r >> 2) + 4 * hi; }
__device__ __forceinline__ bf16x8 vtr2(const ALAS unsigned char* p0, const ALAS unsigned char* p1) {
    const s16x4 a = __builtin_bit_cast(s16x4, __builtin_amdgcn_ds_read_tr16_b64_v4i16((ALAS v4i16_t*)p0));
    const s16x4 b = __builtin_bit_cast(s16x4, __builtin_amdgcn_ds_read_tr16_b64_v4i16((ALAS v4i16_t*)p1));
    return (bf16x8){a[0], a[1], a[2], a[3], b[0], b[1], b[2], b[3]};
}
__device__ __forceinline__ bf16x8 packbf8(const f32x16& p, int b) { u32x4 w; w.x = pk2(p[b], p[b + 1]); w.y = pk2(p[b + 2], p[b + 3]); w.z = pk2(p[b + 4], p[b + 5]); w.w = pk2(p[b + 6], p[b + 7]); return __builtin_bit_cast(bf16x8, w); }
typedef _Float16 f16x2_t __attribute__((ext_vector_type(2)));
__device__ __forceinline__ unsigned pkh2(float lo, float hi) { const f32x2_t v = {lo, hi}; return __builtin_bit_cast(unsigned, __builtin_convertvector(v, f16x2_t)); }
__device__ __forceinline__ f16x8 packh8(const f32x16& p, int b) { u32x4 w; w.x = pkh2(p[b], p[b + 1]); w.y = pkh2(p[b + 2], p[b + 3]); w.z = pkh2(p[b + 4], p[b + 5]); w.w = pkh2(p[b + 6], p[b + 7]); return __builtin_bit_cast(f16x8, w); }
__device__ __forceinline__ void pv_tile(f32x16 (&o)[2], const ALAS unsigned char* vb, int vl, const bf16x8 (&pb)[4]) {
#pragma unroll
    for (int dh = 0; dh < 2; ++dh)
#pragma unroll
        for (int s = 0; s < 4; ++s) { const ALAS unsigned char* a = vb + vl + (16 * s) * VSTR + dh * 64;
            o[dh] = __builtin_amdgcn_mfma_f32_32x32x16_bf16(vtr2(a, a + 8 * VSTR), pb[s], o[dh], 0, 0, 0); }
}
template <int MODE>
__device__ __forceinline__ void qk_tile(f32x16& p0, f32x16& p1, const ALAS unsigned char* kb, int kl, const bf16x8 (&qr)[4], const ALAS float* cum2, int key0, int hi, float cqm) {
    if (MODE == 1) {
#pragma unroll
        for (int g = 0; g < 4; ++g) { const f32x4 cb0 = *(const ALAS f32x4*)(cum2 + key0 + 8 * g + 4 * hi), cb1 = *(const ALAS f32x4*)(cum2 + key0 + 32 + 8 * g + 4 * hi);
#pragma unroll
            for (int e = 0; e < 4; ++e) { p0[4 * g + e] = cqm + cb0[e]; p1[4 * g + e] = cqm + cb1[e]; } }
    } else {
#pragma unroll
        for (int r = 0; r < 16; ++r) { p0[r] = 0.f; p1[r] = 0.f; } }
#pragma unroll
    for (int d0 = 0; d0 < 4; ++d0) { const bf16x8 ka = *(const ALAS bf16x8*)(kb + kl + 32 * d0), kc = *(const ALAS bf16x8*)(kb + kl + 32 * KSTR + 32 * d0);
        p0 = __builtin_amdgcn_mfma_f32_32x32x16_bf16(ka, qr[d0], p0, 0, 0, 0); p1 = __builtin_amdgcn_mfma_f32_32x32x16_bf16(kc, qr[d0], p1, 0, 0, 0); }
}
template <int MODE>
__device__ __forceinline__ void unit(ALAS unsigned char* lds, const bf16* Q, const bf16* K, const bf16* V, int pitch, bf16* O, size_t rowbase, int q0, const ALAS float* cum2) {
    const int tid = threadIdx.x, lane = tid & 63, r32 = lane & 31, hi = lane >> 5, wid = __builtin_amdgcn_readfirstlane(tid >> 6);
    const int R0 = q0 + 32 * wid, qrow = R0 + r32;
    bf16x8 qr[4];
#pragma unroll
    for (int d0 = 0; d0 < 4; ++d0) qr[d0] = *(const bf16x8*)(Q + (rowbase + qrow) * pitch + 16 * d0 + 8 * hi);
    const int srow = tid >> 3, sch = tid & 7;
    const bf16* kg = K + (rowbase + srow) * pitch + sch * 8; const bf16* vg = V + (rowbase + srow) * pitch + sch * 8;
    const int kdst = srow * KSTR + sch * 16, vdst = KT_BYTES + srow * VSTR + sch * 16;
    const int kl = r32 * KSTR + 16 * hi;
    const int vl = (4 * hi + ((lane & 15) >> 2)) * VSTR + (16 * ((lane >> 4) & 1) + 4 * (lane & 3)) * 2;
    ALAS unsigned* flags = (ALAS unsigned*)(lds + FLAG_OFF);
    const int jtop = (q0 >> 6) + 3;
    u32x4 kA, vA, kB, vB, kC = {0u, 0u, 0u, 0u}, vC = {0u, 0u, 0u, 0u};
    { const u32x4 k0 = *(const u32x4*)(kg + (size_t)jtop * 64 * pitch), v0 = *(const u32x4*)(vg + (size_t)jtop * 64 * pitch);
      kA = *(const u32x4*)(kg + (size_t)(jtop - 1) * 64 * pitch); vA = *(const u32x4*)(vg + (size_t)(jtop - 1) * 64 * pitch);
      kB = *(const u32x4*)(kg + (size_t)(jtop - 2) * 64 * pitch); vB = *(const u32x4*)(vg + (size_t)(jtop - 2) * 64 * pitch);
      *(ALAS u32x4*)(lds + kdst) = k0; *(ALAS u32x4*)(lds + vdst) = v0; }
    __syncthreads();
    f32x16 o[2];
#pragma unroll
    for (int r = 0; r < 16; ++r) { o[0][r] = 0.f; o[1][r] = 0.f; }
    float carry = 0.f, m = 0.f, l = 0.f; bool started = false;
    const float cq = (MODE == 1) ? -cum2[qrow] : 0.f; float qn = 0.f;
    if (MODE == 1) { float s2 = 0.f;
#pragma unroll
        for (int d0 = 0; d0 < 4; ++d0)
#pragma unroll
            for (int j = 0; j < 8; ++j) { const float v = bf2f((unsigned short)qr[d0][j]); s2 += v * v; }
        s2 += __shfl_xor(s2, 32); qn = sqrtf(s2) * 1.002f; }
    f16x8 M0, M1, ONES;
#pragma unroll
    for (int j = 0; j < 8; ++j) { const int kk = 8 * (j >> 2) + 4 * hi + (j & 3); M0[j] = (kk > r32) ? (_Float16)1.f : (_Float16)0.f; M1[j] = (16 + kk > r32) ? (_Float16)1.f : (_Float16)0.f; ONES[j] = (_Float16)1.f; }
    int sl = 0;
    f32x16 p0, p1;
    for (int j = jtop; j >= 0; --j) {
        const bool more = j > 0;
        if (MODE == 1) { if (j > 2) { kC = *(const u32x4*)(kg + (size_t)(j - 3) * 64 * pitch); vC = *(const u32x4*)(vg + (size_t)(j - 3) * 64 * pitch); } }
        else { if (j > 1 && j < jtop) { kB = *(const u32x4*)(kg + (size_t)(j - 2) * 64 * pitch); vB = *(const u32x4*)(vg + (size_t)(j - 2) * 64 * pitch); } }
        const int key0 = 64 * j;
        const bool act = key0 <= R0 + 31;
        if (act) qk_tile<MODE>(p0, p1, lds + sl, kl, qr, cum2, key0, hi, cq - m);
        if (act) {
            const bool diag = key0 + 63 >= R0;
            const ALAS unsigned char* vb = lds + sl + KT_BYTES;
            bf16x8 pb[4];
            if (MODE == 0) {
                f32x16 l0, l1; float rs = 0.f;
#pragma unroll
                for (int r = 0; r < 16; ++r) { const int key = key0 + crow(r, hi);
                    float a = -softplus2(p0[r]), b = -softplus2(p1[r]);
                    l0[r] = a; l1[r] = b; }
                if (diag) { asm volatile("; sb diag mask 1" ::: "memory");
#pragma unroll
                    for (int r = 0; r < 16; ++r) { const int key = key0 + crow(r, hi); if (!(key < qrow)) l0[r] = 0.f; if (!(key + 32 < qrow)) l1[r] = 0.f; } }
#pragma unroll
                for (int r = 0; r < 16; ++r) rs += l0[r] + l1[r];
                rs += __shfl_xor(rs, 32);
                const f16x8 lb0 = packh8(l0, 0), lb1 = packh8(l0, 8), lb2 = packh8(l1, 0), lb3 = packh8(l1, 8);
#pragma unroll
                for (int r = 0; r < 16; ++r) { p0[r] += l0[r]; p1[r] += l1[r]; }
                asm volatile("" : "+v"(p0), "+v"(p1));
                f32x16 c0, c1;
#pragma unroll
                for (int r = 0; r < 16; ++r) { c0[r] = carry; c1[r] = carry; }
                c0 = __builtin_amdgcn_mfma_f32_32x32x16_f16(M0, lb0, c0, 0, 0, 0); c0 = __builtin_amdgcn_mfma_f32_32x32x16_f16(M1, lb1, c0, 0, 0, 0);
                c0 = __builtin_amdgcn_mfma_f32_32x32x16_f16(ONES, lb2, c0, 0, 0, 0); c0 = __builtin_amdgcn_mfma_f32_32x32x16_f16(ONES, lb3, c0, 0, 0, 0);
                c1 = __builtin_amdgcn_mfma_f32_32x32x16_f16(M0, lb2, c1, 0, 0, 0); c1 = __builtin_amdgcn_mfma_f32_32x32x16_f16(M1, lb3, c1, 0, 0, 0);
#pragma unroll
                for (int r = 0; r < 16; ++r) { const int key = key0 + crow(r, hi);
                    p0[r] = __builtin_amdgcn_exp2f(p0[r] + c0[r]); p1[r] = __builtin_amdgcn_exp2f(p1[r] + c1[r]); }
                if (diag) { asm volatile("; sb diag mask 2" ::: "memory");
#pragma unroll
                    for (int r = 0; r < 16; ++r) { const int key = key0 + crow(r, hi); if (!(key < qrow)) p0[r] = 0.f; if (!(key + 32 < qrow)) p1[r] = 0.f; } }
                carry += rs;
            } else {
                if (diag) { asm volatile("; fox diag mask" ::: "memory");
#pragma unroll
                    for (int r = 0; r < 16; ++r) { const int key = key0 + crow(r, hi); if (key > qrow) p0[r] = -INFINITY; if (key + 32 > qrow) p1[r] = -INFINITY; } }
                float ma = __builtin_fmaxf(__builtin_fmaxf(p0[0], p0[1]), p1[0]), mb = __builtin_fmaxf(__builtin_fmaxf(p0[2], p0[3]), p1[1]);
                ma = __builtin_fmaxf(__builtin_fmaxf(ma, p1[2]), p1[3]);
#pragma unroll
                for (int r = 4; r < 16; r += 4) { ma = __builtin_fmaxf(__builtin_fmaxf(ma, p0[r]), p0[r + 1]); mb = __builtin_fmaxf(__builtin_fmaxf(mb, p0[r + 2]), p0[r + 3]);
                    ma = __builtin_fmaxf(__builtin_fmaxf(ma, p1[r]), p1[r + 1]); mb = __builtin_fmaxf(__builtin_fmaxf(mb, p1[r + 2]), p1[r + 3]); }
                float mt = __builtin_fmaxf(ma, mb); mt = __builtin_fmaxf(mt, __shfl_xor(mt, 32));
                if (!started) {
                    asm volatile("; fox first tile" ::: "memory"); m = mt; started = true;
#pragma unroll
                    for (int r = 0; r < 16; ++r) { p0[r] -= mt; p1[r] -= mt; }
                } else if (__any(mt > 0.f)) {
                    asm volatile("; fox rescale" ::: "memory"); const float dl = __builtin_fmaxf(mt, 0.f); m += dl; const float f = __builtin_amdgcn_exp2f(-dl); l *= f; o[0] = o[0] * f; o[1] = o[1] * f;
#pragma unroll
                    for (int r = 0; r < 16; ++r) { p0[r] -= dl; p1[r] -= dl; } }
                float ls = 0.f;
#pragma unroll
                for (int r = 0; r < 16; ++r) { p0[r] = __builtin_amdgcn_exp2f(p0[r]); p1[r] = __builtin_amdgcn_exp2f(p1[r]); ls += p0[r] + p1[r]; }
                l += ls;
            }
            pb[0] = packbf8(p0, 0); pb[1] = packbf8(p0, 8); pb[2] = packbf8(p1, 0); pb[3] = packbf8(p1, 8);
            pv_tile(o, vb, vl, pb);
        }
        if (more) { *(ALAS u32x4*)(lds + (sl ^ STAGE) + kdst) = kA; *(ALAS u32x4*)(lds + (sl ^ STAGE) + vdst) = vA; }
        kA = kB; vA = vB; if (MODE == 1) { kB = kC; vB = vC; }
        { bool done;
          if (MODE == 0) done = __all(carry < EXIT_T);
          else {
              const float ub = more ? qn * cum2[4096 + j - 1] + (cq - m) + cum2[64 * j - 1] : 0.f; done = started && __all(ub < EXIT_T - 2.f); }
          if (lane == 0) flags[(j & 1) * 8 + wid] = done ? 1u : 0u; }
        __syncthreads();
        { unsigned a = 1u;
#pragma unroll
            for (int w = 0; w < 8; ++w) a &= flags[(j & 1) * 8 + w];
            if (a) break; }
        sl ^= STAGE;
    }
    float inv = 1.f;
    if (MODE == 1) { l += __shfl_xor(l, 32); inv = 1.0f / l; }
    bf16* orow = O + (rowbase + qrow) * DM;
#pragma unroll
    for (int dh = 0; dh < 2; ++dh)
#pragma unroll
        for (int g = 0; g < 4; ++g) { u32x2 w; w.x = pk2(o[dh][4 * g] * inv, o[dh][4 * g + 1] * inv); w.y = pk2(o[dh][4 * g + 2] * inv, o[dh][4 * g + 3] * inv);
            *(u32x2*)(orow + 32 * dh + 8 * g + 4 * hi) = w; }
    __syncthreads();
}
__device__ __forceinline__ void fox_tables(ALAS float* cum2, const float* lf, const bf16* K, int pitch) {
    const int tid = threadIdx.x, lane = tid & 63, wid = tid >> 6;
    ALAS float* pm = cum2 + 4096; ALAS float* wtot = cum2 + 4096 + 64; ALAS float* kt = cum2 + 4096 + 128;
    const f32x4 a = *(const f32x4*)(lf + tid * 8), b = *(const f32x4*)(lf + tid * 8 + 4);
    float v[8] = {a[0], a[1], a[2], a[3], b[0], b[1], b[2], b[3]};
#pragma unroll
    for (int i = 1; i < 8; ++i) v[i] += v[i - 1];
    float inc = v[7];
#pragma unroll
    for (int o = 1; o < 64; o <<= 1) { const float n = __shfl_up(inc, o); if (lane >= o) inc += n; }
    if (lane == 63) wtot[wid] = inc;
    for (int it = 0; it < 64; ++it) { const int key = it * 64 + wid * 8 + (lane >> 3);
        const u32x4 kk = *(const u32x4*)(K + (size_t)key * pitch + (lane & 7) * 8);
        float s = 0.f;
#pragma unroll
        for (int q = 0; q < 4; ++q) { const float x0 = bf2f(kk[q] & 0xffff), x1 = bf2f(kk[q] >> 16); s += x0 * x0 + x1 * x1; }
        s += __shfl_xor(s, 1); s += __shfl_xor(s, 2); s += __shfl_xor(s, 4);
        s = fmaxf(s, __shfl_xor(s, 8)); s = fmaxf(s, __shfl_xor(s, 16)); s = fmaxf(s, __shfl_xor(s, 32));
        if (lane == 0) kt[it * 8 + wid] = s; }
    __syncthreads();
    float base = inc - v[7];
    for (int w = 0; w < wid; ++w) base += wtot[w];
#pragma unroll
    for (int i = 0; i < 8; ++i) cum2[tid * 8 + i] = -(v[i] + base) * LOG2E;
    if (wid == 0) { float t = 0.f;
#pragma unroll
        for (int w = 0; w < 8; ++w) t = fmaxf(t, kt[lane * 8 + w]);
#pragma unroll
        for (int o = 1; o < 64; o <<= 1) { const float n = __shfl_up(t, o); if (lane >= o) t = fmaxf(t, n); }
        pm[lane] = sqrtf(t) * 1.002f; }
    __syncthreads();
}

constexpr int RSTR = 192;
__device__ __forceinline__ void ret_pass_a(ALAS unsigned char* lds, const bf16* P  , float* loc, float* grp, int bh, int g) {
    const int tid = threadIdx.x, lane = tid & 63, r32 = lane & 31, hi = lane >> 5, wid = __builtin_amdgcn_readfirstlane(tid >> 6);
    const int b = bh >> 3, h = bh & 7; const size_t rowbase = (size_t)b * SEQ;
    const float lg2 = log2f(1.0f - exp2f(-5.0f - (float)h)); const float cd = exp2f(128.f * lg2);
    ALAS unsigned char* kt = lds; ALAS unsigned char* vt = lds + 128 * RSTR;
    const int eh = wid >> 1, dh = wid & 1;
    const int tl = (4 * hi + ((lane & 15) >> 2)) * RSTR + (16 * ((lane >> 4) & 1) + 4 * (lane & 3)) * 2;
    f32x16 R;
#pragma unroll
    for (int r = 0; r < 16; ++r) R[r] = 0.f;
    for (int j = 0; j < 4; ++j) { const int n = 4 * g + j; const size_t tok0 = rowbase + (size_t)n * 128;
#pragma unroll
        for (int i = 0; i < 2; ++i) { const int idx = tid + 512 * i, row = idx >> 3, ch = idx & 7;
            const u32x4 kk = *(const u32x4*)(P + (tok0 + row) * EW + 512 + h * 64 + ch * 8), vv = *(const u32x4*)(P + (tok0 + row) * EW + 1024 + h * 64 + ch * 8);
            const float dk = exp2f((float)(127 - row) * lg2); u32x4 kd;
            kd.x = pk2(bf2f(kk.x & 0xffff) * dk, bf2f(kk.x >> 16) * dk); kd.y = pk2(bf2f(kk.y & 0xffff) * dk, bf2f(kk.y >> 16) * dk);
            kd.z = pk2(bf2f(kk.z & 0xffff) * dk, bf2f(kk.z >> 16) * dk); kd.w = pk2(bf2f(kk.w & 0xffff) * dk, bf2f(kk.w >> 16) * dk);
            *(ALAS u32x4*)(kt + row * RSTR + ch * 16) = kd; *(ALAS u32x4*)(vt + row * RSTR + ch * 16) = vv; }
        __syncthreads();
        if (wid < 4) {
            float* lo = loc + ((size_t)bh * 32 + n) * 4096;
#pragma unroll
            for (int r = 0; r < 16; ++r) lo[(32 * eh + crow(r, hi)) * 64 + 32 * dh + r32] = R[r];
            R = R * cd;
#pragma unroll
            for (int s = 0; s < 8; ++s) { const ALAS unsigned char* va = vt + tl + (16 * s) * RSTR + eh * 64; const ALAS unsigned char* ka = kt + tl + (16 * s) * RSTR + dh * 64;
                R = __builtin_amdgcn_mfma_f32_32x32x16_bf16(vtr2(va, va + 8 * RSTR), vtr2(ka, ka + 8 * RSTR), R, 0, 0, 0); }
        }
        __syncthreads();
    }
    if (wid < 4) { float* go = grp + ((size_t)bh * 8 + g) * 4096;
#pragma unroll
        for (int r = 0; r < 16; ++r) go[(32 * eh + crow(r, hi)) * 64 + 32 * dh + r32] = R[r]; }
}
constexpr int RB_Q = 0, RB_K = 128 * KSTR, RB_G = 2 * 128 * KSTR, RB_V = 3 * 128 * KSTR, RB_S = RB_V + 128 * RSTR, RB_RED = RB_S + 64 * KSTR;
__device__ __forceinline__ void ret_pass_b(ALAS unsigned char* lds, const bf16* P, const float* loc, const float* grp, const float* retnorm, bf16* Y, int bh, int n) {
    const int tid = threadIdx.x, lane = tid & 63, r32 = lane & 31, hi = lane >> 5, wid = __builtin_amdgcn_readfirstlane(tid >> 6);
    const int b = bh >> 3, h = bh & 7; const size_t tok0 = (size_t)b * SEQ + (size_t)n * 128;
    const float lg2 = log2f(1.0f - exp2f(-5.0f - (float)h)); const float cd = exp2f(128.f * lg2), cd4 = exp2f(512.f * lg2);
    const int g = n >> 2, j = n & 3;
    { const int e = tid >> 3, d0 = (tid & 7) * 8; const size_t off = (size_t)e * 64 + d0;
      f32x4 s0 = {0.f, 0.f, 0.f, 0.f}, s1 = {0.f, 0.f, 0.f, 0.f};
      for (int gp = 0; gp < g; ++gp) { const float* gs = grp + ((size_t)bh * 8 + gp) * 4096 + off; s0 = s0 * cd4 + *(const f32x4*)gs; s1 = s1 * cd4 + *(const f32x4*)(gs + 4); }
      const float cj = exp2f(128.f * (float)j * lg2); const float* lo = loc + ((size_t)bh * 32 + n) * 4096 + off;
      s0 = s0 * cj + *(const f32x4*)lo; s1 = s1 * cj + *(const f32x4*)(lo + 4);
      u32x4 w; w.x = pk2(s0[0], s0[1]); w.y = pk2(s0[2], s0[3]); w.z = pk2(s1[0], s1[1]); w.w = pk2(s1[2], s1[3]);
      *(ALAS u32x4*)(lds + RB_S + e * KSTR + d0 * 2) = w; }
#pragma unroll
    for (int i = 0; i < 2; ++i) { const int idx = tid + 512 * i, row = idx >> 3, ch = idx & 7; const bf16* src = P + (tok0 + row) * EW + h * 64 + ch * 8;
        *(ALAS u32x4*)(lds + RB_Q + row * KSTR + ch * 16) = *(const u32x4*)src; *(ALAS u32x4*)(lds + RB_K + row * KSTR + ch * 16) = *(const u32x4*)(src + 512);
        *(ALAS u32x4*)(lds + RB_V + row * RSTR + ch * 16) = *(const u32x4*)(src + 1024); *(ALAS u32x4*)(lds + RB_G + row * KSTR + ch * 16) = *(const u32x4*)(src + 1536); }
    __syncthreads();
    const int qb = wid & 3, eh = wid >> 2, qloc = 32 * qb + r32;
    const int tl = (4 * hi + ((lane & 15) >> 2)) * RSTR + (16 * ((lane >> 4) & 1) + 4 * (lane & 3)) * 2;
    bf16x8 qf[4];
#pragma unroll
    for (int d0 = 0; d0 < 4; ++d0) qf[d0] = *(const ALAS bf16x8*)(lds + RB_Q + qloc * KSTR + 32 * d0 + 16 * hi);
    float dloc[16];
#pragma unroll
    for (int r = 0; r < 16; ++r) dloc[r] = exp2f((float)(r32 - crow(r, hi)) * lg2);
    f32x16 ain, acr;
#pragma unroll
    for (int r = 0; r < 16; ++r) { ain[r] = 0.f; acr[r] = 0.f; }
    for (int kt = 0; kt <= qb; ++kt) {
        f32x16 s;
#pragma unroll
        for (int r = 0; r < 16; ++r) s[r] = 0.f;
#pragma unroll
        for (int d0 = 0; d0 < 4; ++d0) s = __builtin_amdgcn_mfma_f32_32x32x16_bf16(*(const ALAS bf16x8*)(lds + RB_K + (32 * kt + r32) * KSTR + 32 * d0 + 16 * hi), qf[d0], s, 0, 0, 0);
        const float fac = exp2f(32.f * (float)(qb - kt) * lg2);
#pragma unroll
        for (int r = 0; r < 16; ++r) { float v = s[r] * (dloc[r] * fac); if (kt == qb && crow(r, hi) > r32) v = 0.f; s[r] = v; }
        const bf16x8 pb0 = packbf8(s, 0), pb1 = packbf8(s, 8);
        const ALAS unsigned char* va = lds + RB_V + tl + (32 * kt) * RSTR + eh * 64;
        ain = __builtin_amdgcn_mfma_f32_32x32x16_bf16(vtr2(va, va + 8 * RSTR), pb0, ain, 0, 0, 0);
        ain = __builtin_amdgcn_mfma_f32_32x32x16_bf16(vtr2(va + 16 * RSTR, va + 24 * RSTR), pb1, ain, 0, 0, 0);
    }
#pragma unroll
    for (int d0 = 0; d0 < 4; ++d0) acr = __builtin_amdgcn_mfma_f32_32x32x16_bf16(*(const ALAS bf16x8*)(lds + RB_S + (32 * eh + r32) * KSTR + 32 * d0 + 16 * hi), qf[d0], acr, 0, 0, 0);
    const float qd = exp2f((float)(qloc + 1) * lg2);
    float s1 = 0.f, s2 = 0.f;
#pragma unroll
    for (int r = 0; r < 16; ++r) { const float v = ain[r] + qd * acr[r]; ain[r] = v; s1 += v; s2 += v * v; }
    s1 += __shfl_xor(s1, 32); s2 += __shfl_xor(s2, 32);
    ALAS float* red = (ALAS float*)(lds + RB_RED);
    if (hi == 0) { red[(wid * 32 + r32) * 2] = s1; red[(wid * 32 + r32) * 2 + 1] = s2; }
    __syncthreads();
    { const int pw = wid ^ 4; s1 += red[(pw * 32 + r32) * 2]; s2 += red[(pw * 32 + r32) * 2 + 1]; }
    const float mu = s1 * (1.f / 64.f); const float var = fmaxf(s2 * (1.f / 64.f) - mu * mu, 0.f); const float rstd = 1.0f / sqrtf(var + GN_EPS);
    bf16* yrow = Y + (tok0 + qloc) * DM + h * 64 + 32 * eh;
#pragma unroll
    for (int gq = 0; gq < 4; ++gq) { const int e0 = 8 * gq + 4 * hi;
        const u32x2 gv = *(const ALAS u32x2*)(lds + RB_G + qloc * KSTR + (32 * eh + e0) * 2); const f32x4 rn = *(const f32x4*)(retnorm + h * 64 + 32 * eh + e0);
        const float g0 = bf2f(gv.x & 0xffff), g1 = bf2f(gv.x >> 16), g2 = bf2f(gv.y & 0xffff), g3 = bf2f(gv.y >> 16);
        u32x2 w; w.x = pk2((ain[4 * gq] - mu) * rstd * rn[0] * silu_f(g0), (ain[4 * gq + 1] - mu) * rstd * rn[1] * silu_f(g1));
        w.y = pk2((ain[4 * gq + 2] - mu) * rstd * rn[2] * silu_f(g2), (ain[4 * gq + 3] - mu) * rstd * rn[3] * silu_f(g3));
        *(u32x2*)(yrow + e0) = w; }
    __syncthreads();
}
#undef ALAS
}
#define LAS __attribute__((address_space(3)))
#define XB_TMO      128
#define XB_XCNT(j)  (256  + 64 * (j))
#define XB_XSUB(j)  (1280 + 64 * (j))
#define XB_XGEN(j)  (2304 + 64 * (j))
#define XB_TOP      3328
#define XB_TOPGEN   3392
#define XCD_BAR_WORDS 3456
#define XB_SPIN_CAP (1u << 23)
__device__ __forceinline__ unsigned xb_ld(unsigned* p)              { return __hip_atomic_load(p, __ATOMIC_RELAXED, __HIP_MEMORY_SCOPE_AGENT); }
__device__ __forceinline__ unsigned xb_add(unsigned* p, unsigned v) { return __hip_atomic_fetch_add(p, v, __ATOMIC_RELAXED, __HIP_MEMORY_SCOPE_AGENT); }
__device__ __forceinline__ unsigned xb_xcc_id() { return (unsigned)__builtin_amdgcn_s_getreg((3 << 11) | 20) & 0xFu; }
#define XB_SPIN(cond, bar) do { unsigned _sp = 0; while (cond) { __builtin_amdgcn_s_sleep(1); \
    if ((++_sp & 255u) == 0u) { if (xb_ld(&(bar)[XB_TMO])) break; if (_sp > XB_SPIN_CAP) { atomicAdd(&(bar)[XB_TMO], 1u); break; } } } } while (0)
struct XcdBarrier { unsigned* bar; unsigned x; volatile LAS unsigned* st; };
__device__ __forceinline__ XcdBarrier xcd_barrier_post(unsigned* bar, volatile LAS unsigned* st) {
    XcdBarrier b; b.bar = bar; b.x = xb_xcc_id(); b.st = st;
    if (threadIdx.x == 0) (void)xb_add(&bar[XB_XCNT(b.x)], 1u);
    return b;
}
__device__ __forceinline__ void xcd_barrier_complete(unsigned* bar, unsigned x, unsigned& nloc, unsigned& nx) {
    const unsigned G = gridDim.x * gridDim.y * gridDim.z;
    unsigned sum, cnt, mine, sp = 0u;
    for (;;) {
        sum = 0u; cnt = 0u; mine = 0u;
#pragma unroll
        for (unsigned j = 0; j < 16; ++j) { const unsigned c = xb_ld(&bar[XB_XCNT(j)]); sum += c; cnt += (c > 0u) ? 1u : 0u; mine = (j == x) ? c : mine; }
        if (sum == G) break;
        __builtin_amdgcn_s_sleep(1);
        if ((++sp & 255u) == 0u) { if (xb_ld(&bar[XB_TMO])) break; if (sp > XB_SPIN_CAP) { atomicAdd(&bar[XB_TMO], 1u); break; } }
    }
    nloc = mine > 0u ? mine : 1u; nx = cnt > 0u ? cnt : 1u;
}
__device__ __forceinline__ void xcd_barrier(const XcdBarrier& b) {
    asm volatile("s_waitcnt vmcnt(0)" ::: "memory");
    __syncthreads();
    if (threadIdx.x == 0) {
        unsigned* bar = b.bar;
        __builtin_amdgcn_s_waitcnt(0);
        unsigned nloc = b.st[0], nx = b.st[1];
        if (nloc == 0u) { xcd_barrier_complete(bar, b.x, nloc, nx); b.st[0] = nloc; b.st[1] = nx; }
        const unsigned old = xb_add(&bar[XB_XSUB(b.x)], 1u);
        const unsigned gen = old / nloc;
        if (old + 1u == (gen + 1u) * nloc) {
            __builtin_amdgcn_fence(__ATOMIC_RELEASE, "agent");
            asm volatile("s_waitcnt vmcnt(0)" ::: "memory");
            const unsigned og = xb_add(&bar[XB_TOP], 1u);
            const unsigned tg = og / nx;
            if (og + 1u == (tg + 1u) * nx) xb_add(&bar[XB_TOPGEN], 1u);
            else XB_SPIN(xb_ld(&bar[XB_TOPGEN]) == tg, bar);
            __builtin_amdgcn_fence(__ATOMIC_ACQUIRE, "agent");
            xb_add(&bar[XB_XGEN(b.x)], 1u);
            asm volatile("s_waitcnt vmcnt(0)" ::: "memory");
        } else {
            XB_SPIN(xb_ld(&bar[XB_XGEN(b.x)]) == gen, bar);
            __builtin_amdgcn_fence(__ATOMIC_ACQUIRE, "agent");
            asm volatile("s_waitcnt vmcnt(0)" ::: "memory");
        }
    }
    __syncthreads();
}

constexpr int NWAVES = 8, NTHR = NWAVES * 64;
constexpr int RING_BYTES = 131072, LDS_BYTES = 147456, MISC_OFF = LDS_BYTES - 256;
constexpr int NPHASE = 16;

__device__ __forceinline__ void mixer_even_simple(unsigned char* ws, const float* retnorm, int gw, int ngw, int lane) {
    const bf16* P = (const bf16*)(ws + WS_BIG); bf16* Y = (bf16*)(ws + WS_X0);
    for (int idx = gw; idx < BATCH * 8 * SEQ; idx += ngw) {
        const int t = idx & (SEQ - 1), h = (idx >> 12) & 7, b = idx >> 15; const size_t rb = (size_t)b * SEQ;
        { const float lg2 = log2f(1.0f - exp2f(-5.0f - (float)h));
          const float q = bf2f(P[(rb + t) * EW + h * 64 + lane]); float o = 0.f;
          for (int s = 0; s <= t; ++s) { const float k = bf2f(P[(rb + s) * EW + 512 + h * 64 + lane]), v = bf2f(P[(rb + s) * EW + 1024 + h * 64 + lane]);
              o += exp2f(lg2 * (float)(t - s)) * wave_sum(q * k) * v; }
          const float mu = wave_sum(o) * (1.f / 64.f); const float dv = o - mu; const float var = wave_sum(dv * dv) * (1.f / 64.f);
          const float g = bf2f(P[(rb + t) * EW + 1536 + h * 64 + lane]);
          Y[(rb + t) * DM + h * 64 + lane] = (bf16)f2bf(dv * (1.0f / sqrtf(var + GN_EPS)) * retnorm[h * 64 + lane] * silu_f(g)); }
        { const float q = bf2f(P[(rb + t) * EW + 2048 + h * 64 + lane]); float o = 0.f, carry = 0.f;
          for (int s = t - 1; s >= 0; --s) { const float k = bf2f(P[(rb + s) * EW + 2560 + h * 64 + lane]), v = bf2f(P[(rb + s) * EW + 3072 + h * 64 + lane]);
              const float y = wave_sum(q * k); const float lf2 = -softplus2(y); o += __builtin_amdgcn_exp2f(y + lf2 + carry) * v; carry += lf2; }
          Y[(rb + t) * DM + 512 + h * 64 + lane] = (bf16)f2bf(o); }
    }
}
__device__ __forceinline__ void fox_simple(unsigned char* ws, LAS float* cum, int vcu, int wave, int lane) {
    const bf16* P = (const bf16*)(ws + WS_BIG); bf16* Y = (bf16*)(ws + WS_X0);
    const int bh = vcu >> 1, b = bh >> 4, h = bh & 15; const size_t rb = (size_t)b * SEQ;
    const float* lf = (const float*)(ws + WS_LOGF) + (size_t)bh * SEQ;
    if (wave == 0) { float run = 0.f;
        for (int j = 0; j < 64; ++j) run += lf[lane * 64 + j];
        float inc = run;
#pragma unroll
        for (int o = 1; o < 64; o <<= 1) { const float n = __shfl_up(inc, o); if (lane >= o) inc += n; }
        float acc = inc - run;
        for (int j = 0; j < 64; ++j) { acc += lf[lane * 64 + j]; cum[lane * 64 + j] = acc; } }
    __syncthreads();
    for (int t = (vcu & 1) + 2 * wave; t < SEQ; t += 16) {
        const float q = bf2f(P[(rb + t) * QKVW + h * 64 + lane]); const float ct = cum[t]; float m = -INFINITY, l = 0.f, o = 0.f;
        for (int s = 0; s <= t; ++s) { const float k = bf2f(P[(rb + s) * QKVW + 1024 + h * 64 + lane]), v = bf2f(P[(rb + s) * QKVW + 2048 + h * 64 + lane]);
            const float x = wave_sum(q * k) + (ct - cum[s]) * LOG2E;
            if (x > m) { const float f = __builtin_amdgcn_exp2f(m - x); l *= f; o *= f; m = x; }
            const float pr = __builtin_amdgcn_exp2f(x - m); l += pr; o += pr * v; }
        Y[(rb + t) * DM + h * 64 + lane] = (bf16)f2bf(o / l); }
    __syncthreads();
}
__device__ __forceinline__ void router_phase(unsigned char* ws, const bf16* hres, LAS unsigned* rl, int vcu, int wave, int lane) {
    unsigned* ctl = (unsigned*)(ws + WS_CTL); const int tid = threadIdx.x;
    LAS unsigned* lcnt = rl; LAS unsigned* lbase = rl + 16; LAS int* tinfo = (LAS int*)(rl + 32); LAS float* tg = (LAS float*)(rl + 32 + 256); LAS unsigned* tpos = rl + 32 + 512;
    if (tid < 16) lcnt[tid] = 0u;
    __syncthreads();
    const float* part4 = (const float*)(ws + WS_PART) + (size_t)2 * T * 16; const float* RW = (const float*)(ws + WS_ROUTW); float* rstd4 = (float*)(ws + WS_RSTD4);
    f32x4 rw[NEXP][4];
#pragma unroll
    for (int e = 0; e < NEXP; ++e)
#pragma unroll
        for (int j = 0; j < 4; ++j) rw[e][j] = *((const f32x4*)(RW + e * DM) + lane + 64 * j);
    for (int i0 = 0; i0 < 16; i0 += 4) {
        f32x4 v[4][4]; float ps[4];
#pragma unroll
        for (int q = 0; q < 4; ++q) { const int row = vcu * 128 + wave * 16 + i0 + q; const u32x2* xr = (const u32x2*)(hres + (size_t)row * DM) + lane;
#pragma unroll
            for (int j = 0; j < 4; ++j) { const u32x2 w = xr[64 * j]; v[q][j] = (f32x4){bf2f(w.x & 0xffff), bf2f(w.x >> 16), bf2f(w.y & 0xffff), bf2f(w.y >> 16)}; }
            ps[q] = (lane < 16) ? part4[(size_t)row * 16 + lane] : 0.f; }
#pragma unroll
        for (int q = 0; q < 4; ++q) { const int lt = wave * 16 + i0 + q, row = vcu * 128 + lt; float lg[NEXP];
#pragma unroll
            for (int e = 0; e < NEXP; ++e) { float s = 0.f;
#pragma unroll
                for (int j = 0; j < 4; ++j) s += (v[q][j][0] * rw[e][j][0] + v[q][j][1] * rw[e][j][1]) + (v[q][j][2] * rw[e][j][2] + v[q][j][3] * rw[e][j][3]);
                lg[e] = wave_sum(s); }
            float ss = 0.f;
#pragma unroll
            for (int k = 0; k < 16; ++k) ss += __shfl(ps[q], k);
            const float rstd = 1.0f / sqrtf(ss * (1.f / DM) + NORM_EPS);
            int b1 = 0; float v1 = lg[0];
#pragma unroll
            for (int e = 1; e < NEXP; ++e) if (lg[e] > v1) { v1 = lg[e]; b1 = e; }
            int b2 = -1; float v2 = -INFINITY;
#pragma unroll
            for (int e = 0; e < NEXP; ++e) if (e != b1 && lg[e] > v2) { v2 = lg[e]; b2 = e; }
            if (b2 < 0) b2 = (b1 + 1) & 7;
            const float g1 = 1.f / (1.f + __expf((v2 - v1) * rstd)), g2 = 1.f - g1;
            if (lane == 0) { rstd4[row] = rstd; tinfo[lt * 2] = b1; tinfo[lt * 2 + 1] = b2; tg[lt * 2] = g1; tg[lt * 2 + 1] = g2;
                tpos[lt * 2] = __hip_atomic_fetch_add(&lcnt[b1], 1u, __ATOMIC_RELAXED, __HIP_MEMORY_SCOPE_WORKGROUP); tpos[lt * 2 + 1] = __hip_atomic_fetch_add(&lcnt[8 + b2], 1u, __ATOMIC_RELAXED, __HIP_MEMORY_SCOPE_WORKGROUP); } }
    }
    __syncthreads();
    if (tid < 16) lbase[tid] = __hip_atomic_fetch_add(&ctl[CW_CNT + 64 * tid], lcnt[tid], __ATOMIC_RELAXED, __HIP_MEMORY_SCOPE_AGENT);
    __syncthreads();
    if (tid < 256) { const int lt = tid >> 1, c = tid & 1, e = tinfo[tid]; const unsigned pos = lbase[c * 8 + e] + tpos[tid];
        ((int*)(ws + WS_LIST))[(size_t)(c * 8 + e) * T + pos] = vcu * 128 + lt; ((float*)(ws + WS_GATE))[(size_t)(c * 8 + e) * T + pos] = tg[tid]; }
    __syncthreads();
}

typedef const __attribute__((address_space(4))) Params* KParams;
__device__ __forceinline__ KParams kargs() { unsigned long long v = (unsigned long long)__builtin_amdgcn_kernarg_segment_ptr(); asm volatile("" : "+s"(v)); return (KParams)v; }
__global__ void __launch_bounds__(NTHR, 2) mega_fwd(Params p_unused) {
    extern __shared__ __attribute__((aligned(16))) unsigned char lds_raw[];
    LAS unsigned char* lds = (LAS unsigned char*)lds_raw;
    const int tid = threadIdx.x, lane = tid & 63, wave = __builtin_amdgcn_readfirstlane(tid >> 6);
    if (tid < 64) ((LAS unsigned*)(lds + MISC_OFF))[tid] = 0u;
    __syncthreads();
    XcdBarrier bar = xcd_barrier_post((unsigned*)(kargs()->ws + WS_CTL) + CW_BAR + kargs()->li * XCD_BAR_WORDS, (volatile LAS unsigned*)(lds + MISC_OFF) + 8);
#ifndef PH_MASK
#define PH_MASK 0xffff
#endif
#define IN(k) (((PH_MASK >> (k)) & 1) && kargs()->ph_lo <= (k) && (k) < kargs()->ph_hi)
#ifdef PROBE_PH
#define SEAM(k) do { if ((k) == PROBE_PH && threadIdx.x == 0) { const unsigned busy_ = (unsigned)(__builtin_amdgcn_s_memrealtime() - pr_last); unsigned* pw_ = (unsigned*)(kargs()->ws + WS_CTL) + 2048; \
        __hip_atomic_fetch_max(pw_, busy_, __ATOMIC_RELAXED, __HIP_MEMORY_SCOPE_AGENT); __hip_atomic_fetch_min(pw_ + 64, ~busy_, __ATOMIC_RELAXED, __HIP_MEMORY_SCOPE_AGENT); __hip_atomic_fetch_max(pw_ + 128, ~busy_, __ATOMIC_RELAXED, __HIP_MEMORY_SCOPE_AGENT); } \
    if (IN(k) && IN((k) + 1)) xcd_barrier(bar); \
    if (threadIdx.x == 0) { const unsigned long long now_ = __builtin_amdgcn_s_memrealtime(); if ((k) == PROBE_PH && blockIdx.x == 0) { LAS unsigned* pl_ = (LAS unsigned*)(lds + LDS_BYTES - 128); unsigned* pw_ = (unsigned*)(kargs()->ws + WS_CTL) + 2048; \
        pl_[2] = (unsigned)(now_ - pr_last); pl_[3] = __hip_atomic_load(pw_, __ATOMIC_RELAXED, __HIP_MEMORY_SCOPE_AGENT); pl_[4] = ~__hip_atomic_load(pw_ + 128, __ATOMIC_RELAXED, __HIP_MEMORY_SCOPE_AGENT); } pr_last = now_; } } while (0)
#else
#define SEAM(k) do { if (IN(k) && IN((k) + 1)) xcd_barrier(bar); } while (0)
#endif
#define GRID_VARS const int G = gridDim.x, bx = blockIdx.x; const int vcu = (G % 8 == 0) ? (bx % 8) * (G / 8) + bx / 8 : bx; const int gw = vcu * NWAVES + wave, ngw = G * NWAVES; (void)gw; (void)ngw; (void)vcu; \
    KParams kp = kargs(); unsigned char* ws = kp->ws; (void)ws

#ifdef PROBE_PH
    unsigned long long pr_last = __builtin_amdgcn_s_memrealtime();
#endif
    if (IN(0)) { GRID_VARS; Params p; for (int i = 0; i < 19; ++i) p.in[i] = kp->in[i]; p.out = kp->out; p.ws = ws; p.ph_lo = 0; p.ph_hi = 0; p.li = 0; p.pad = 0;
        prologue_weights(p, (LAS float*)(lds + wave * TR_SCR_BYTES), gw, ngw, lane);
        prologue_small(p, bx * NTHR + tid, G * NTHR);
        const float* x = kp->in[0]; bf16* X0 = (bf16*)(ws + WS_X0);
        for (int m = gw; m < T; m += ngw) rms_row_to_bf16(x + (size_t)m * DM, X0 + (size_t)m * DM, lane);
    }
    SEAM(0);
    if (IN(1)) { GRID_VARS; pg8::ProbDense P{(const bf16*)(ws + WS_X0), (const bf16*)(ws + WS_W_IN_E), DM}; pg8::StaticOrder S; S.init(T / 256, EW / 256, G, bx);
        pg8::EpiInEven E{(bf16*)(ws + WS_BIG), (const float2*)(ws + WS_ROPE)}; pg8::gemm_phase(lds, P, S, E, 1); }
    SEAM(1);
#ifdef MIX_SIMPLE
    if (IN(2)) { GRID_VARS; mixer_even_simple(ws, kp->in[3], gw, ngw, lane); }
    SEAM(2);
    SEAM(3);
#else
    if (IN(2)) { GRID_VARS; const bf16* Pj = (const bf16*)(ws + WS_BIG); float* loc = kp->out; float* grp = kp->out + (size_t)8 * 1024 * 1024;
#ifdef PROBE_PH
        const unsigned long long pt0_ = __builtin_amdgcn_s_memrealtime();
#endif
        for (int k = 0; k < 2; ++k) { const int u = vcu + 256 * k; att::ret_pass_a(lds, Pj, loc, grp, u >> 3, u & 7); }
#ifdef PROBE_PH
        if (blockIdx.x == 0 && threadIdx.x == 0) ((LAS unsigned*)(lds + LDS_BYTES - 128))[5] = (unsigned)(__builtin_amdgcn_s_memrealtime() - pt0_);
#endif
        for (int k = 0; k < 2; ++k) { const int u = vcu + 256 * k, bh = u >> 4, qb = u & 15, h = bh & 7;
            att::unit<0>(lds, Pj + 2048 + h * 64, Pj + 2560 + h * 64, Pj + 3072 + h * 64, EW, (bf16*)(ws + WS_X0) + 512 + h * 64, (size_t)(bh >> 3) * SEQ, qb * 256, nullptr); } }
    SEAM(2);
    if (IN(3)) { GRID_VARS; const bf16* Pj = (const bf16*)(ws + WS_BIG); const float* loc = kp->out; const float* grp = kp->out + (size_t)8 * 1024 * 1024; const float* rn = kp->in[3];
#ifdef PROBE_PH
        const unsigned long long pt0_ = __builtin_amdgcn_s_memrealtime();
#endif
        for (int k = 0; k < 8; ++k) { const int u = vcu + 256 * k; att::ret_pass_b(lds, Pj, loc, grp, rn, (bf16*)(ws + WS_X0), u >> 5, u & 31); }
#ifdef PROBE_PH
        if (blockIdx.x == 0 && threadIdx.x == 0) ((LAS unsigned*)(lds + LDS_BYTES - 128))[6] = (unsigned)(__builtin_amdgcn_s_memrealtime() - pt0_);
#endif
        for (int k = 2; k < 4; ++k) { const int u = vcu + 256 * k, bh = u >> 4, qb = u & 15, h = bh & 7;
            att::unit<0>(lds, Pj + 2048 + h * 64, Pj + 2560 + h * 64, Pj + 3072 + h * 64, EW, (bf16*)(ws + WS_X0) + 512 + h * 64, (size_t)(bh >> 3) * SEQ, qb * 256, nullptr); } }
    SEAM(3);
#endif
    if (IN(4)) { GRID_VARS; pg8::ProbDense P{(const bf16*)(ws + WS_X0), (const bf16*)(ws + WS_W_OUT_E), DM}; pg8::StaticOrder S; S.init(T / 256, DM / 256, G, bx);
        pg8::EpiResid<true> E{kp->in[0], (bf16*)(ws + WS_BIG), (float*)(ws + WS_PART)}; pg8::gemm_phase(lds, P, S, E, 4); }
    SEAM(4);
    if (IN(5)) { GRID_VARS; pg8::ProbDense P{(const bf16*)(ws + WS_BIG), (const bf16*)(ws + WS_W_GU_E), DM}; pg8::StaticOrder S; S.init(T / 256, GU / 256, G, bx);
        pg8::EpiGU E{(bf16*)(ws + WS_HID), (const float*)(ws + WS_PART)}; pg8::gemm_phase(lds, P, S, E, 5); }
    SEAM(5);
    if (IN(6)) { GRID_VARS; pg8::ProbDense P{(const bf16*)(ws + WS_HID), (const bf16*)(ws + WS_W_DN_E), DFF}; pg8::StaticOrder S; S.init(T / 256, DM / 256, G, bx);
        pg8::EpiResid<false> E{(const bf16*)(ws + WS_BIG), (bf16*)(ws + WS_X0), (float*)(ws + WS_PART) + (size_t)T * 16}; pg8::gemm_phase(lds, P, S, E, 6); }
    SEAM(6);
    if (IN(7)) { GRID_VARS; pg8::ProbDense P{(const bf16*)(ws + WS_X0), (const bf16*)(ws + WS_W_IN_O), DM}; pg8::StaticOrder S; S.init(T / 256, OWP / 256, G, bx);
        pg8::EpiInOdd E{(bf16*)(ws + WS_BIG), (const float*)(ws + WS_PART) + (size_t)T * 16, kp->in[11], (float*)(ws + WS_LOGF)}; pg8::gemm_phase(lds, P, S, E, 7); }
    SEAM(7);
#ifdef FOX_SIMPLE
    if (IN(8)) { GRID_VARS; fox_simple(ws, (LAS float*)lds, vcu, wave, lane); }
#else
    if (IN(8)) { GRID_VARS; const bf16* Pj = (const bf16*)(ws + WS_BIG); const int bh = vcu >> 1, h = bh & 15;
        LAS float* cum2 = (LAS float*)(lds + att::CUM_OFF);
        att::fox_tables(cum2, (const float*)(ws + WS_LOGF) + (size_t)bh * SEQ, Pj + (size_t)(bh >> 4) * SEQ * QKVW + 1024 + h * 64, QKVW);
        for (int k = 0; k < 8; ++k) { const int s = 4 * (vcu & 1) + (k >> 1), qb = (k & 1) ? 15 - s : s;
            att::unit<1>(lds, Pj + h * 64, Pj + 1024 + h * 64, Pj + 2048 + h * 64, QKVW, (bf16*)kp->out + h * 64, (size_t)(bh >> 4) * SEQ, qb * 256, cum2); } }
#endif
    SEAM(8);
    if (IN(9)) { GRID_VARS; pg8::ProbDense P{(const bf16*)kp->out, (const bf16*)(ws + WS_W_OUT_O), DM}; pg8::StaticOrder S; S.init(T / 256, DM / 256, G, bx);
        pg8::EpiResid<false> E{(const bf16*)(ws + WS_X0), (bf16*)(ws + WS_BIG), (float*)(ws + WS_PART) + (size_t)2 * T * 16}; pg8::gemm_phase(lds, P, S, E, 9); }
    SEAM(9);
    if (IN(10)) { GRID_VARS; if (G == 256) router_phase(ws, (const bf16*)(ws + WS_BIG), (LAS unsigned*)lds, vcu, wave, lane); }
    SEAM(10);
#define MOE_PASS(c) do { \
        if (IN(11 + 2 * c)) { GRID_VARS; const unsigned* ctl = (const unsigned*)(ws + WS_CTL); int ntile = 0; \
        _Pragma("unroll") \
            for (int e = 0; e < 8; ++e) ntile += ((int)ctl[CW_CNT + 64 * (c * 8 + e)] + 255) >> 8; \
            pg8::ProbMoeGU P{(const bf16*)(ws + WS_BIG), (const bf16*)(ws + WS_W_GU_M), DM, (size_t)GU * DM * 2, ctl, c, (const int*)(ws + WS_LIST)}; pg8::StaticOrder S; S.init(ntile, GU / 256, G, bx); \
            pg8::EpiMoeGU E{(bf16*)(ws + WS_HID), (const float*)(ws + WS_RSTD4), ctl, c, (const int*)(ws + WS_LIST)}; pg8::gemm_phase(lds, P, S, E, 11 + 2 * c); } \
        SEAM(11 + 2 * c); \
        if (IN(12 + 2 * c)) { GRID_VARS; const unsigned* ctl = (const unsigned*)(ws + WS_CTL); int ntile = 0; \
        _Pragma("unroll") \
            for (int e = 0; e < 8; ++e) ntile += ((int)ctl[CW_CNT + 64 * (c * 8 + e)] + 255) >> 8; \
            pg8::ProbMoeDown P{(const bf16*)(ws + WS_HID), (const bf16*)(ws + WS_W_DN_M), DFF, (size_t)DM * DFF * 2, ctl, c}; pg8::StaticOrder S; S.init(ntile, DM / 256, G, bx); \
            pg8::EpiMoeDown<(c == 0)> E{kp->out, (const bf16*)(ws + WS_BIG), ctl, c, (const int*)(ws + WS_LIST), (const float*)(ws + WS_GATE)}; pg8::gemm_phase(lds, P, S, E, 12 + 2 * c); } \
        SEAM(12 + 2 * c); \
    } while (0)
    MOE_PASS(0);
    MOE_PASS(1);
#undef MOE_PASS
    if (IN(15)) { GRID_VARS; float* out = kp->out; const float* fg = kp->in[18]; for (int m = gw; m < T; m += ngw) final_norm_row(out + (size_t)m * DM, fg, lane); }
#ifdef PROBE_PH
    if (blockIdx.x == 0 && threadIdx.x == 0) { const unsigned v = ((LAS unsigned*)(lds + LDS_BYTES - 128))[PROBE_SEL]; const unsigned long long t0 = __builtin_amdgcn_s_memrealtime();
        while (__builtin_amdgcn_s_memrealtime() - t0 < (unsigned long long)v * 16ull) __builtin_amdgcn_s_sleep(8); }
#endif
#undef IN
#undef SEAM
#undef GRID_VARS
}

#ifndef MK_N_LAUNCHES
#define MK_N_LAUNCHES 1
#endif
extern "C" void kernel_launch(void* const* d_in, const int* in_sizes, int n_in, void* d_out, int out_size, void* d_ws, size_t ws_size, hipStream_t stream) {
    static int grid = 0;
    if (grid == 0) {
        if (n_in != 19 || out_size != T * DM || ws_size < WS_END) { fprintf(stderr, "kernel_launch: unexpected shapes (n_in %d out %d ws %zu)\n", n_in, out_size, ws_size); grid = -1; return; }
        int dev = 0, cus = 0, per_cu = 0;
        if (hipGetDevice(&dev) != hipSuccess || hipDeviceGetAttribute(&cus, hipDeviceAttributeMultiprocessorCount, dev) != hipSuccess) { grid = -1; return; }
        if (hipFuncSetAttribute((const void*)mega_fwd, hipFuncAttributeMaxDynamicSharedMemorySize, LDS_BYTES) != hipSuccess) { fprintf(stderr, "kernel_launch: hipFuncSetAttribute failed\n"); grid = -1; return; }
        if (hipOccupancyMaxActiveBlocksPerMultiprocessor(&per_cu, (const void*)mega_fwd, NTHR, LDS_BYTES) != hipSuccess || per_cu < 1) { fprintf(stderr, "kernel_launch: occupancy query says %d\n", per_cu); }
        (void)hipGetLastError();
        grid = cus;
        if (grid != 256) fprintf(stderr, "kernel_launch: %d CUs; the router phase assumes 256\n", grid);
    }
    if (grid < 0) return;
    (void)in_sizes;
    if (hipMemsetAsync((char*)d_ws + WS_CTL, 0, CTL_BYTES, stream) != hipSuccess) return;
    Params p{};
    for (int i = 0; i < 19; ++i) p.in[i] = (const float*)d_in[i];
    p.out = (float*)d_out; p.ws = (unsigned char*)d_ws;
#if defined(EXP_PHASE)
    p.ph_lo = 0; p.ph_hi = EXP_PHASE + 1; p.li = 0; hipLaunchKernelGGL(mega_fwd, dim3(grid), dim3(NTHR), LDS_BYTES, stream, p);
    p.ph_lo = EXP_PHASE; p.ph_hi = EXP_PHASE + 1; p.li = 1; hipLaunchKernelGGL(mega_fwd, dim3(grid), dim3(NTHR), LDS_BYTES, stream, p);
    p.ph_lo = EXP_PHASE + 1; p.ph_hi = NPHASE; p.li = 2; hipLaunchKernelGGL(mega_fwd, dim3(grid), dim3(NTHR), LDS_BYTES, stream, p);
#elif MK_N_LAUNCHES == 1
    p.ph_lo = 0; p.ph_hi = NPHASE; p.li = 0;
    hipLaunchKernelGGL(mega_fwd, dim3(grid), dim3(NTHR), LDS_BYTES, stream, p);
#else
    for (int k = 0; k < NPHASE; ++k) { p.ph_lo = k; p.ph_hi = k + 1; p.li = 0; hipLaunchKernelGGL(mega_fwd, dim3(grid), dim3(NTHR), LDS_BYTES, stream, p); }
#endif
}
```
